# Optimizing an MI355X kernel written in HIP

```python
import jax, jax.numpy as jnp
from jax import lax
import numpy as np

D_MODEL = 1024
BATCH = 16
SEQ = 2048
DEPTH = 2

CHUNK = 64
Q_BLOCK = 128
EPS = 1e-6

A_HEADS = 8
A_HEAD_DIM = 64
IDX_HEADS = 4
IDX_DIM = 64
TOPK_MAX = 256

B_HEADS = 8
B_HEAD_DIM = 64

C_HEADS = 4
C_KEY_DIM = 64
C_VAL_DIM = 128
C_GATE_RANK = 16
C_GATE_TAU = 16.0

PEER_HEADS = 8
PEER_NKEYS = 128
PEER_EXPERTS = PEER_NKEYS * PEER_NKEYS
PEER_QDIM = 256
PEER_TOPK = 16
TOKEN_BLOCK = 128

N_BRANCH = 3
BRANCH_WIDTH = 512
COL_WIDTHS = (
    A_HEADS * A_HEAD_DIM,
    A_HEAD_DIM,
    A_HEAD_DIM,
    IDX_HEADS * IDX_DIM,
    IDX_DIM,
    IDX_HEADS,
    B_HEADS * B_HEAD_DIM,
    B_HEADS * B_HEAD_DIM,
    B_HEADS * B_HEAD_DIM,
    C_HEADS * C_KEY_DIM,
    C_HEADS * C_KEY_DIM,
    C_HEADS * C_VAL_DIM,
    C_HEADS * C_VAL_DIM,
    C_GATE_RANK,
    N_BRANCH * D_MODEL,
)
IN_COLS = sum(COL_WIDTHS)

kernel_name = "hybrid_dsa_stickbreak_gla_peer_trunk"


def rms_norm(x, g):
    xf = x.astype(jnp.float32)
    y = xf * lax.rsqrt(jnp.mean(xf * xf, axis=-1, keepdims=True) + EPS)
    return y.astype(x.dtype) * g


def to_blocks(x, nb):
    b, t = x.shape[:2]
    return jnp.moveaxis(x.reshape(b, nb, t // nb, *x.shape[2:]), 1, 0)


def from_blocks(y):
    y = jnp.moveaxis(y, 0, 1)
    return y.reshape(y.shape[0], y.shape[1] * y.shape[2], *y.shape[3:])


def dsa_attention(q, k, v, q_idx, k_idx, w_idx, q_gain, k_gain):
    bsz, t_len = q.shape[:2]
    n_sel = min(TOPK_MAX, t_len // 4)
    nb = t_len // Q_BLOCK
    q = rms_norm(q, q_gain)
    k = rms_norm(k, k_gain)
    scale = A_HEAD_DIM ** -0.5
    gather = jax.vmap(lambda table, idx: table[idx])
    keys_pos = jnp.arange(t_len)

    def block(args):
        i, qb, qib, wb = args
        t = i * Q_BLOCK + jnp.arange(Q_BLOCK)
        limit = (t // CHUNK + 1) * CHUNK
        admissible = keys_pos[None, :] < limit[:, None]
        rel = jax.nn.relu(jnp.einsum('bqhd,bsd->bqhs', qib, k_idx).astype(jnp.float32))
        score = jnp.einsum('bqh,bqhs->bqs', wb.astype(jnp.float32), rel)
        score = jnp.where(admissible[None], score, -jnp.inf)
        _, sel = lax.top_k(score, n_sel)
        valid = sel < limit[None, :, None]
        k_sel = gather(k, sel)
        v_sel = gather(v, sel)
        logits = jnp.einsum('bqhd,bqkd->bqhk', qb, k_sel).astype(jnp.float32) * scale
        logits = jnp.where(valid[:, :, None, :], logits, -jnp.inf)
        p = jax.nn.softmax(logits, axis=-1).astype(v.dtype)
        return jnp.einsum('bqhk,bqkd->bqhd', p, v_sel)

    out = lax.map(block, (jnp.arange(nb), to_blocks(q, nb), to_blocks(q_idx, nb), to_blocks(w_idx, nb)))
    return from_blocks(out).reshape(bsz, t_len, -1)


def stick_breaking_attention(q, k, v, q_gain, k_gain):
    bsz, t_len = q.shape[:2]
    nb = t_len // Q_BLOCK
    q = rms_norm(q, q_gain)
    k = rms_norm(k, k_gain)
    scale = B_HEAD_DIM ** -0.5
    keys_pos = jnp.arange(t_len)

    def block(args):
        i, qb = args
        t = i * Q_BLOCK + jnp.arange(Q_BLOCK)
        strict = keys_pos[None, :] < t[:, None]
        z = jnp.einsum('bqhd,bshd->bhqs', qb, k).astype(jnp.float32) * scale
        log_beta = jax.nn.log_sigmoid(z)
        log_keep = jnp.where(strict, jax.nn.log_sigmoid(-z), 0.0)
        later = lax.cumsum(log_keep, axis=3, reverse=True) - log_keep
        a = jnp.where(strict, jnp.exp(log_beta + later), 0.0).astype(v.dtype)
        return jnp.einsum('bhqs,bshd->bqhd', a, v)

    out = lax.map(block, (jnp.arange(nb), to_blocks(q, nb)))
    return from_blocks(out).reshape(bsz, t_len, -1)


def gla_attention(q, k, v, r, a_low, w_alpha, b_alpha, out_gain):
    bsz, t_len = q.shape[:2]
    nc = t_len // CHUNK
    f32 = jnp.float32
    log_alpha = jax.nn.log_sigmoid((a_low @ w_alpha + b_alpha).astype(f32)) / C_GATE_TAU
    log_alpha = log_alpha.reshape(bsz, t_len, C_HEADS, C_KEY_DIM)
    qs = q.astype(f32) * (C_KEY_DIM ** -0.5)

    def chunks(x):
        return jnp.swapaxes(to_blocks(x, nc), 2, 3)

    causal = jnp.tril(jnp.ones((CHUNK, CHUNK), dtype=bool))

    def step(state, inp):
        qc, kc, vc, lac = inp
        b = jnp.cumsum(lac, axis=2)
        o_inter = jnp.einsum('bhtk,bhkv->bhtv', qc * jnp.exp(b), state)
        diff = b[:, :, :, None, :] - b[:, :, None, :, :]
        decay = jnp.exp(jnp.where(causal[:, :, None], diff, -jnp.inf))
        att = jnp.einsum('bhtk,bhsk,bhtsk->bhts', qc, kc, decay)
        o_intra = jnp.einsum('bhts,bhsv->bhtv', att, vc)
        b_last = b[:, :, -1:, :]
        state = state * jnp.exp(b_last[:, :, 0, :, None]) + jnp.einsum(
            'bhsk,bhsv->bhkv', kc * jnp.exp(b_last - b), vc)
        return state, o_inter + o_intra

    state0 = jnp.zeros((bsz, C_HEADS, C_KEY_DIM, C_VAL_DIM), f32)
    _, o = lax.scan(step, state0, (chunks(qs), chunks(k.astype(f32)), chunks(v.astype(f32)), chunks(log_alpha)))
    o = from_blocks(jnp.swapaxes(o, 2, 3)).astype(q.dtype)
    o = rms_norm(o, out_gain.reshape(C_HEADS, C_VAL_DIM)) * jax.nn.silu(r)
    return o.reshape(bsz, t_len, -1)


def hybrid_mixer(n, w_in, b_gate, a_qn_g, a_kn_g, b_qn_g, b_kn_g, c_w_alpha, c_b_alpha, c_on_g,
                 w_oa, w_ob, w_oc, w_out):
    bsz, t_len, d = n.shape
    z = n @ w_in
    (aq, ak, av, iq, ik, iw, bq, bk, bv, cq, ck, cv, cr, ca, gl) = jnp.split(
        z, np.cumsum(COL_WIDTHS)[:-1].tolist(), axis=-1)
    ya = dsa_attention(aq.reshape(bsz, t_len, A_HEADS, A_HEAD_DIM), ak, av,
                       iq.reshape(bsz, t_len, IDX_HEADS, IDX_DIM), ik, iw, a_qn_g, a_kn_g)
    yb = stick_breaking_attention(bq.reshape(bsz, t_len, B_HEADS, B_HEAD_DIM),
                                  bk.reshape(bsz, t_len, B_HEADS, B_HEAD_DIM),
                                  bv.reshape(bsz, t_len, B_HEADS, B_HEAD_DIM), b_qn_g, b_kn_g)
    yc = gla_attention(cq.reshape(bsz, t_len, C_HEADS, C_KEY_DIM), ck.reshape(bsz, t_len, C_HEADS, C_KEY_DIM),
                       cv.reshape(bsz, t_len, C_HEADS, C_VAL_DIM), cr.reshape(bsz, t_len, C_HEADS, C_VAL_DIM),
                       ca, c_w_alpha, c_b_alpha, c_on_g)
    gates = jax.nn.sigmoid((gl + b_gate).astype(jnp.float32)).astype(n.dtype).reshape(bsz, t_len, N_BRANCH, d)
    merged = gates[:, :, 0] * (ya @ w_oa) + gates[:, :, 1] * (yb @ w_ob) + gates[:, :, 2] * (yc @ w_oc)
    return merged @ w_out


def peer_ffn(xn, w_pq, sub_keys, u_tab, v_tab):
    bsz, t_len, d = xn.shape
    nblk = (bsz * t_len) // TOKEN_BLOCK
    xt = xn.reshape(nblk, TOKEN_BLOCK, d)

    def block(xb):
        q = (xb @ w_pq).reshape(TOKEN_BLOCK, PEER_HEADS, 2, PEER_QDIM // 2)
        s = jnp.einsum('nhpd,hpkd->nhpk', q, sub_keys).astype(jnp.float32)
        top_s, top_i = lax.top_k(s, PEER_TOPK)
        cand = (top_s[:, :, 0, :, None] + top_s[:, :, 1, None, :]).reshape(TOKEN_BLOCK, PEER_HEADS, -1)
        cand_idx = (top_i[:, :, 0, :, None] * PEER_NKEYS + top_i[:, :, 1, None, :]).reshape(
            TOKEN_BLOCK, PEER_HEADS, -1)
        best_s, best_j = lax.top_k(cand, PEER_TOPK)
        expert = jnp.take_along_axis(cand_idx, best_j, axis=-1)
        g = jax.nn.softmax(best_s, axis=-1)
        u = u_tab[expert]
        vv = v_tab[expert]
        act = jax.nn.gelu(jnp.einsum('nd,nhkd->nhk', xb, u).astype(jnp.float32), approximate=False)
        return jnp.einsum('nhk,nhkd->nd', (g * act).astype(xb.dtype), vv)

    return lax.map(block, xt).reshape(bsz, t_len, d)


def setup_inputs(seed: int = 0) -> dict:
    key = jax.random.key(seed)
    ks = jax.random.split(key, 24)
    L, D = DEPTH, D_MODEL

    def nrm(k, shape, std):
        return jax.random.normal(k, shape, jnp.float32) * std

    return {
        "x": nrm(ks[0], (BATCH, SEQ, D), 1.0),
        "c": nrm(ks[1], (BATCH, D), 1.0),
        "norm1_g": 1.0 + nrm(ks[2], (L, D), 0.02),
        "norm2_g": 1.0 + nrm(ks[3], (L, D), 0.02),
        "w_mod": nrm(ks[4], (L, D, 6 * D), 0.5 * D ** -0.5),
        "b_mod": nrm(ks[5], (L, 6 * D), 0.02),
        "w_in": nrm(ks[6], (L, D, IN_COLS), D ** -0.5),
        "b_gate": nrm(ks[7], (L, N_BRANCH * D), 0.02),
        "a_qn_g": 1.0 + nrm(ks[8], (L, A_HEAD_DIM), 0.02),
        "a_kn_g": 1.0 + nrm(ks[9], (L, A_HEAD_DIM), 0.02),
        "b_qn_g": 1.0 + nrm(ks[10], (L, B_HEAD_DIM), 0.02),
        "b_kn_g": 1.0 + nrm(ks[11], (L, B_HEAD_DIM), 0.02),
        "c_w_alpha": nrm(ks[12], (L, C_GATE_RANK, C_HEADS * C_KEY_DIM), C_GATE_RANK ** -0.5),
        "c_b_alpha": nrm(ks[13], (L, C_HEADS * C_KEY_DIM), 0.02),
        "c_on_g": 1.0 + nrm(ks[14], (L, C_HEADS * C_VAL_DIM), 0.02),
        "w_oa": nrm(ks[15], (L, A_HEADS * A_HEAD_DIM, D), (A_HEADS * A_HEAD_DIM) ** -0.5),
        "w_ob": nrm(ks[16], (L, B_HEADS * B_HEAD_DIM, D), (B_HEADS * B_HEAD_DIM) ** -0.5),
        "w_oc": nrm(ks[17], (L, C_HEADS * C_VAL_DIM, D), (C_HEADS * C_VAL_DIM) ** -0.5),
        "w_out": nrm(ks[18], (L, D, D), D ** -0.5),
        "peer_wq": nrm(ks[19], (L, D, PEER_HEADS * PEER_QDIM), D ** -0.5),
        "peer_subkeys": nrm(ks[20], (L, PEER_HEADS, 2, PEER_NKEYS, PEER_QDIM // 2), (PEER_QDIM // 2) ** -0.5),
        "peer_u": nrm(ks[21], (L, PEER_EXPERTS, D), D ** -0.5),
        "peer_v": nrm(ks[22], (L, PEER_EXPERTS, D), 1.0),
    }


def reference(x, c, norm1_g, norm2_g, w_mod, b_mod, w_in, b_gate, a_qn_g, a_kn_g, b_qn_g, b_kn_g,
              c_w_alpha, c_b_alpha, c_on_g, w_oa, w_ob, w_oc, w_out,
              peer_wq, peer_subkeys, peer_u, peer_v):
    bsz, t_len, d = x.shape
    h = x
    c_act = jax.nn.silu(c)
    for l in range(DEPTH):
        mod = (c_act @ w_mod[l] + b_mod[l]).reshape(bsz, 6, 1, d)
        shift1, scale1, gate1 = mod[:, 0], mod[:, 1], mod[:, 2]
        shift2, scale2, gate2 = mod[:, 3], mod[:, 4], mod[:, 5]
        n = rms_norm(h, norm1_g[l]) * (1.0 + scale1) + shift1
        y = hybrid_mixer(n, w_in[l], b_gate[l], a_qn_g[l], a_kn_g[l], b_qn_g[l], b_kn_g[l],
                         c_w_alpha[l], c_b_alpha[l], c_on_g[l], w_oa[l], w_ob[l], w_oc[l], w_out[l])
        h = h + gate1 * y
        n = rms_norm(h, norm2_g[l]) * (1.0 + scale2) + shift2
        h = h + gate2 * peer_ffn(n, peer_wq[l], peer_subkeys[l], peer_u[l], peer_v[l])
    return h
```

```cpp
#include <hip/hip_runtime.h>
#include <hip/hip_cooperative_groups.h>
#include <cstdio>
#include <cstdint>
namespace cg = cooperative_groups;

#ifndef MK_COOP
#define MK_COOP 0
#endif

typedef unsigned short bf16;

constexpr int D = 1024, BATCH = 16, SEQ = 2048, DEPTH = 2, NTOK = BATCH * SEQ;
constexpr int INC = 7124;
constexpr int ZC = 4096;
constexpr int Z_AQ = 0, Z_AK = 512, Z_AV = 576, Z_IQ = 640, Z_IK = 896, Z_BQ = 960, Z_BK = 1472, Z_BV = 1984,
              Z_CQ = 2496, Z_CK = 2752, Z_CV = 3008, Z_CR = 3520, Z_IW = 4032, Z_CA = 4036;
constexpr int NTHR = 512;
constexpr int LDS_BYTES = 147456;

constexpr size_t MiB = 1u << 20;
constexpr size_t WS_CTL = 0;
constexpr size_t WS_MOD = 1 * MiB;
constexpr size_t WS_N = 28 * MiB;
constexpr size_t WS_YA = 92 * MiB, WS_YB = 124 * MiB, WS_YC = 156 * MiB;
constexpr size_t WS_MERGED = WS_YA;
constexpr size_t WS_Z = 188 * MiB;
constexpr size_t WS_T = WS_Z;
constexpr size_t WS_M = WS_Z + 128 * MiB;
constexpr size_t WS_PQ = WS_Z;
constexpr size_t WS_PE = WS_Z + 128 * MiB;
constexpr size_t WS_PG = WS_Z + 144 * MiB;
constexpr size_t WS_CRAW = 452 * MiB;
constexpr size_t WS_END = 516 * MiB;

struct Ids { int tid, bid; };
struct Params {
    const float *x, *c, *norm1_g, *norm2_g, *w_mod, *b_mod, *w_in, *b_gate, *a_qn_g, *a_kn_g, *b_qn_g, *b_kn_g,
                *c_w_alpha, *c_b_alpha, *c_on_g, *w_oa, *w_ob, *w_oc, *w_out, *peer_wq, *peer_subkeys, *peer_u, *peer_v;
    float* out; unsigned char* ws;
    int ph_lo, ph_hi;
};

__device__ __forceinline__ float bf2f(bf16 v) { return __uint_as_float(((unsigned)v) << 16); }
__device__ __forceinline__ bf16 f2bf(float f) { unsigned u = __float_as_uint(f); return (bf16)((u + 0x7fffu + ((u >> 16) & 1u)) >> 16); }
__device__ __forceinline__ float wave_sum(float v) {
#pragma unroll
    for (int o = 1; o < 64; o <<= 1) v += __shfl_xor(v, o);
    return v;
}
__device__ __forceinline__ float wave_max(float v) {
#pragma unroll
    for (int o = 1; o < 64; o <<= 1) v = fmaxf(v, __shfl_xor(v, o));
    return v;
}
__device__ __forceinline__ float logsig(float x) { return fminf(x, 0.f) - log1pf(expf(-fabsf(x))); }
__device__ __forceinline__ void unpack8(uint4 u, float* f) {
    f[0] = __uint_as_float(u.x << 16); f[1] = __uint_as_float(u.x & 0xffff0000u);
    f[2] = __uint_as_float(u.y << 16); f[3] = __uint_as_float(u.y & 0xffff0000u);
    f[4] = __uint_as_float(u.z << 16); f[5] = __uint_as_float(u.z & 0xffff0000u);
    f[6] = __uint_as_float(u.w << 16); f[7] = __uint_as_float(u.w & 0xffff0000u);
}

__device__ void ph_mod(const Ids& id, const Params& p, float* lds) {
    float* s_c = lds; float* s_red = lds + 16384;
    const int tid = id.tid;
    for (int i = tid; i < 16384; i += NTHR) { float v = p.c[i]; s_c[i] = v / (1.f + expf(-v)); }
    __syncthreads();
    float* mod = (float*)(p.ws + WS_MOD);
    const int j = tid & 63, ks = tid >> 6;
    for (int item = id.bid; item < 2 * 96; item += gridDim.x) {
        const int l = item / 96, jt = item % 96, col = jt * 64 + j;
        const float* w = p.w_mod + (size_t)l * 1024 * 6144 + col;
        float acc[16];
#pragma unroll
        for (int b = 0; b < 16; ++b) acc[b] = 0.f;
        for (int k = ks * 128; k < ks * 128 + 128; ++k) {
            const float wv = w[(size_t)k * 6144];
#pragma unroll
            for (int b = 0; b < 16; ++b) acc[b] += s_c[b * 1024 + k] * wv;
        }
#pragma unroll
        for (int b = 0; b < 16; ++b) s_red[(ks * 64 + j) * 16 + b] = acc[b];
        __syncthreads();
        for (int o = tid; o < 1024; o += NTHR) {
            const int jj = o & 63, b = o >> 6; float s = 0.f;
            for (int q = 0; q < 8; ++q) s += s_red[(q * 64 + jj) * 16 + b];
            const int c2 = jt * 64 + jj;
            mod[((size_t)l * 16 + b) * 6144 + c2] = s + p.b_mod[l * 6144 + c2];
        }
        __syncthreads();
    }
}

__device__ void ph_norm(const Ids& id, const Params& p, int layer, int which) {
    const float* hin = (which == 0 && layer == 0) ? p.x : p.out;
    const float* g = (which == 0 ? p.norm1_g : p.norm2_g) + layer * 1024;
    const float* mod = (const float*)(p.ws + WS_MOD) + (size_t)layer * 16 * 6144;
    bf16* N = (bf16*)(p.ws + WS_N);
    const int lane = id.tid & 63, wave = id.tid >> 6;
    for (int tok = id.bid * 8 + wave; tok < NTOK; tok += gridDim.x * 8) {
        const int b = tok >> 11;
        const float* shift = mod + b * 6144 + (which ? 3 : 0) * 1024; const float* scale = shift + 1024;
        const float4* hr = (const float4*)(hin + (size_t)tok * 1024);
        float4 v[4]; float ss = 0.f;
#pragma unroll
        for (int j = 0; j < 4; ++j) { v[j] = hr[lane + 64 * j]; ss += v[j].x * v[j].x + v[j].y * v[j].y + v[j].z * v[j].z + v[j].w * v[j].w; }
        ss = wave_sum(ss);
        const float r = rsqrtf(ss * (1.f / 1024.f) + 1e-6f);
#pragma unroll
        for (int j = 0; j < 4; ++j) {
            const int c = (lane + 64 * j) * 4;
            const float4 gg = *(const float4*)(g + c), sc = *(const float4*)(scale + c), sh = *(const float4*)(shift + c);
            const float o0 = v[j].x * r * gg.x * (1.f + sc.x) + sh.x, o1 = v[j].y * r * gg.y * (1.f + sc.y) + sh.y;
            const float o2 = v[j].z * r * gg.z * (1.f + sc.z) + sh.z, o3 = v[j].w * r * gg.w * (1.f + sc.w) + sh.w;
            uint2 pk; pk.x = (unsigned)f2bf(o0) | ((unsigned)f2bf(o1) << 16); pk.y = (unsigned)f2bf(o2) | ((unsigned)f2bf(o3) << 16);
            *(uint2*)(N + (size_t)tok * 1024 + c) = pk;
        }
    }
}

__device__ __forceinline__ int inproj_src_col(int n) { return n < 960 ? n : (n < 4032 ? n + 4 : (n < 4036 ? n - 4032 + 960 : n)); }
template <bool MAP, class Epi>
__device__ void gemm_naive(const Ids& id, const bf16* A, int lda, const float* W, int ldb, int N, int K, const Epi& epi, float* lds) {
    float* As = lds;
    float* Bs = lds + 16 * 132;
    const int tid = id.tid, tx = tid & 31, ty = tid >> 5;
    const int ntn = (N + 127) / 128, ntm = NTOK / 128;
    for (int tile = id.bid; tile < ntm * ntn; tile += gridDim.x) {
        const int tm = tile / ntn, tn = tile % ntn, m0 = tm * 128, n0 = tn * 128;
        float acc[8][4];
#pragma unroll
        for (int i = 0; i < 8; ++i)
#pragma unroll
            for (int j = 0; j < 4; ++j) acc[i][j] = 0.f;
        for (int k0 = 0; k0 < K; k0 += 16) {
            {
                const int row = tid >> 2, kq = (tid & 3) * 4;
                const uint2 raw = *(const uint2*)(A + (size_t)(m0 + row) * lda + k0 + kq);
                As[(kq + 0) * 132 + row] = __uint_as_float(raw.x << 16);
                As[(kq + 1) * 132 + row] = __uint_as_float(raw.x & 0xffff0000u);
                As[(kq + 2) * 132 + row] = __uint_as_float(raw.y << 16);
                As[(kq + 3) * 132 + row] = __uint_as_float(raw.y & 0xffff0000u);
            }
            {
                const int k = tid >> 5, nq = (tid & 31) * 4;
                float4 v = make_float4(0.f, 0.f, 0.f, 0.f);
                if (n0 + nq < N) v = *(const float4*)(W + (size_t)(k0 + k) * ldb + (MAP ? inproj_src_col(n0 + nq) : n0 + nq));
                *(float4*)(Bs + k * 128 + nq) = v;
            }
            __syncthreads();
#pragma unroll
            for (int kk = 0; kk < 16; ++kk) {
                const float4 a0 = *(const float4*)(As + kk * 132 + ty * 8), a1 = *(const float4*)(As + kk * 132 + ty * 8 + 4);
                const float4 bb = *(const float4*)(Bs + kk * 128 + tx * 4);
                const float a[8] = {a0.x, a0.y, a0.z, a0.w, a1.x, a1.y, a1.z, a1.w};
                const float b[4] = {bb.x, bb.y, bb.z, bb.w};
#pragma unroll
                for (int i = 0; i < 8; ++i)
#pragma unroll
                    for (int j = 0; j < 4; ++j) acc[i][j] += a[i] * b[j];
            }
            __syncthreads();
        }
        const int n = n0 + tx * 4;
        if (n < N) {
#pragma unroll
            for (int i = 0; i < 8; ++i) epi(m0 + ty * 8 + i, n, acc[i][0], acc[i][1], acc[i][2], acc[i][3]);
        }
    }
}

struct EpiBf { bf16* O; int ldo; int dcol0;
    __device__ __forceinline__ void operator()(int m, int n, float v0, float v1, float v2, float v3) const {
        uint2 pk; pk.x = (unsigned)f2bf(v0) | ((unsigned)f2bf(v1) << 16); pk.y = (unsigned)f2bf(v2) | ((unsigned)f2bf(v3) << 16);
        *(uint2*)(O + (size_t)m * ldo + dcol0 + n) = pk; } };
struct EpiF32 { float* T;
    __device__ __forceinline__ void operator()(int m, int n, float v0, float v1, float v2, float v3) const {
        *(float4*)(T + (size_t)m * 1024 + n) = make_float4(v0, v1, v2, v3); } };
__device__ __forceinline__ float sigm(float x) { return 1.f / (1.f + expf(-x)); }
struct EpiGate { const float* T; float* M; const float* bias; bf16* merged; int mode;
    __device__ __forceinline__ void operator()(int m, int n, float v0, float v1, float v2, float v3) const {
        const float4 t = *(const float4*)(T + (size_t)m * 1024 + n); const float4 bb = *(const float4*)(bias + n);
        float4 r = make_float4(sigm(v0 + bb.x) * t.x, sigm(v1 + bb.y) * t.y, sigm(v2 + bb.z) * t.z, sigm(v3 + bb.w) * t.w);
        if (mode >= 1) { const float4 o = *(const float4*)(M + (size_t)m * 1024 + n); r.x += o.x; r.y += o.y; r.z += o.z; r.w += o.w; }
        if (mode <= 1) *(float4*)(M + (size_t)m * 1024 + n) = r;
        else { uint2 pk; pk.x = (unsigned)f2bf(r.x) | ((unsigned)f2bf(r.y) << 16); pk.y = (unsigned)f2bf(r.z) | ((unsigned)f2bf(r.w) << 16);
               *(uint2*)(merged + (size_t)m * 1024 + n) = pk; } } };
struct EpiRes { const float* hin; float* out; const float* gate;
    __device__ __forceinline__ void operator()(int m, int n, float v0, float v1, float v2, float v3) const {
        const int b = m >> 11; const float4 g = *(const float4*)(gate + (size_t)b * 6144 + n); const float4 h = *(const float4*)(hin + (size_t)m * 1024 + n);
        *(float4*)(out + (size_t)m * 1024 + n) = make_float4(h.x + g.x * v0, h.y + g.y * v1, h.z + g.z * v2, h.w + g.w * v3); } };

__device__ void ph_qknorm(const Ids& id, const Params& p, int layer) {
    bf16* Z = (bf16*)(p.ws + WS_Z);
    const int lane = id.tid & 63, wave = id.tid >> 6;
    for (int tok = id.bid * 8 + wave; tok < NTOK; tok += gridDim.x * 8) {
        bf16* zr = Z + (size_t)tok * ZC;
        for (int v = 0; v < 25; ++v) {
            int off; const float* g;
            if (v < 8) { off = Z_AQ + v * 64; g = p.a_qn_g; } else if (v == 8) { off = Z_AK; g = p.a_kn_g; }
            else if (v < 17) { off = Z_BQ + (v - 9) * 64; g = p.b_qn_g; } else { off = Z_BK + (v - 17) * 64; g = p.b_kn_g; }
            const float x = bf2f(zr[off + lane]); const float ss = wave_sum(x * x);
            zr[off + lane] = f2bf(x * rsqrtf(ss * (1.f / 64.f) + 1e-6f) * g[layer * 64 + lane]);
        }
    }
}

__device__ void ph_A(const Ids& id, const Params& p, float* lds) {
    const bf16* Z = (const bf16*)(p.ws + WS_Z); bf16* YA = (bf16*)(p.ws + WS_YA);
    float* s_iq = lds; float* s_iw = lds + 256; float* s_q = lds + 264; float* s_sc = lds + 776; int* s_sel = (int*)(lds + 2824); float* s_lg = lds + 3080;
    const int tid = id.tid, lane = tid & 63, wave = tid >> 6;
    for (int tok = id.bid; tok < NTOK; tok += gridDim.x) {
        const int b = tok >> 11, t = tok & 2047, limit = ((t >> 6) + 1) << 6;
        const bf16* zr = Z + (size_t)tok * ZC; const bf16* zb = Z + (size_t)b * SEQ * ZC;
        if (tid < 256) s_iq[tid] = bf2f(zr[Z_IQ + tid]);
        if (tid < 4) s_iw[tid] = bf2f(zr[Z_IW + tid]);
        s_q[tid] = bf2f(zr[Z_AQ + tid]);
        __syncthreads();
        for (int s = tid; s < limit; s += NTHR) {
            const uint4* kr = (const uint4*)(zb + (size_t)s * ZC + Z_IK);
            float d0 = 0.f, d1 = 0.f, d2 = 0.f, d3 = 0.f;
#pragma unroll 1
            for (int c = 0; c < 8; ++c) { float kv[8]; unpack8(kr[c], kv);
#pragma unroll
                for (int e = 0; e < 8; ++e) { const int d = c * 8 + e; d0 += s_iq[d] * kv[e]; d1 += s_iq[64 + d] * kv[e]; d2 += s_iq[128 + d] * kv[e]; d3 += s_iq[192 + d] * kv[e]; } }
            s_sc[s] = s_iw[0] * fmaxf(d0, 0.f) + s_iw[1] * fmaxf(d1, 0.f) + s_iw[2] * fmaxf(d2, 0.f) + s_iw[3] * fmaxf(d3, 0.f);
        }
        __syncthreads();
        int nk;
        if (limit <= 256) { nk = limit; if (tid < limit) s_sel[tid] = tid; }
        else { nk = 256;
            for (int s = tid; s < limit; s += NTHR) { const float v = s_sc[s]; int rank = 0;
                for (int j = 0; j < limit; ++j) { const float u = s_sc[j]; rank += (u > v || (u == v && j < s)) ? 1 : 0; }
                if (rank < 256) s_sel[rank] = s; } }
        __syncthreads();
        for (int idx = tid; idx < 2048; idx += NTHR) { const int h = idx >> 8, j = idx & 255;
            if (j < nk) { const uint4* kr = (const uint4*)(zb + (size_t)s_sel[j] * ZC + Z_AK); float dot = 0.f;
#pragma unroll 1
                for (int c = 0; c < 8; ++c) { float kv[8]; unpack8(kr[c], kv);
#pragma unroll
                    for (int e = 0; e < 8; ++e) dot += s_q[h * 64 + c * 8 + e] * kv[e]; }
                s_lg[idx] = dot * 0.125f; } }
        __syncthreads();
        { float* lg = s_lg + wave * 256; float m = -INFINITY;
          for (int j = lane; j < nk; j += 64) m = fmaxf(m, lg[j]);
          m = wave_max(m); float sum = 0.f;
          for (int j = lane; j < nk; j += 64) { const float e = expf(lg[j] - m); lg[j] = e; sum += e; }
          sum = wave_sum(sum); const float inv = 1.f / sum;
          for (int j = lane; j < nk; j += 64) lg[j] *= inv; }
        __syncthreads();
        { const int h = tid >> 6, d = tid & 63; float acc = 0.f;
          for (int j = 0; j < nk; ++j) acc += s_lg[h * 256 + j] * bf2f(zb[(size_t)s_sel[j] * ZC + Z_AV + d]);
          YA[(size_t)tok * 512 + tid] = f2bf(acc); }
        __syncthreads();
    }
}

__device__ void ph_B(const Ids& id, const Params& p, float* lds) {
    const bf16* Z = (const bf16*)(p.ws + WS_Z); bf16* YB = (bf16*)(p.ws + WS_YB);
    const int tid = id.tid, lane = tid & 63, wave = tid >> 6;
    float* s_q = lds + wave * 64;
    for (int tok = id.bid; tok < NTOK; tok += gridDim.x) {
        const int b = tok >> 11, t = tok & 2047;
        const bf16* zr = Z + (size_t)tok * ZC; const bf16* zb = Z + (size_t)b * SEQ * ZC;
        s_q[lane] = bf2f(zr[Z_BQ + wave * 64 + lane]);
        __syncthreads();
        float acc = 0.f, carry = 0.f;
        for (int shi = t - 1; shi >= 0; shi -= 64) {
            const int s = shi - lane; const bool valid = s >= 0; const int sc = valid ? s : 0;
            const uint4* kr = (const uint4*)(zb + (size_t)sc * ZC + Z_BK + wave * 64);
            float dot = 0.f;
#pragma unroll
            for (int c = 0; c < 8; ++c) { float kv[8]; unpack8(kr[c], kv);
#pragma unroll
                for (int e = 0; e < 8; ++e) dot += s_q[c * 8 + e] * kv[e]; }
            const float zz = dot * 0.125f;
            const float lk = valid ? logsig(-zz) : 0.f, lb = logsig(zz);
            float incl = lk;
#pragma unroll
            for (int off = 1; off < 64; off <<= 1) { const float y = __shfl_up(incl, off); if (lane >= off) incl += y; }
            const float later = carry + incl - lk;
            const float a = valid ? expf(lb + later) : 0.f;
            carry += __shfl(incl, 63);
            const int cnt = (shi + 1 < 64) ? shi + 1 : 64;
            for (int l2 = 0; l2 < cnt; ++l2) { const float al = __shfl(a, l2); acc += al * bf2f(zb[(size_t)(shi - l2) * ZC + Z_BV + wave * 64 + lane]); }
        }
        YB[(size_t)tok * 512 + wave * 64 + lane] = f2bf(acc);
        __syncthreads();
    }
}

__device__ void ph_C(const Ids& id, const Params& p, int layer, float* lds) {
    const bf16* Z = (const bf16*)(p.ws + WS_Z); float* OR = (float*)(p.ws + WS_CRAW);
    float* s_al = lds; float* s_k = lds + 1024; float* s_q = lds + 2048; float* s_wa = lds + 3072; float* s_ba = lds + 4096;
    const float* wal = p.c_w_alpha + layer * 16 * 256; const float* bal = p.c_b_alpha + layer * 256;
    const int tid = id.tid;
    for (int item = id.bid; item < 64; item += gridDim.x) {
        const int b = item >> 2, h = item & 3; const bf16* zb = Z + (size_t)b * SEQ * ZC;
        for (int i = tid; i < 1024; i += NTHR) { const int r = i >> 6, k = i & 63; s_wa[i] = wal[r * 256 + h * 64 + k]; }
        if (tid < 64) s_ba[tid] = bal[h * 64 + tid];
        float S[64];
#pragma unroll
        for (int k = 0; k < 64; ++k) S[k] = 0.f;
        __syncthreads();
        for (int t0 = 0; t0 < SEQ; t0 += 16) {
            for (int i = tid; i < 1024; i += NTHR) { const int st = i >> 6, k = i & 63; const bf16* zr = zb + (size_t)(t0 + st) * ZC;
                float x = s_ba[k];
#pragma unroll
                for (int r = 0; r < 16; ++r) x += bf2f(zr[Z_CA + r]) * s_wa[r * 64 + k];
                s_al[i] = expf(logsig(x) * (1.f / 16.f));
                s_k[i] = bf2f(zr[Z_CK + h * 64 + k]); s_q[i] = bf2f(zr[Z_CQ + h * 64 + k]) * 0.125f; }
            __syncthreads();
            if (tid < 128) {
                for (int st = 0; st < 16; ++st) {
                    const float vv = bf2f(zb[(size_t)(t0 + st) * ZC + Z_CV + h * 128 + tid]);
                    float o = 0.f;
#pragma unroll
                    for (int k = 0; k < 64; ++k) { S[k] = s_al[st * 64 + k] * S[k] + s_k[st * 64 + k] * vv; o += s_q[st * 64 + k] * S[k]; }
                    OR[(size_t)(b * SEQ + t0 + st) * 512 + h * 128 + tid] = o;
                }
            }
            __syncthreads();
        }
    }
}
__device__ void ph_Cpost(const Ids& id, const Params& p, int layer) {
    const bf16* Z = (const bf16*)(p.ws + WS_Z); const float* OR = (const float*)(p.ws + WS_CRAW); bf16* YC = (bf16*)(p.ws + WS_YC);
    const int lane = id.tid & 63, wave = id.tid >> 6;
    for (int idx = id.bid * 8 + wave; idx < NTOK * 4; idx += gridDim.x * 8) {
        const int tok = idx >> 2, h = idx & 3;
        const float o0 = OR[(size_t)tok * 512 + h * 128 + lane], o1 = OR[(size_t)tok * 512 + h * 128 + 64 + lane];
        const float ss = wave_sum(o0 * o0 + o1 * o1); const float r = rsqrtf(ss * (1.f / 128.f) + 1e-6f);
        const float g0 = p.c_on_g[layer * 512 + h * 128 + lane], g1 = p.c_on_g[layer * 512 + h * 128 + 64 + lane];
        const float r0 = bf2f(Z[(size_t)tok * ZC + Z_CR + h * 128 + lane]), r1 = bf2f(Z[(size_t)tok * ZC + Z_CR + h * 128 + 64 + lane]);
        YC[(size_t)tok * 512 + h * 128 + lane] = f2bf(o0 * r * g0 * (r0 / (1.f + expf(-r0))));
        YC[(size_t)tok * 512 + h * 128 + 64 + lane] = f2bf(o1 * r * g1 * (r1 / (1.f + expf(-r1))));
    }
}

__device__ void ph_peersel(const Ids& id, const Params& p, int layer, float* lds) {
    const bf16* PQ = (const bf16*)(p.ws + WS_PQ); int* PE = (int*)(p.ws + WS_PE); float* PG = (float*)(p.ws + WS_PG);
    const float* SK = p.peer_subkeys + (size_t)layer * 8 * 2 * 128 * 128;
    float* s_q = lds; float* s_sc = lds + 2048; float* s_ts = lds + 4096; int* s_ti = (int*)(lds + 4352); float* s_bs = lds + 4608; int* s_be = (int*)(lds + 4736);
    const int tid = id.tid;
    for (int tok = id.bid; tok < NTOK; tok += gridDim.x) {
        for (int i = tid; i < 2048; i += NTHR) s_q[i] = bf2f(PQ[(size_t)tok * 2048 + i]);
        __syncthreads();
        for (int idx = tid; idx < 2048; idx += NTHR) { const int list = idx >> 7;
            const float4* kr = (const float4*)(SK + (size_t)idx * 128); const float* q = s_q + list * 128; float dot = 0.f;
            for (int c = 0; c < 32; ++c) { const float4 kv = kr[c]; dot += q[c * 4] * kv.x + q[c * 4 + 1] * kv.y + q[c * 4 + 2] * kv.z + q[c * 4 + 3] * kv.w; }
            s_sc[idx] = dot; }
        __syncthreads();
        for (int idx = tid; idx < 2048; idx += NTHR) { const int list = idx >> 7, i = idx & 127; const float v = s_sc[idx]; int rank = 0;
            for (int j = 0; j < 128; ++j) { const float u = s_sc[list * 128 + j]; rank += (u > v || (u == v && j < i)) ? 1 : 0; }
            if (rank < 16) { s_ts[list * 16 + rank] = v; s_ti[list * 16 + rank] = i; } }
        __syncthreads();
        for (int idx = tid; idx < 2048; idx += NTHR) { const int h = idx >> 8, a = (idx >> 4) & 15, b = idx & 15;
            s_sc[idx] = s_ts[(2 * h) * 16 + a] + s_ts[(2 * h + 1) * 16 + b]; }
        __syncthreads();
        for (int idx = tid; idx < 2048; idx += NTHR) { const int h = idx >> 8, i = idx & 255; const float v = s_sc[idx]; int rank = 0;
            for (int j = 0; j < 256; ++j) { const float u = s_sc[h * 256 + j]; rank += (u > v || (u == v && j < i)) ? 1 : 0; }
            if (rank < 16) { s_bs[h * 16 + rank] = v; s_be[h * 16 + rank] = s_ti[(2 * h) * 16 + (i >> 4)] * 128 + s_ti[(2 * h + 1) * 16 + (i & 15)]; } }
        __syncthreads();
        if (tid < 128) { const int h = tid >> 4; const float m = s_bs[h * 16]; float sum = 0.f;
            for (int k = 0; k < 16; ++k) sum += expf(s_bs[h * 16 + k] - m);
            PG[(size_t)tok * 128 + tid] = expf(s_bs[tid] - m) / sum; PE[(size_t)tok * 128 + tid] = s_be[tid]; }
        __syncthreads();
    }
}
__device__ void ph_peerexp(const Ids& id, const Params& p, int layer, float* lds) {
    const bf16* N = (const bf16*)(p.ws + WS_N); const int* PE = (const int*)(p.ws + WS_PE); const float* PG = (const float*)(p.ws + WS_PG);
    const float* U = p.peer_u + (size_t)layer * 16384 * 1024; const float* V = p.peer_v + (size_t)layer * 16384 * 1024;
    const float* mod = (const float*)(p.ws + WS_MOD) + (size_t)layer * 16 * 6144;
    float* s_x = lds; float* s_w = lds + 1024; int* s_e = (int*)(lds + 1152);
    const int tid = id.tid, lane = tid & 63, wave = tid >> 6;
    for (int tok = id.bid; tok < NTOK; tok += gridDim.x) {
        const int b = tok >> 11;
        for (int i = tid; i < 1024; i += NTHR) s_x[i] = bf2f(N[(size_t)tok * 1024 + i]);
        if (tid < 128) s_e[tid] = PE[(size_t)tok * 128 + tid];
        __syncthreads();
        for (int i = 0; i < 16; ++i) { const int slot = wave * 16 + i; const int e = s_e[slot];
            const float4* ur = (const float4*)(U + (size_t)e * 1024); float dot = 0.f;
#pragma unroll
            for (int j = 0; j < 4; ++j) { const float4 uv = ur[lane + 64 * j]; const float* xx = s_x + (lane + 64 * j) * 4; dot += xx[0] * uv.x + xx[1] * uv.y + xx[2] * uv.z + xx[3] * uv.w; }
            dot = wave_sum(dot);
            const float act = 0.5f * dot * (1.f + erff(dot * 0.70710678118654752f));
            if (lane == 0) s_w[slot] = PG[(size_t)tok * 128 + slot] * act; }
        __syncthreads();
        { float a0 = 0.f, a1 = 0.f;
          for (int j = 0; j < 128; ++j) { const float2 vv = *(const float2*)(V + (size_t)s_e[j] * 1024 + tid * 2); const float w = s_w[j]; a0 += w * vv.x; a1 += w * vv.y; }
          const float2 g = *(const float2*)(mod + (size_t)b * 6144 + 5 * 1024 + tid * 2);
          float2* o = (float2*)(p.out + (size_t)tok * 1024 + tid * 2); float2 hv = *o; hv.x += g.x * a0; hv.y += g.y * a1; *o = hv; }
        __syncthreads();
    }
}

constexpr int PH_PER_LAYER = 16;

template <int Q>
__device__ __forceinline__ void run_phase(const Params& p, int layer, float* lds) {
    Ids id; id.tid = threadIdx.x; id.bid = blockIdx.x;
    if constexpr (Q < 0) { ph_mod(id, p, lds); return; }
    unsigned char* ws = p.ws;
    bf16* N = (bf16*)(ws + WS_N); bf16* Z = (bf16*)(ws + WS_Z);
    const float* mod = (const float*)(ws + WS_MOD) + (size_t)layer * 16 * 6144;
    const float* win = p.w_in + (size_t)layer * 1024 * INC;
    float* T = (float*)(ws + WS_T); float* M = (float*)(ws + WS_M); bf16* MG = (bf16*)(ws + WS_MERGED);
    if constexpr (Q == 0) ph_norm(id, p, layer, 0);
    if constexpr (Q == 1) gemm_naive<true>(id, N, 1024, win, INC, 4052, 1024, EpiBf{Z, ZC, 0}, lds);
    if constexpr (Q == 2) ph_qknorm(id, p, layer);
    if constexpr (Q == 3) { ph_A(id, p, lds); ph_B(id, p, lds); ph_C(id, p, layer, lds); }
    if constexpr (Q == 4) ph_Cpost(id, p, layer);
    if constexpr (Q == 5) gemm_naive<false>(id, (const bf16*)(ws + WS_YA), 512, p.w_oa + (size_t)layer * 512 * 1024, 1024, 1024, 512, EpiF32{T}, lds);
    if constexpr (Q == 6) gemm_naive<false>(id, N, 1024, win + 4052, INC, 1024, 1024, EpiGate{T, M, p.b_gate + layer * 3072, MG, 0}, lds);
    if constexpr (Q == 7) gemm_naive<false>(id, (const bf16*)(ws + WS_YB), 512, p.w_ob + (size_t)layer * 512 * 1024, 1024, 1024, 512, EpiF32{T}, lds);
    if constexpr (Q == 8) gemm_naive<false>(id, N, 1024, win + 4052 + 1024, INC, 1024, 1024, EpiGate{T, M, p.b_gate + layer * 3072 + 1024, MG, 1}, lds);
    if constexpr (Q == 9) gemm_naive<false>(id, (const bf16*)(ws + WS_YC), 512, p.w_oc + (size_t)layer * 512 * 1024, 1024, 1024, 512, EpiF32{T}, lds);
    if constexpr (Q == 10) gemm_naive<false>(id, N, 1024, win + 4052 + 2048, INC, 1024, 1024, EpiGate{T, M, p.b_gate + layer * 3072 + 2048, MG, 2}, lds);
    if constexpr (Q == 11) gemm_naive<false>(id, MG, 1024, p.w_out + (size_t)layer * 1024 * 1024, 1024, 1024, 1024, EpiRes{layer == 0 ? p.x : p.out, p.out, mod + 2 * 1024}, lds);
    if constexpr (Q == 12) ph_norm(id, p, layer, 1);
    if constexpr (Q == 13) gemm_naive<false>(id, N, 1024, p.peer_wq + (size_t)layer * 1024 * 2048, 2048, 2048, 1024, EpiBf{(bf16*)(ws + WS_PQ), 2048, 0}, lds);
    if constexpr (Q == 14) ph_peersel(id, p, layer, lds);
    if constexpr (Q == 15) ph_peerexp(id, p, layer, lds);
}

#if MK_COOP
#define GSYNC() cg::this_grid().sync()
template <int Q> __device__ __forceinline__ void layer_phases(const Params& p, int layer, float* lds) {
    run_phase<Q>(p, layer, lds);
    if constexpr (Q + 1 < PH_PER_LAYER) { GSYNC(); layer_phases<Q + 1>(p, layer, lds); }
}
__global__ void __launch_bounds__(NTHR, 2) k_mega(Params p) {
    extern __shared__ __attribute__((aligned(16))) unsigned char lds_raw[];
    float* lds = (float*)lds_raw;
    run_phase<-1>(p, 0, lds); GSYNC();
    layer_phases<0>(p, 0, lds); GSYNC();
    layer_phases<0>(p, 1, lds);
}
#else
template <int Q> __global__ void __launch_bounds__(NTHR, 2) k_phase(Params p) {
    extern __shared__ __attribute__((aligned(16))) unsigned char lds_raw[];
    run_phase<Q>(p, p.ph_lo, (float*)lds_raw);
}
template <int Q> static void launch_phase(Params p, int layer, int grid, hipStream_t stream) {
    static bool attr = false;
    if (!attr) { (void)hipFuncSetAttribute((const void*)k_phase<Q>, hipFuncAttributeMaxDynamicSharedMemorySize, LDS_BYTES); attr = true; }
    p.ph_lo = layer; p.ph_hi = 0;
    hipLaunchKernelGGL(k_phase<Q>, dim3(grid), dim3(NTHR), LDS_BYTES, stream, p);
}
template <int Q> static void launch_layer(const Params& p, int layer, int grid, hipStream_t stream) {
    launch_phase<Q>(p, layer, grid, stream);
    if constexpr (Q + 1 < PH_PER_LAYER) launch_layer<Q + 1>(p, layer, grid, stream);
}
#endif

extern "C" void kernel_launch(void* const* d_in, const int* in_sizes, int n_in, void* d_out, int out_size, void* d_ws, size_t ws_size, hipStream_t stream) {
    static int grid = 0;
    if (grid == 0) {
        if (n_in != 23 || out_size != NTOK * D || ws_size < WS_END) { fprintf(stderr, "kernel_launch: unexpected problem: n_in %d out %d ws %zu (need %zu)\n", n_in, out_size, ws_size, (size_t)WS_END); grid = -1; return; }
        int dev = 0, cus = 0;
        (void)hipGetDevice(&dev); (void)hipDeviceGetAttribute(&cus, hipDeviceAttributeMultiprocessorCount, dev);
#if MK_COOP
        int per_cu = 0;
        if (hipFuncSetAttribute((const void*)k_mega, hipFuncAttributeMaxDynamicSharedMemorySize, LDS_BYTES) != hipSuccess) { fprintf(stderr, "hipFuncSetAttribute failed\n"); grid = -1; return; }
        if (hipOccupancyMaxActiveBlocksPerMultiprocessor(&per_cu, (const void*)k_mega, NTHR, LDS_BYTES) != hipSuccess || per_cu < 1) { fprintf(stderr, "occupancy query: %d\n", per_cu); per_cu = 1; }
        (void)hipGetLastError();
        grid = cus * per_cu;
#else
        grid = cus;
#endif
        fprintf(stderr, "kernel_launch: grid %d (cus %d), ws %zu\n", grid, cus, ws_size);
    }
    if (grid < 0) return;
    Params p{};
    const float** pp = (const float**)&p;
    for (int i = 0; i < 23; ++i) pp[i] = (const float*)d_in[i];
    p.out = (float*)d_out; p.ws = (unsigned char*)d_ws;
#if MK_COOP
    void* args[] = {&p};
    hipError_t e = hipLaunchCooperativeKernel((const void*)k_mega, dim3(grid), dim3(NTHR), args, LDS_BYTES, stream);
    if (e != hipSuccess) fprintf(stderr, "cooperative launch failed: %s (grid %d)\n", hipGetErrorString(e), grid);
#else
    launch_phase<-1>(p, 0, grid, stream);
    launch_layer<0>(p, 0, grid, stream);
    launch_layer<0>(p, 1, grid, stream);
#endif
}
```

```cpp
#include <hip/hip_runtime.h>
#include <hip/hip_cooperative_groups.h>
#include <cstdio>
#include <cstdint>
namespace cg = cooperative_groups;

#ifndef MK_COOP
#define MK_COOP 1
#endif

typedef unsigned short bf16;

constexpr int D = 1024, BATCH = 16, SEQ = 2048, DEPTH = 2, NTOK = BATCH * SEQ;
constexpr int INC = 7124;
constexpr int ZC = 4096;
constexpr int Z_AQ = 0, Z_AK = 512, Z_AV = 576, Z_IQ = 640, Z_IK = 896, Z_BQ = 960, Z_BK = 1472, Z_BV = 1984,
              Z_CQ = 2496, Z_CK = 2752, Z_CV = 3008, Z_CR = 3520, Z_IW = 4032, Z_CA = 4036;
constexpr int NTHR = 512;
constexpr int LDS_BYTES = 147456;

constexpr size_t MiB = 1u << 20;
constexpr size_t WS_CTL = 0;
constexpr size_t WS_MOD = 1 * MiB;
constexpr size_t WS_WIN_T = 2 * MiB;
constexpr size_t WS_WG_T = 10 * MiB;
constexpr size_t WS_WOA_T = 16 * MiB, WS_WOB_T = 17 * MiB, WS_WOC_T = 18 * MiB;
constexpr size_t WS_WOUT_T = 19 * MiB;
constexpr size_t WS_WPQ_T = 21 * MiB;
constexpr size_t WS_SKB = 25 * MiB;
constexpr size_t WS_N = 28 * MiB;
constexpr size_t WS_YA = 92 * MiB, WS_YB = 124 * MiB, WS_YC = 156 * MiB;
constexpr size_t WS_Z = 188 * MiB;
constexpr size_t WS_G = WS_Z;
constexpr size_t WS_M = 380 * MiB;
constexpr size_t WS_PQ = WS_Z;
constexpr size_t WS_PE = WS_Z + 128 * MiB;
constexpr size_t WS_PG = WS_Z + 144 * MiB;
constexpr size_t WS_CRAW = 452 * MiB;
constexpr size_t WS_END = 516 * MiB;
constexpr size_t WS_QKG = WS_CTL + 131072;
constexpr size_t WS_HM = WS_YA;

struct Ids { int tid, bid; };
struct Params {
    const float *x, *c, *norm1_g, *norm2_g, *w_mod, *b_mod, *w_in, *b_gate, *a_qn_g, *a_kn_g, *b_qn_g, *b_kn_g,
                *c_w_alpha, *c_b_alpha, *c_on_g, *w_oa, *w_ob, *w_oc, *w_out, *peer_wq, *peer_subkeys, *peer_u, *peer_v;
    float* out; unsigned char* ws;
    int ph_lo, ph_hi;
};

__device__ __forceinline__ float bf2f(bf16 v) { return __uint_as_float(((unsigned)v) << 16); }
__device__ __forceinline__ bf16 f2bf(float f) { unsigned u = __float_as_uint(f); return (bf16)((u + 0x7fffu + ((u >> 16) & 1u)) >> 16); }
__device__ __forceinline__ unsigned cvt_pk(float lo, float hi) { typedef float f2 __attribute__((ext_vector_type(2))); typedef __bf16 b2 __attribute__((ext_vector_type(2))); f2 v = {lo, hi}; b2 b = __builtin_convertvector(v, b2); return __builtin_bit_cast(unsigned, b); }
__device__ __forceinline__ float wave_sum(float v) {
#pragma unroll
    for (int o = 1; o < 64; o <<= 1) v += __shfl_xor(v, o);
    return v;
}
__device__ __forceinline__ float wave_max(float v) {
#pragma unroll
    for (int o = 1; o < 64; o <<= 1) v = fmaxf(v, __shfl_xor(v, o));
    return v;
}
__device__ __forceinline__ float logsig(float x) { return fminf(x, 0.f) - log1pf(expf(-fabsf(x))); }
__device__ __forceinline__ void unpack8(uint4 u, float* f) {
    f[0] = __uint_as_float(u.x << 16); f[1] = __uint_as_float(u.x & 0xffff0000u);
    f[2] = __uint_as_float(u.y << 16); f[3] = __uint_as_float(u.y & 0xffff0000u);
    f[4] = __uint_as_float(u.z << 16); f[5] = __uint_as_float(u.z & 0xffff0000u);
    f[6] = __uint_as_float(u.w << 16); f[7] = __uint_as_float(u.w & 0xffff0000u);
}

__device__ __forceinline__ void ph_mod(const Ids& id, const Params& p, float* lds) {
    float* s_c = lds; float* s_red = lds + 16384;
    const int tid = id.tid;
    for (int i = tid; i < 16384; i += NTHR) { float v = p.c[i]; s_c[i] = v / (1.f + expf(-v)); }
    __syncthreads();
    float* mod = (float*)(p.ws + WS_MOD);
    const int j = tid & 63, ks = tid >> 6;
    for (int item = id.bid; item < 2 * 96; item += gridDim.x) {
        const int l = item / 96, jt = item % 96, col = jt * 64 + j;
        const float* w = p.w_mod + (size_t)l * 1024 * 6144 + col;
        float acc[16];
#pragma unroll
        for (int b = 0; b < 16; ++b) acc[b] = 0.f;
        for (int k = ks * 128; k < ks * 128 + 128; ++k) {
            const float wv = w[(size_t)k * 6144];
#pragma unroll
            for (int b = 0; b < 16; ++b) acc[b] += s_c[b * 1024 + k] * wv;
        }
#pragma unroll
        for (int b = 0; b < 16; ++b) s_red[(ks * 64 + j) * 16 + b] = acc[b];
        __syncthreads();
        for (int o = tid; o < 1024; o += NTHR) {
            const int jj = o & 63, b = o >> 6; float s = 0.f;
            for (int q = 0; q < 8; ++q) s += s_red[(q * 64 + jj) * 16 + b];
            const int c2 = jt * 64 + jj;
            mod[((size_t)l * 16 + b) * 6144 + c2] = s + p.b_mod[l * 6144 + c2];
        }
        __syncthreads();
    }
}

__device__ __forceinline__ void ph_norm(const Ids& id, const Params& p, int layer, int which) {
    const float* g = (which == 0 ? p.norm1_g : p.norm2_g) + layer * 1024;
    const float* mod = (const float*)(p.ws + WS_MOD) + (size_t)layer * 16 * 6144;
    bf16* N = (bf16*)(p.ws + WS_N);
    const int lane = id.tid & 63, wave = __builtin_amdgcn_readfirstlane(id.tid >> 6);
    if (which == 0 && layer == 0) {
    const float* hin = p.x;
    for (int tok = id.bid * 8 + wave; tok < NTOK; tok += gridDim.x * 8) {
        const int b = tok >> 11;
        const float* shift = mod + b * 6144 + (which ? 3 : 0) * 1024; const float* scale = shift + 1024;
        const float4* hr = (const float4*)(hin + (size_t)tok * 1024);
        float4 v[4]; float ss = 0.f;
#pragma unroll
        for (int j = 0; j < 4; ++j) { v[j] = hr[lane + 64 * j]; ss += v[j].x * v[j].x + v[j].y * v[j].y + v[j].z * v[j].z + v[j].w * v[j].w; }
        ss = wave_sum(ss);
        const float r = rsqrtf(ss * (1.f / 1024.f) + 1e-6f);
#pragma unroll
        for (int j = 0; j < 4; ++j) {
            const int c = (lane + 64 * j) * 4;
            const float4 gg = *(const float4*)(g + c), sc = *(const float4*)(scale + c), sh = *(const float4*)(shift + c);
            const float o0 = v[j].x * r * gg.x * (1.f + sc.x) + sh.x, o1 = v[j].y * r * gg.y * (1.f + sc.y) + sh.y;
            const float o2 = v[j].z * r * gg.z * (1.f + sc.z) + sh.z, o3 = v[j].w * r * gg.w * (1.f + sc.w) + sh.w;
            uint2 pk; pk.x = (unsigned)f2bf(o0) | ((unsigned)f2bf(o1) << 16); pk.y = (unsigned)f2bf(o2) | ((unsigned)f2bf(o3) << 16);
            *(uint2*)(N + (size_t)tok * 1024 + c) = pk;
        }
    }
    } else {
    const bf16* hin = which ? (const bf16*)(p.ws + WS_HM) : (const bf16*)p.out;
    for (int tok = id.bid * 8 + wave; tok < NTOK; tok += gridDim.x * 8) {
        const int b = tok >> 11;
        const float* shift = mod + b * 6144 + (which ? 3 : 0) * 1024; const float* scale = shift + 1024;
        const uint4* hr = (const uint4*)(hin + (size_t)tok * 1024);
        float v[2][8]; float ss = 0.f;
#pragma unroll
        for (int j = 0; j < 2; ++j) { unpack8(hr[lane + 64 * j], v[j]);
#pragma unroll
            for (int i = 0; i < 8; ++i) ss += v[j][i] * v[j][i]; }
        ss = wave_sum(ss);
        const float r = rsqrtf(ss * (1.f / 1024.f) + 1e-6f);
#pragma unroll
        for (int j = 0; j < 2; ++j) {
            const int c = (lane + 64 * j) * 8; float o[8];
#pragma unroll
            for (int q = 0; q < 2; ++q) { const float4 gg = *(const float4*)(g + c + 4 * q), sc = *(const float4*)(scale + c + 4 * q), sh = *(const float4*)(shift + c + 4 * q);
                o[4 * q] = v[j][4 * q] * r * gg.x * (1.f + sc.x) + sh.x; o[4 * q + 1] = v[j][4 * q + 1] * r * gg.y * (1.f + sc.y) + sh.y;
                o[4 * q + 2] = v[j][4 * q + 2] * r * gg.z * (1.f + sc.z) + sh.z; o[4 * q + 3] = v[j][4 * q + 3] * r * gg.w * (1.f + sc.w) + sh.w; }
            uint4 pk; pk.x = (unsigned)f2bf(o[0]) | ((unsigned)f2bf(o[1]) << 16); pk.y = (unsigned)f2bf(o[2]) | ((unsigned)f2bf(o[3]) << 16);
            pk.z = (unsigned)f2bf(o[4]) | ((unsigned)f2bf(o[5]) << 16); pk.w = (unsigned)f2bf(o[6]) | ((unsigned)f2bf(o[7]) << 16);
            *(uint4*)(N + (size_t)tok * 1024 + c) = pk;
        }
    }
    }
}

__device__ __forceinline__ int inproj_src_col(int n) { return n < 960 ? n : (n < 4032 ? n + 4 : (n < 4036 ? n - 4032 + 960 : n)); }
template <bool MAP, class Epi>
__device__ void gemm_naive(const Ids& id, const bf16* A, int lda, const float* W, int ldb, int N, int K, const Epi& epi, float* lds) {
    float* As = lds;
    float* Bs = lds + 16 * 132;
    const int tid = id.tid, tx = tid & 31, ty = tid >> 5;
    const int ntn = (N + 127) / 128, ntm = NTOK / 128;
    for (int tile = id.bid; tile < ntm * ntn; tile += gridDim.x) {
        const int tm = tile / ntn, tn = tile % ntn, m0 = tm * 128, n0 = tn * 128;
        float acc[8][4];
#pragma unroll
        for (int i = 0; i < 8; ++i)
#pragma unroll
            for (int j = 0; j < 4; ++j) acc[i][j] = 0.f;
        for (int k0 = 0; k0 < K; k0 += 16) {
            {
                const int row = tid >> 2, kq = (tid & 3) * 4;
                const uint2 raw = *(const uint2*)(A + (size_t)(m0 + row) * lda + k0 + kq);
                As[(kq + 0) * 132 + row] = __uint_as_float(raw.x << 16);
                As[(kq + 1) * 132 + row] = __uint_as_float(raw.x & 0xffff0000u);
                As[(kq + 2) * 132 + row] = __uint_as_float(raw.y << 16);
                As[(kq + 3) * 132 + row] = __uint_as_float(raw.y & 0xffff0000u);
            }
            {
                const int k = tid >> 5, nq = (tid & 31) * 4;
                float4 v = make_float4(0.f, 0.f, 0.f, 0.f);
                if (n0 + nq < N) v = *(const float4*)(W + (size_t)(k0 + k) * ldb + (MAP ? inproj_src_col(n0 + nq) : n0 + nq));
                *(float4*)(Bs + k * 128 + nq) = v;
            }
            __syncthreads();
#pragma unroll
            for (int kk = 0; kk < 16; ++kk) {
                const float4 a0 = *(const float4*)(As + kk * 132 + ty * 8), a1 = *(const float4*)(As + kk * 132 + ty * 8 + 4);
                const float4 bb = *(const float4*)(Bs + kk * 128 + tx * 4);
                const float a[8] = {a0.x, a0.y, a0.z, a0.w, a1.x, a1.y, a1.z, a1.w};
                const float b[4] = {bb.x, bb.y, bb.z, bb.w};
#pragma unroll
                for (int i = 0; i < 8; ++i)
#pragma unroll
                    for (int j = 0; j < 4; ++j) acc[i][j] += a[i] * b[j];
            }
            __syncthreads();
        }
        const int n = n0 + tx * 4;
        if (n < N) {
#pragma unroll
            for (int i = 0; i < 8; ++i) epi(m0 + ty * 8 + i, n, acc[i][0], acc[i][1], acc[i][2], acc[i][3]);
        }
    }
}

struct EpiBf { bf16* O; int ldo; int dcol0;
    __device__ __forceinline__ void operator()(int m, int n, float v0, float v1, float v2, float v3) const {
        uint2 pk; pk.x = (unsigned)f2bf(v0) | ((unsigned)f2bf(v1) << 16); pk.y = (unsigned)f2bf(v2) | ((unsigned)f2bf(v3) << 16);
        *(uint2*)(O + (size_t)m * ldo + dcol0 + n) = pk; } };
struct EpiF32 { float* T;
    __device__ __forceinline__ void operator()(int m, int n, float v0, float v1, float v2, float v3) const {
        *(float4*)(T + (size_t)m * 1024 + n) = make_float4(v0, v1, v2, v3); } };
__device__ __forceinline__ float sigm(float x) { return 1.f / (1.f + expf(-x)); }
struct EpiGate { const float* T; float* M; const float* bias; bf16* merged; int mode;
    __device__ __forceinline__ void operator()(int m, int n, float v0, float v1, float v2, float v3) const {
        const float4 t = *(const float4*)(T + (size_t)m * 1024 + n); const float4 bb = *(const float4*)(bias + n);
        float4 r = make_float4(sigm(v0 + bb.x) * t.x, sigm(v1 + bb.y) * t.y, sigm(v2 + bb.z) * t.z, sigm(v3 + bb.w) * t.w);
        if (mode >= 1) { const float4 o = *(const float4*)(M + (size_t)m * 1024 + n); r.x += o.x; r.y += o.y; r.z += o.z; r.w += o.w; }
        if (mode <= 1) *(float4*)(M + (size_t)m * 1024 + n) = r;
        else { uint2 pk; pk.x = (unsigned)f2bf(r.x) | ((unsigned)f2bf(r.y) << 16); pk.y = (unsigned)f2bf(r.z) | ((unsigned)f2bf(r.w) << 16);
               *(uint2*)(merged + (size_t)m * 1024 + n) = pk; } } };
struct EpiRes { const float* hin; float* out; const float* gate;
    __device__ __forceinline__ void operator()(int m, int n, float v0, float v1, float v2, float v3) const {
        const int b = m >> 11; const float4 g = *(const float4*)(gate + (size_t)b * 6144 + n); const float4 h = *(const float4*)(hin + (size_t)m * 1024 + n);
        *(float4*)(out + (size_t)m * 1024 + n) = make_float4(h.x + g.x * v0, h.y + g.y * v1, h.z + g.z * v2, h.w + g.w * v3); } };


struct EpiSigBfN { bf16* G; const float* bias;
    __device__ __forceinline__ void operator()(int m, int n, float v0, float v1, float v2, float v3) const {
        const float4 bb = *(const float4*)(bias + n);
        uint2 pk; pk.x = (unsigned)f2bf(sigm(v0 + bb.x)) | ((unsigned)f2bf(sigm(v1 + bb.y)) << 16); pk.y = (unsigned)f2bf(sigm(v2 + bb.z)) | ((unsigned)f2bf(sigm(v3 + bb.w)) << 16);
        *(uint2*)(G + (size_t)m * 3072 + n) = pk; } };
struct EpiProjN { const bf16* G; float* M; bf16* MG; int mode; const float* rawbias;
    __device__ __forceinline__ void operator()(int m, int n, float v0, float v1, float v2, float v3) const {
        const uint2 gw = *(const uint2*)(G + (size_t)m * 3072 + n);
        float g0 = __uint_as_float(gw.x << 16), g1 = __uint_as_float(gw.x & 0xffff0000u), g2 = __uint_as_float(gw.y << 16), g3 = __uint_as_float(gw.y & 0xffff0000u);
        if (rawbias) { g0 = sigm(g0 + rawbias[n]); g1 = sigm(g1 + rawbias[n + 1]); g2 = sigm(g2 + rawbias[n + 2]); g3 = sigm(g3 + rawbias[n + 3]); }
        float4 r = make_float4(v0 * g0, v1 * g1, v2 * g2, v3 * g3);
        if (mode >= 1) { const float4 o = *(const float4*)(M + (size_t)m * 1024 + n); r.x += o.x; r.y += o.y; r.z += o.z; r.w += o.w; }
        if (mode <= 1) *(float4*)(M + (size_t)m * 1024 + n) = r;
        else { uint2 pk; pk.x = (unsigned)f2bf(r.x) | ((unsigned)f2bf(r.y) << 16); pk.y = (unsigned)f2bf(r.z) | ((unsigned)f2bf(r.w) << 16);
               *(uint2*)(MG + (size_t)m * 1024 + n) = pk; } } };

__device__ __forceinline__ void ph_qknorm(const Ids& id, const Params& p, int layer) {
    bf16* Z = (bf16*)(p.ws + WS_Z);
    const int lane = id.tid & 63, wave = __builtin_amdgcn_readfirstlane(id.tid >> 6), sub = lane & 7;
    float gaq[8], gak[8], gbq[8], gbk[8];
#pragma unroll
    for (int i = 0; i < 8; ++i) { gaq[i] = p.a_qn_g[layer * 64 + sub * 8 + i]; gak[i] = p.a_kn_g[layer * 64 + sub * 8 + i]; gbq[i] = p.b_qn_g[layer * 64 + sub * 8 + i]; gbk[i] = p.b_kn_g[layer * 64 + sub * 8 + i]; }
    for (int tok = id.bid * 8 + wave; tok < NTOK; tok += gridDim.x * 8) {
        bf16* zr = Z + (size_t)tok * ZC;
        uint4* p0 = (uint4*)(zr + Z_AQ + lane * 8); uint4* p1 = (uint4*)(zr + Z_AK + sub * 8); uint4* p2 = (uint4*)(zr + Z_BQ + lane * 8); uint4* p3 = (uint4*)(zr + Z_BK + lane * 8);
        const uint4 r0 = *p0, r1 = *p1, r2 = *p2, r3 = *p3;
        float v0[8], v1[8], v2[8], v3[8]; unpack8(r0, v0); unpack8(r1, v1); unpack8(r2, v2); unpack8(r3, v3);
        float s0 = 0.f, s1 = 0.f, s2 = 0.f, s3 = 0.f;
#pragma unroll
        for (int i = 0; i < 8; ++i) { s0 += v0[i] * v0[i]; s1 += v1[i] * v1[i]; s2 += v2[i] * v2[i]; s3 += v3[i] * v3[i]; }
#pragma unroll
        for (int o = 1; o < 8; o <<= 1) { s0 += __shfl_xor(s0, o); s1 += __shfl_xor(s1, o); s2 += __shfl_xor(s2, o); s3 += __shfl_xor(s3, o); }
        const float n0 = rsqrtf(s0 * (1.f / 64.f) + 1e-6f), n1 = rsqrtf(s1 * (1.f / 64.f) + 1e-6f), n2 = rsqrtf(s2 * (1.f / 64.f) + 1e-6f), n3 = rsqrtf(s3 * (1.f / 64.f) + 1e-6f);
        uint4 o0, o1, o2, o3;
        o0.x = cvt_pk(v0[0] * n0 * gaq[0], v0[1] * n0 * gaq[1]); o0.y = cvt_pk(v0[2] * n0 * gaq[2], v0[3] * n0 * gaq[3]); o0.z = cvt_pk(v0[4] * n0 * gaq[4], v0[5] * n0 * gaq[5]); o0.w = cvt_pk(v0[6] * n0 * gaq[6], v0[7] * n0 * gaq[7]);
        o1.x = cvt_pk(v1[0] * n1 * gak[0], v1[1] * n1 * gak[1]); o1.y = cvt_pk(v1[2] * n1 * gak[2], v1[3] * n1 * gak[3]); o1.z = cvt_pk(v1[4] * n1 * gak[4], v1[5] * n1 * gak[5]); o1.w = cvt_pk(v1[6] * n1 * gak[6], v1[7] * n1 * gak[7]);
        o2.x = cvt_pk(v2[0] * n2 * gbq[0], v2[1] * n2 * gbq[1]); o2.y = cvt_pk(v2[2] * n2 * gbq[2], v2[3] * n2 * gbq[3]); o2.z = cvt_pk(v2[4] * n2 * gbq[4], v2[5] * n2 * gbq[5]); o2.w = cvt_pk(v2[6] * n2 * gbq[6], v2[7] * n2 * gbq[7]);
        o3.x = cvt_pk(v3[0] * n3 * gbk[0], v3[1] * n3 * gbk[1]); o3.y = cvt_pk(v3[2] * n3 * gbk[2], v3[3] * n3 * gbk[3]); o3.z = cvt_pk(v3[4] * n3 * gbk[4], v3[5] * n3 * gbk[5]); o3.w = cvt_pk(v3[6] * n3 * gbk[6], v3[7] * n3 * gbk[7]);
        *p0 = o0; if (lane < 8) *p1 = o1; *p2 = o2; *p3 = o3;
    }
}

__device__ __forceinline__ void ph_A(const Ids& id, const Params& p, float* lds) {
    const bf16* Z = (const bf16*)(p.ws + WS_Z); bf16* YA = (bf16*)(p.ws + WS_YA);
    float* s_iq = lds; float* s_iw = lds + 256; float* s_q = lds + 264; float* s_sc = lds + 776; int* s_sel = (int*)(lds + 2824); float* s_lg = lds + 3080;
    const int tid = id.tid, lane = tid & 63, wave = tid >> 6;
    for (int tok = id.bid; tok < NTOK; tok += gridDim.x) {
        const int b = tok >> 11, t = tok & 2047, limit = ((t >> 6) + 1) << 6;
        const bf16* zr = Z + (size_t)tok * ZC; const bf16* zb = Z + (size_t)b * SEQ * ZC;
        if (tid < 256) s_iq[tid] = bf2f(zr[Z_IQ + tid]);
        if (tid < 4) s_iw[tid] = bf2f(zr[Z_IW + tid]);
        s_q[tid] = bf2f(zr[Z_AQ + tid]);
        __syncthreads();
        for (int s = tid; s < limit; s += NTHR) {
            const uint4* kr = (const uint4*)(zb + (size_t)s * ZC + Z_IK);
            float d0 = 0.f, d1 = 0.f, d2 = 0.f, d3 = 0.f;
#pragma unroll 1
            for (int c = 0; c < 8; ++c) { float kv[8]; unpack8(kr[c], kv);
#pragma unroll
                for (int e = 0; e < 8; ++e) { const int d = c * 8 + e; d0 += s_iq[d] * kv[e]; d1 += s_iq[64 + d] * kv[e]; d2 += s_iq[128 + d] * kv[e]; d3 += s_iq[192 + d] * kv[e]; } }
            s_sc[s] = s_iw[0] * fmaxf(d0, 0.f) + s_iw[1] * fmaxf(d1, 0.f) + s_iw[2] * fmaxf(d2, 0.f) + s_iw[3] * fmaxf(d3, 0.f);
        }
        __syncthreads();
        int nk;
        if (limit <= 256) { nk = limit; if (tid < limit) s_sel[tid] = tid; }
        else { nk = 256;
            for (int s = tid; s < limit; s += NTHR) { const float v = s_sc[s]; int rank = 0;
                for (int j = 0; j < limit; ++j) { const float u = s_sc[j]; rank += (u > v || (u == v && j < s)) ? 1 : 0; }
                if (rank < 256) s_sel[rank] = s; } }
        __syncthreads();
        for (int idx = tid; idx < 2048; idx += NTHR) { const int h = idx >> 8, j = idx & 255;
            if (j < nk) { const uint4* kr = (const uint4*)(zb + (size_t)s_sel[j] * ZC + Z_AK); float dot = 0.f;
#pragma unroll 1
                for (int c = 0; c < 8; ++c) { float kv[8]; unpack8(kr[c], kv);
#pragma unroll
                    for (int e = 0; e < 8; ++e) dot += s_q[h * 64 + c * 8 + e] * kv[e]; }
                s_lg[idx] = dot * 0.125f; } }
        __syncthreads();
        { float* lg = s_lg + wave * 256; float m = -INFINITY;
          for (int j = lane; j < nk; j += 64) m = fmaxf(m, lg[j]);
          m = wave_max(m); float sum = 0.f;
          for (int j = lane; j < nk; j += 64) { const float e = expf(lg[j] - m); lg[j] = e; sum += e; }
          sum = wave_sum(sum); const float inv = 1.f / sum;
          for (int j = lane; j < nk; j += 64) lg[j] *= inv; }
        __syncthreads();
        { const int h = tid >> 6, d = tid & 63; float acc = 0.f;
          for (int j = 0; j < nk; ++j) acc += s_lg[h * 256 + j] * bf2f(zb[(size_t)s_sel[j] * ZC + Z_AV + d]);
          YA[(size_t)tok * 512 + tid] = f2bf(acc); }
        __syncthreads();
    }
}

__device__ __forceinline__ void ph_B(const Ids& id, const Params& p, float* lds) {
    const bf16* Z = (const bf16*)(p.ws + WS_Z); bf16* YB = (bf16*)(p.ws + WS_YB);
    const int tid = id.tid, lane = tid & 63, wave = tid >> 6;
    float* s_q = lds + wave * 64;
    for (int tok = id.bid; tok < NTOK; tok += gridDim.x) {
        const int b = tok >> 11, t = tok & 2047;
        const bf16* zr = Z + (size_t)tok * ZC; const bf16* zb = Z + (size_t)b * SEQ * ZC;
        s_q[lane] = bf2f(zr[Z_BQ + wave * 64 + lane]);
        __syncthreads();
        float acc = 0.f, carry = 0.f;
        for (int shi = t - 1; shi >= 0; shi -= 64) {
            const int s = shi - lane; const bool valid = s >= 0; const int sc = valid ? s : 0;
            const uint4* kr = (const uint4*)(zb + (size_t)sc * ZC + Z_BK + wave * 64);
            float dot = 0.f;
#pragma unroll
            for (int c = 0; c < 8; ++c) { float kv[8]; unpack8(kr[c], kv);
#pragma unroll
                for (int e = 0; e < 8; ++e) dot += s_q[c * 8 + e] * kv[e]; }
            const float zz = dot * 0.125f;
            const float lk = valid ? logsig(-zz) : 0.f, lb = logsig(zz);
            float incl = lk;
#pragma unroll
            for (int off = 1; off < 64; off <<= 1) { const float y = __shfl_up(incl, off); if (lane >= off) incl += y; }
            const float later = carry + incl - lk;
            const float a = valid ? expf(lb + later) : 0.f;
            carry += __shfl(incl, 63);
            const int cnt = (shi + 1 < 64) ? shi + 1 : 64;
            for (int l2 = 0; l2 < cnt; ++l2) { const float al = __shfl(a, l2); acc += al * bf2f(zb[(size_t)(shi - l2) * ZC + Z_BV + wave * 64 + lane]); }
        }
        YB[(size_t)tok * 512 + wave * 64 + lane] = f2bf(acc);
        __syncthreads();
    }
}


typedef short s16x8 __attribute__((ext_vector_type(8)));
typedef short s16x4 __attribute__((ext_vector_type(4)));
typedef float f32x16 __attribute__((ext_vector_type(16)));
typedef __attribute__((address_space(3))) unsigned char lds_u8;
constexpr float SB_EXIT = 30.0f;
__device__ __forceinline__ s16x8 ldsv8(const lds_u8* p) { return *(const __attribute__((address_space(3))) s16x8*)p; }
__device__ __forceinline__ s16x4 lds_tr_read(const lds_u8* p) { return __builtin_bit_cast(s16x4, __builtin_amdgcn_ds_read_tr16_b64_v4i16((__attribute__((address_space(3))) s16x4*)p)); }
__device__ __forceinline__ void ph_B_mfma(const Ids& id, const Params& p, float* lds) {
    const bf16* Z = (const bf16*)(p.ws + WS_Z); bf16* YB = (bf16*)(p.ws + WS_YB);
    const int lane = id.tid & 63, wave = __builtin_amdgcn_readfirstlane(id.tid >> 6), r = lane & 31, hf = lane >> 5;
    lds_u8* vl = (lds_u8*)lds + wave * 4096;
    const int i16 = lane & 15;
    const lds_u8* vrd = vl + (4 * hf + (i16 >> 2)) * 128 + ((lane >> 4) & 1) * 32 + (i16 & 3) * 8;
    for (int item = id.bid; item < 1024; item += gridDim.x) {
        const int b = item >> 6, h = (item >> 3) & 7, qt = (item & 7) * 8 + wave, t0 = qt * 32;
        const bf16* zb = Z + (size_t)b * SEQ * ZC;
        s16x8 qf[4];
#pragma unroll
        for (int kk = 0; kk < 4; ++kk) qf[kk] = *(const s16x8*)(zb + (size_t)(t0 + r) * ZC + Z_BQ + h * 64 + kk * 16 + hf * 8);
        f32x16 o0, o1;
#pragma unroll
        for (int i = 0; i < 16; ++i) { o0[i] = 0.f; o1[i] = 0.f; }
        float carry = 0.f;
        for (int s0 = t0; s0 >= 0; s0 -= 32) {
            s16x8 kf[4];
#pragma unroll
            for (int kk = 0; kk < 4; ++kk) kf[kk] = *(const s16x8*)(zb + (size_t)(s0 + r) * ZC + Z_BK + h * 64 + kk * 16 + hf * 8);
#pragma unroll
            for (int i = 0; i < 4; ++i) { const int row = (lane >> 3) + 8 * i;
                typedef unsigned u4v __attribute__((ext_vector_type(4)));
                const u4v v = *(const u4v*)(zb + (size_t)(s0 + row) * ZC + Z_BV + h * 64 + (lane & 7) * 8);
                *(__attribute__((address_space(3))) u4v*)(vl + row * 128 + (lane & 7) * 16) = v; }
            f32x16 sacc;
#pragma unroll
            for (int i = 0; i < 16; ++i) sacc[i] = 0.f;
#pragma unroll
            for (int kk = 0; kk < 4; ++kk) sacc = __builtin_amdgcn_mfma_f32_32x32x16_bf16(kf[kk], qf[kk], sacc, 0, 0, 0);
            float lk[16], lb[16];
            const int tq = t0 + r;
#pragma unroll
            for (int i = 0; i < 16; ++i) { const float zz = sacc[i] * 0.125f; const int key = s0 + (i & 3) + 8 * (i >> 2) + 4 * hf;
                const float l = fminf(zz, 0.f) - __logf(1.f + __expf(-fabsf(zz)));
                lb[i] = l; lk[i] = (key < tq) ? l - zz : 0.f; }
            float gs[4], go[4], base[4];
#pragma unroll
            for (int g = 0; g < 4; ++g) { gs[g] = (lk[4 * g] + lk[4 * g + 1]) + (lk[4 * g + 2] + lk[4 * g + 3]); go[g] = __shfl_xor(gs[g], 32); }
            float run = carry;
#pragma unroll
            for (int g = 3; g >= 0; --g) { base[g] = hf ? run : run + go[g]; run += gs[g] + go[g]; }
            carry = run;
            float a[16];
#pragma unroll
            for (int g = 0; g < 4; ++g) {
                const float l3 = base[g], l2 = l3 + lk[4 * g + 3], l1 = l2 + lk[4 * g + 2], l0 = l1 + lk[4 * g + 1];
                const int key0 = s0 + 8 * g + 4 * hf;
                a[4 * g + 0] = (key0 + 0 < tq) ? __expf(lb[4 * g + 0] + l0) : 0.f;
                a[4 * g + 1] = (key0 + 1 < tq) ? __expf(lb[4 * g + 1] + l1) : 0.f;
                a[4 * g + 2] = (key0 + 2 < tq) ? __expf(lb[4 * g + 2] + l2) : 0.f;
                a[4 * g + 3] = (key0 + 3 < tq) ? __expf(lb[4 * g + 3] + l3) : 0.f;
            }
            uint4 pw0, pw1;
            pw0.x = cvt_pk(a[0], a[1]); pw0.y = cvt_pk(a[2], a[3]); pw0.z = cvt_pk(a[4], a[5]); pw0.w = cvt_pk(a[6], a[7]);
            pw1.x = cvt_pk(a[8], a[9]); pw1.y = cvt_pk(a[10], a[11]); pw1.z = cvt_pk(a[12], a[13]); pw1.w = cvt_pk(a[14], a[15]);
            const s16x8 pf0 = __builtin_bit_cast(s16x8, pw0), pf1 = __builtin_bit_cast(s16x8, pw1);
            {
                const s16x4 a00l = lds_tr_read(vrd), a00h = lds_tr_read(vrd + 1024), a01l = lds_tr_read(vrd + 2048), a01h = lds_tr_read(vrd + 2048 + 1024);
                const s16x4 a10l = lds_tr_read(vrd + 64), a10h = lds_tr_read(vrd + 64 + 1024), a11l = lds_tr_read(vrd + 64 + 2048), a11h = lds_tr_read(vrd + 64 + 2048 + 1024);
                o0 = __builtin_amdgcn_mfma_f32_32x32x16_bf16(__builtin_shufflevector(a00l, a00h, 0, 1, 2, 3, 4, 5, 6, 7), pf0, o0, 0, 0, 0);
                o0 = __builtin_amdgcn_mfma_f32_32x32x16_bf16(__builtin_shufflevector(a01l, a01h, 0, 1, 2, 3, 4, 5, 6, 7), pf1, o0, 0, 0, 0);
                o1 = __builtin_amdgcn_mfma_f32_32x32x16_bf16(__builtin_shufflevector(a10l, a10h, 0, 1, 2, 3, 4, 5, 6, 7), pf0, o1, 0, 0, 0);
                o1 = __builtin_amdgcn_mfma_f32_32x32x16_bf16(__builtin_shufflevector(a11l, a11h, 0, 1, 2, 3, 4, 5, 6, 7), pf1, o1, 0, 0, 0);
            }
            if (__all(carry < -SB_EXIT)) break;
        }
        bf16* orow = YB + (size_t)(b * SEQ + t0 + r) * 512 + h * 64 + 4 * hf;
#pragma unroll
        for (int g = 0; g < 4; ++g) {
            uint2 w0, w1; w0.x = cvt_pk(o0[4 * g], o0[4 * g + 1]); w0.y = cvt_pk(o0[4 * g + 2], o0[4 * g + 3]);
            w1.x = cvt_pk(o1[4 * g], o1[4 * g + 1]); w1.y = cvt_pk(o1[4 * g + 2], o1[4 * g + 3]);
            *(uint2*)(orow + 8 * g) = w0; *(uint2*)(orow + 32 + 8 * g) = w1;
        }
    }
    __syncthreads();
}


__device__ __forceinline__ int wave_sum_i32(int v) {
    v += __builtin_amdgcn_update_dpp(0, v, 0x128, 0xf, 0xf, true);
    v += __builtin_amdgcn_update_dpp(0, v, 0x124, 0xf, 0xf, true);
    v += __builtin_amdgcn_update_dpp(0, v, 0x122, 0xf, 0xf, true);
    v += __builtin_amdgcn_update_dpp(0, v, 0x121, 0xf, 0xf, true);
    return __builtin_amdgcn_readlane(v, 0) + __builtin_amdgcn_readlane(v, 16) + __builtin_amdgcn_readlane(v, 32) + __builtin_amdgcn_readlane(v, 48);
}
#ifndef REP_SEL
#define REP_SEL 1
#endif
#ifndef REP_ATT
#define REP_ATT 1
#endif
constexpr int SC_STRIDE = 2052;

template <int NJ>
__device__ __forceinline__ void select_emit(const unsigned (&u)[NJ], unsigned T, int lane, unsigned* mrow) {
    int cg = 0, ce = 0;
#pragma unroll
    for (int j = 0; j < NJ; ++j) { cg += (u[j] > T) ? 1 : 0; ce += (u[j] == T) ? 1 : 0; }
    const int cpk = wave_sum_i32(cg | (ce << 16)); const int cgt = cpk & 0xffff, ceq = cpk >> 16, need = 256 - cgt;
    if (ceq == need) {
#pragma unroll 4
        for (int j = 0; j < NJ; ++j) { const unsigned long long bal = __builtin_amdgcn_ballot_w64(u[j] >= T); if (lane == 0) { mrow[2 * j] = (unsigned)bal; mrow[2 * j + 1] = (unsigned)(bal >> 32); } }
    } else {
        int running = 0;
#pragma unroll 4
        for (int j = 0; j < NJ; ++j) { const unsigned long long eqm = __builtin_amdgcn_ballot_w64(u[j] == T);
            const int pre = running + (int)__builtin_amdgcn_mbcnt_hi((unsigned)(eqm >> 32), __builtin_amdgcn_mbcnt_lo((unsigned)eqm, 0u));
            const unsigned long long bal = __builtin_amdgcn_ballot_w64(u[j] > T || (u[j] == T && pre < need));
            if (lane == 0) { mrow[2 * j] = (unsigned)bal; mrow[2 * j + 1] = (unsigned)(bal >> 32); }
            running += __builtin_popcountll(eqm); }
    }
    if (lane < 32 - NJ) { mrow[2 * (NJ + lane)] = 0u; mrow[2 * (NJ + lane) + 1] = 0u; }
}
template <int NJ>
__device__ __forceinline__ void select2(const float* scq, int nj, int lane, unsigned* mrow0) {
    unsigned u0[NJ], u1[NJ];
#pragma unroll
    for (int j = 0; j < NJ; ++j) { unsigned k0 = 0u, k1 = 0u;
        if (j < nj) { const float x0 = scq[j * 64 + lane] + 0.0f, x1 = scq[SC_STRIDE + j * 64 + lane] + 0.0f; const unsigned b0 = __float_as_uint(x0), b1 = __float_as_uint(x1);
            k0 = (b0 & 0x80000000u) ? ~b0 : (b0 | 0x80000000u); k1 = (b1 & 0x80000000u) ? ~b1 : (b1 | 0x80000000u); }
        u0[j] = k0; u1[j] = k1; }
    unsigned T0 = 0u, T1 = 0u;
    for (int bit = 31; bit >= 0; --bit) {
        const unsigned Tc0 = T0 | (1u << bit), Tc1 = T1 | (1u << bit); int c0 = 0, c1 = 0;
#pragma unroll
        for (int j = 0; j < NJ; ++j) { c0 += (u0[j] >= Tc0) ? 1 : 0; c1 += (u1[j] >= Tc1) ? 1 : 0; }
        const int sp = wave_sum_i32(c0 | (c1 << 16));
        const int s0 = sp & 0xffff, s1 = sp >> 16;
        if (s0 >= 256) T0 = Tc0;
        if (s1 >= 256) T1 = Tc1;
    }
    select_emit<NJ>(u0, T0, lane, mrow0); select_emit<NJ>(u1, T1, lane, mrow0 + 64);
}
typedef float f32x4v __attribute__((ext_vector_type(4)));

__device__ __forceinline__ void ph_A_mfma(const Ids& id, const Params& p, int layer, float* lds, size_t ya_off = WS_YA, int bmax = 16) {
    const bf16* Z = (const bf16*)(p.ws + WS_Z); bf16* YA = (bf16*)(p.ws + ya_off);
    const int lane = id.tid & 63, wave = __builtin_amdgcn_readfirstlane(id.tid >> 6), r = lane & 31, hf = lane >> 5;
    float* sc = lds;
    unsigned* msk = (unsigned*)(lds + 16 * SC_STRIDE);
    lds_u8* vl = (lds_u8*)lds + wave * 4096;
    const int i16 = lane & 15;
    const lds_u8* vrd = vl + (4 * hf + (i16 >> 2)) * 128 + ((lane >> 4) & 1) * 32 + (i16 & 3) * 8;
    float Mref2; bool fixref;
    { const float gq = wave_max(fabsf(p.a_qn_g[layer * 64 + lane])), gk = wave_max(fabsf(p.a_kn_g[layer * 64 + lane]));
      Mref2 = 8.f * gq * gk * 1.001f * 1.4426950408889634f + 0.01f; fixref = Mref2 < 40.f; }
    for (int it = id.bid; it < 1024; it += gridDim.x) {
        const int c = it & 255, k4 = it >> 8, qp = c & 63, qt = (k4 & 1) ? 63 - qp : qp, b = (c >> 6) + 4 * k4;
        const int t0 = qt * 32, limit = ((t0 >> 6) + 1) << 6, nj = limit >> 6;
        const bf16* zb = Z + (size_t)b * SEQ * ZC;
        for (int half = 0; half < 2; ++half) {
            const int tq0 = t0 + 16 * half, qc = lane & 15, kg = lane >> 4;
            {
                s16x8 bq[4][2]; float w[4];
#pragma unroll
                for (int h = 0; h < 4; ++h) {
#pragma unroll
                    for (int kk = 0; kk < 2; ++kk) bq[h][kk] = *(const s16x8*)(zb + (size_t)(tq0 + qc) * ZC + Z_IQ + h * 64 + kk * 32 + kg * 8);
                    w[h] = bf2f(zb[(size_t)(tq0 + qc) * ZC + Z_IW + h]); }
                for (int kt0 = wave; kt0 * 16 < limit; kt0 += 32) {
                    s16x8 ak[4][2]; int key0[4]; bool ok[4];
#pragma unroll
                    for (int jt = 0; jt < 4; ++jt) { const int kt = kt0 + 8 * jt; ok[jt] = kt * 16 < limit; key0[jt] = (ok[jt] ? kt : kt0) * 16;
                        ak[jt][0] = *(const s16x8*)(zb + (size_t)(key0[jt] + qc) * ZC + Z_IK + kg * 8); ak[jt][1] = *(const s16x8*)(zb + (size_t)(key0[jt] + qc) * ZC + Z_IK + 32 + kg * 8); }
#pragma unroll
                    for (int jt = 0; jt < 4; ++jt) {
                        f32x4v score = {0.f, 0.f, 0.f, 0.f};
#pragma unroll
                        for (int h = 0; h < 4; ++h) { f32x4v d = {0.f, 0.f, 0.f, 0.f};
                            d = __builtin_amdgcn_mfma_f32_16x16x32_bf16(ak[jt][0], bq[h][0], d, 0, 0, 0); d = __builtin_amdgcn_mfma_f32_16x16x32_bf16(ak[jt][1], bq[h][1], d, 0, 0, 0);
#pragma unroll
                            for (int e = 0; e < 4; ++e) score[e] += w[h] * fmaxf(d[e], 0.f); }
                        if (ok[jt]) *(f32x4v*)(sc + qc * SC_STRIDE + key0[jt] + 4 * kg) = score;
                    }
                }
            }
            __syncthreads();
            for (int rsel = 0; rsel < REP_SEL; ++rsel) {
                asm volatile("" : "+s"(rsel));
                unsigned* mrow0 = msk + (16 * half + wave * 2) * 64;
                if (nj <= 4) {
                    if (lane < 32) { const unsigned v = (lane < nj) ? 0xffffffffu : 0u; mrow0[2 * lane] = v; mrow0[2 * lane + 1] = v; mrow0[64 + 2 * lane] = v; mrow0[64 + 2 * lane + 1] = v; }
                } else if (nj <= 8) select2<8>(sc + (wave * 2) * SC_STRIDE, nj, lane, mrow0);
                else if (nj <= 16) select2<16>(sc + (wave * 2) * SC_STRIDE, nj, lane, mrow0);
                else if (nj <= 24) select2<24>(sc + (wave * 2) * SC_STRIDE, nj, lane, mrow0);
                else select2<32>(sc + (wave * 2) * SC_STRIDE, nj, lane, mrow0);
            }
            __syncthreads();
        }
        for (int ratt = 0; ratt < REP_ATT; ++ratt) {
            asm volatile("" : "+s"(ratt));
            const int h = wave;
            s16x8 qf[4];
#pragma unroll
            for (int kk = 0; kk < 4; ++kk) qf[kk] = *(const s16x8*)(zb + (size_t)(t0 + r) * ZC + Z_AQ + h * 64 + kk * 16 + hf * 8);
            f32x16 o0, o1;
#pragma unroll
            for (int i = 0; i < 16; ++i) { o0[i] = 0.f; o1[i] = 0.f; }
            float m = -1e30f, l = 0.f;
            typedef unsigned u4v __attribute__((ext_vector_type(4)));
            const int tid_ = id.tid;
            u4v stg[8];
#define ATT_LOAD(c0) do { _Pragma("unroll") for (int i_ = 0; i_ < 4; ++i_) { const int pc = tid_ + 512 * i_, row = pc >> 3, col = pc & 7; const int key = (c0) + row; \
        const size_t go = (size_t)(key < limit ? key : 0) * ZC + col * 8; stg[i_] = *(const u4v*)(zb + go + Z_AK); stg[4 + i_] = *(const u4v*)(zb + go + Z_AV); } } while (0)
#define ATT_STORE(bufo) do { _Pragma("unroll") for (int i_ = 0; i_ < 4; ++i_) { const int pc = tid_ + 512 * i_, row = pc >> 3, col = pc & 7; \
        *(__attribute__((address_space(3))) u4v*)((lds_u8*)lds + (bufo) + row * 128 + ((col ^ (row & 7)) << 4)) = stg[i_]; \
        *(__attribute__((address_space(3))) u4v*)((lds_u8*)lds + (bufo) + 32768 + row * 128 + (col << 4)) = stg[4 + i_]; } } while (0)
            ATT_LOAD(0); ATT_STORE(0);
            __syncthreads();
            for (int c0 = 0; c0 < limit; c0 += 256) {
                const int bufo = ((c0 >> 8) & 1) * 65536;
                if (c0 + 256 < limit) ATT_LOAD(c0 + 256);
                const int ntile = (limit - c0 < 256) ? ((limit - c0) >> 5) : 8;
                for (int tl = 0; tl < ntile; ++tl) {
                    const int s0 = c0 + tl * 32;
                    const unsigned mw = msk[r * 64 + (s0 >> 5)];
                    if (!__any(mw != 0u)) continue;
                    const lds_u8* kb = (const lds_u8*)lds + bufo + (tl * 32 + r) * 128;
                    f32x16 sacc;
#pragma unroll
                    for (int i = 0; i < 16; ++i) sacc[i] = 0.f;
#pragma unroll
                    for (int kk = 0; kk < 4; ++kk) sacc = __builtin_amdgcn_mfma_f32_32x32x16_bf16(ldsv8(kb + (((kk * 2 + hf) ^ (r & 7)) << 4)), qf[kk], sacc, 0, 0, 0);
                    float a[16]; const unsigned mwh = mw >> (4 * hf);
                    if (fixref) {
                        float ps = 0.f;
#pragma unroll
                        for (int i = 0; i < 16; ++i) { const bool on = (mwh >> ((i & 3) + 8 * (i >> 2))) & 1u;
                            a[i] = on ? __builtin_amdgcn_exp2f(sacc[i] * (0.125f * 1.4426950408889634f) - Mref2) : 0.f; ps += a[i]; }
                        l += ps;
                    } else {
                        float sv[16]; float mx = -1e30f;
#pragma unroll
                        for (int i = 0; i < 16; ++i) { const bool on = (mwh >> ((i & 3) + 8 * (i >> 2))) & 1u;
                            sv[i] = on ? sacc[i] * (0.125f * 1.4426950408889634f) : -1e30f; mx = fmaxf(mx, sv[i]); }
                        mx = fmaxf(mx, __shfl_xor(mx, 32));
                        const float mn = fmaxf(m, mx), alpha = __builtin_amdgcn_exp2f(m - mn);
                        m = mn;
                        float ps = 0.f;
#pragma unroll
                        for (int i = 0; i < 16; ++i) { a[i] = __builtin_amdgcn_exp2f(sv[i] - mn); ps += a[i]; }
                        l = l * alpha + ps;
#pragma unroll
                        for (int i = 0; i < 16; ++i) { o0[i] *= alpha; o1[i] *= alpha; }
                    }
                    uint4 pw0, pw1;
                    pw0.x = cvt_pk(a[0], a[1]); pw0.y = cvt_pk(a[2], a[3]); pw0.z = cvt_pk(a[4], a[5]); pw0.w = cvt_pk(a[6], a[7]);
                    pw1.x = cvt_pk(a[8], a[9]); pw1.y = cvt_pk(a[10], a[11]); pw1.z = cvt_pk(a[12], a[13]); pw1.w = cvt_pk(a[14], a[15]);
                    const s16x8 pf0 = __builtin_bit_cast(s16x8, pw0), pf1 = __builtin_bit_cast(s16x8, pw1);
                    const lds_u8* vr2 = (const lds_u8*)lds + bufo + 32768 + tl * 4096 + (4 * hf + (i16 >> 2)) * 128 + ((lane >> 4) & 1) * 32 + (i16 & 3) * 8;
                    const s16x4 a00l = lds_tr_read(vr2), a00h = lds_tr_read(vr2 + 1024), a01l = lds_tr_read(vr2 + 2048), a01h = lds_tr_read(vr2 + 2048 + 1024);
                    const s16x4 a10l = lds_tr_read(vr2 + 64), a10h = lds_tr_read(vr2 + 64 + 1024), a11l = lds_tr_read(vr2 + 64 + 2048), a11h = lds_tr_read(vr2 + 64 + 2048 + 1024);
                    o0 = __builtin_amdgcn_mfma_f32_32x32x16_bf16(__builtin_shufflevector(a00l, a00h, 0, 1, 2, 3, 4, 5, 6, 7), pf0, o0, 0, 0, 0);
                    o0 = __builtin_amdgcn_mfma_f32_32x32x16_bf16(__builtin_shufflevector(a01l, a01h, 0, 1, 2, 3, 4, 5, 6, 7), pf1, o0, 0, 0, 0);
                    o1 = __builtin_amdgcn_mfma_f32_32x32x16_bf16(__builtin_shufflevector(a10l, a10h, 0, 1, 2, 3, 4, 5, 6, 7), pf0, o1, 0, 0, 0);
                    o1 = __builtin_amdgcn_mfma_f32_32x32x16_bf16(__builtin_shufflevector(a11l, a11h, 0, 1, 2, 3, 4, 5, 6, 7), pf1, o1, 0, 0, 0);
                }
                if (c0 + 256 < limit) ATT_STORE(65536 - bufo);
                __syncthreads();
            }
#undef ATT_LOAD
#undef ATT_STORE
            l += __shfl_xor(l, 32);
            const float inv = 1.f / l;
            bf16* orow = YA + (size_t)(b * SEQ + t0 + r) * 512 + h * 64 + 4 * hf;
            if (b < bmax)
#pragma unroll
            for (int g = 0; g < 4; ++g) {
                uint2 w0, w1; w0.x = cvt_pk(o0[4 * g] * inv, o0[4 * g + 1] * inv); w0.y = cvt_pk(o0[4 * g + 2] * inv, o0[4 * g + 3] * inv);
                w1.x = cvt_pk(o1[4 * g] * inv, o1[4 * g + 1] * inv); w1.y = cvt_pk(o1[4 * g + 2] * inv, o1[4 * g + 3] * inv);
                *(uint2*)(orow + 8 * g) = w0; *(uint2*)(orow + 32 + 8 * g) = w1;
            }
        }
        __syncthreads();
    }
}


constexpr int C_QT = 0, C_KT = 9216, C_QH = 18432, C_KH = 27648, C_VV = 36864, C_SS = 54272, C_F32 = 71680;
__device__ __forceinline__ void ph_C_mfma(const Ids& id, const Params& p, int layer, float* lds) {
    const bf16* Z = (const bf16*)(p.ws + WS_Z); bf16* YC = (bf16*)(p.ws + WS_YC);
    const int tid = id.tid, lane = tid & 63, wave = tid >> 6, r = lane & 31, hf = lane >> 5, i16 = lane & 15;
    lds_u8* L = (lds_u8*)lds;
    typedef __attribute__((address_space(3))) unsigned short lds_u16; typedef __attribute__((address_space(3))) float lds_f32;
    lds_f32* F = (lds_f32*)(L + C_F32);
    const float* walp = p.c_w_alpha + layer * 16 * 256; const float* balp = p.c_b_alpha + layer * 256; const float* gainp = p.c_on_g + layer * 512;
    const int kt = wave & 1, vt2 = wave >> 1;
    const int tt = wave & 1, vt = wave >> 1;
    const int trrow = 8 * hf + (i16 >> 2), trcol = ((lane >> 4) & 1) * 16 + (i16 & 3) * 4;
    const int prow = 4 * hf + (i16 >> 2);
    for (int item = id.bid; item < 64; item += gridDim.x) {
        const int b = item >> 2, h = item & 3; const bf16* zb = Z + (size_t)b * SEQ * ZC;
        __syncthreads();
        for (int i = tid; i < 1024; i += NTHR) F[960 + i] = walp[(i >> 6) * 256 + h * 64 + (i & 63)];
        if (tid < 64) F[1984 + tid] = balp[h * 64 + tid];
        if (tid < 128) F[2048 + tid] = gainp[h * 128 + tid];
        for (int i = tid; i < 64 * 136 / 2; i += NTHR) ((__attribute__((address_space(3))) unsigned*)(L + C_SS))[i] = 0u;
        f32x16 S;
#pragma unroll
        for (int i = 0; i < 16; ++i) S[i] = 0.f;
        __syncthreads();
        for (int c = 0; c < 32; ++c) {
            const int t0c = c * 64; const int k = lane;
            float bb[8], qv[8], kv[8];
            {
                float run = 0.f;
#pragma unroll
                for (int i = 0; i < 8; ++i) { const bf16* zr = zb + (size_t)(t0c + 8 * wave + i) * ZC;
                    float a[16];
                    { const uint2 a0 = *(const uint2*)(zr + Z_CA), a1 = *(const uint2*)(zr + Z_CA + 4), a2 = *(const uint2*)(zr + Z_CA + 8), a3 = *(const uint2*)(zr + Z_CA + 12);
                      uint4 lo4, hi4; lo4.x = a0.x; lo4.y = a0.y; lo4.z = a1.x; lo4.w = a1.y; hi4.x = a2.x; hi4.y = a2.y; hi4.z = a3.x; hi4.w = a3.y; unpack8(lo4, a); unpack8(hi4, a + 8); }
                    float x = F[1984 + k];
#pragma unroll
                    for (int rr = 0; rr < 16; ++rr) x += a[rr] * F[960 + rr * 64 + k];
                    const float la = (fminf(x, 0.f) - __logf(1.f + __expf(-fabsf(x)))) * (1.f / 16.f);
                    run += la; bb[i] = run;
                    qv[i] = bf2f(zr[Z_CQ + h * 64 + k]) * 0.125f; kv[i] = bf2f(zr[Z_CK + h * 64 + k]); }
                F[wave * 64 + k] = run;
                typedef unsigned u4v __attribute__((ext_vector_type(4)));
#pragma unroll
                for (int i = 0; i < 2; ++i) { const int idx = tid + i * 512, row = idx >> 4, ch = idx & 15;
                    const u4v v = *(const u4v*)(zb + (size_t)(t0c + row) * ZC + Z_CV + h * 128 + ch * 8);
                    *(__attribute__((address_space(3))) u4v*)(L + C_VV + row * 272 + ch * 16) = v; }
            }
            __syncthreads();
            {   float pre = 0.f;
                for (int g = 0; g < wave; ++g) pre += F[g * 64 + k];
#pragma unroll
                for (int i = 0; i < 8; ++i) bb[i] += pre;
                if (wave == 3) F[512 + k] = bb[7];
                if (wave == 7) { F[576 + k] = bb[7]; F[640 + k] = __expf(bb[7]); }
            }
            __syncthreads();
            {   const float bmid = F[512 + k], blast = F[576 + k];
#pragma unroll
                for (int i = 0; i < 8; ++i) { const int t = 8 * wave + i;
                    const float e1 = __expf(fminf(fmaxf(bb[i] - bmid, -80.f), 80.f)), e2 = __expf(fminf(fmaxf(bmid - bb[i], -80.f), 80.f));
                    ((lds_u16*)(L + C_QT))[t * 72 + k] = f2bf(qv[i] * e1); ((lds_u16*)(L + C_KT))[t * 72 + k] = f2bf(kv[i] * e2);
                    ((lds_u16*)(L + C_QH))[t * 72 + k] = f2bf(qv[i] * __expf(bb[i])); ((lds_u16*)(L + C_KH))[t * 72 + k] = f2bf(kv[i] * __expf(blast - bb[i])); }
            }
            __syncthreads();
            f32x16 o;
#pragma unroll
            for (int i = 0; i < 16; ++i) o[i] = 0.f;
            {
#pragma unroll
                for (int ks = 0; ks < 4; ++ks) {
                    const lds_u8* ap = L + C_SS + (16 * ks + trrow) * 272 + (vt * 32 + trcol) * 2;
                    const s16x4 lo = lds_tr_read(ap), hi = lds_tr_read(ap + 4 * 272);
                    const s16x8 bq = ldsv8(L + C_QH + (tt * 32 + r) * 144 + (16 * ks + 8 * hf) * 2);
                    o = __builtin_amdgcn_mfma_f32_32x32x16_bf16(__builtin_shufflevector(lo, hi, 0, 1, 2, 3, 4, 5, 6, 7), bq, o, 0, 0, 0);
                }
            }
#pragma unroll
            for (int st = 0; st < 2; ++st) {
                if (st > tt) continue;
                f32x16 at;
#pragma unroll
                for (int i = 0; i < 16; ++i) at[i] = 0.f;
#pragma unroll
                for (int kk = 0; kk < 4; ++kk) at = __builtin_amdgcn_mfma_f32_32x32x16_bf16(ldsv8(L + C_KT + (st * 32 + r) * 144 + (kk * 16 + hf * 8) * 2), ldsv8(L + C_QT + (tt * 32 + r) * 144 + (kk * 16 + hf * 8) * 2), at, 0, 0, 0);
                if (st == tt) {
#pragma unroll
                    for (int i = 0; i < 16; ++i) { const int srow = (i & 3) + 8 * (i >> 2) + 4 * hf; if (srow > r) at[i] = 0.f; }
                }
                uint4 pw0, pw1;
                pw0.x = cvt_pk(at[0], at[1]); pw0.y = cvt_pk(at[2], at[3]); pw0.z = cvt_pk(at[4], at[5]); pw0.w = cvt_pk(at[6], at[7]);
                pw1.x = cvt_pk(at[8], at[9]); pw1.y = cvt_pk(at[10], at[11]); pw1.z = cvt_pk(at[12], at[13]); pw1.w = cvt_pk(at[14], at[15]);
                const s16x8 pf0 = __builtin_bit_cast(s16x8, pw0), pf1 = __builtin_bit_cast(s16x8, pw1);
                const lds_u8* vp = L + C_VV + (st * 32 + prow) * 272 + (vt * 32 + trcol) * 2;
                const s16x4 v0l = lds_tr_read(vp), v0h = lds_tr_read(vp + 8 * 272), v1l = lds_tr_read(vp + 16 * 272), v1h = lds_tr_read(vp + 24 * 272);
                o = __builtin_amdgcn_mfma_f32_32x32x16_bf16(__builtin_shufflevector(v0l, v0h, 0, 1, 2, 3, 4, 5, 6, 7), pf0, o, 0, 0, 0);
                o = __builtin_amdgcn_mfma_f32_32x32x16_bf16(__builtin_shufflevector(v1l, v1h, 0, 1, 2, 3, 4, 5, 6, 7), pf1, o, 0, 0, 0);
            }
            {
#pragma unroll
                for (int i = 0; i < 16; ++i) S[i] *= F[640 + kt * 32 + (i & 3) + 8 * (i >> 2) + 4 * hf];
#pragma unroll
                for (int ks = 0; ks < 4; ++ks) {
                    const lds_u8* ap = L + C_KH + (16 * ks + trrow) * 144 + (kt * 32 + trcol) * 2;
                    const lds_u8* bp = L + C_VV + (16 * ks + trrow) * 272 + (vt2 * 32 + trcol) * 2;
                    const s16x4 al = lds_tr_read(ap), ah = lds_tr_read(ap + 4 * 144), bl = lds_tr_read(bp), bh = lds_tr_read(bp + 4 * 272);
                    S = __builtin_amdgcn_mfma_f32_32x32x16_bf16(__builtin_shufflevector(al, ah, 0, 1, 2, 3, 4, 5, 6, 7), __builtin_shufflevector(bl, bh, 0, 1, 2, 3, 4, 5, 6, 7), S, 0, 0, 0);
                }
            }
            {   float ss = 0.f;
#pragma unroll
                for (int i = 0; i < 16; ++i) ss += o[i] * o[i];
                ss += __shfl_xor(ss, 32);
                __syncthreads();
                if (hf == 0) F[704 + vt * 64 + tt * 32 + r] = ss;
#pragma unroll
                for (int i = 0; i < 16; ++i) ((lds_u16*)(L + C_SS))[(kt * 32 + (i & 3) + 8 * (i >> 2) + 4 * hf) * 136 + vt2 * 32 + r] = f2bf(S[i]);
            }
            __syncthreads();
            {   const int t = tt * 32 + r;
                const float tot = F[704 + t] + F[704 + 64 + t] + F[704 + 128 + t] + F[704 + 192 + t];
                const float rn = rsqrtf(tot * (1.f / 128.f) + 1e-6f);
                const bf16* rrow = zb + (size_t)(t0c + t) * ZC + Z_CR + h * 128 + vt * 32 + 4 * hf;
                bf16* orow = YC + (size_t)(b * SEQ + t0c + t) * 512 + h * 128 + vt * 32 + 4 * hf;
#pragma unroll
                for (int g = 0; g < 4; ++g) {
                    const uint2 rw = *(const uint2*)(rrow + 8 * g);
                    const float r0 = __uint_as_float(rw.x << 16), r1 = __uint_as_float(rw.x & 0xffff0000u), r2 = __uint_as_float(rw.y << 16), r3 = __uint_as_float(rw.y & 0xffff0000u);
                    const int vb = 2048 + vt * 32 + 8 * g + 4 * hf;
                    const float y0 = o[4 * g] * rn * F[vb] * (r0 / (1.f + __expf(-r0))), y1 = o[4 * g + 1] * rn * F[vb + 1] * (r1 / (1.f + __expf(-r1)));
                    const float y2 = o[4 * g + 2] * rn * F[vb + 2] * (r2 / (1.f + __expf(-r2))), y3 = o[4 * g + 3] * rn * F[vb + 3] * (r3 / (1.f + __expf(-r3)));
                    uint2 w; w.x = cvt_pk(y0, y1); w.y = cvt_pk(y2, y3); *(uint2*)(orow + 8 * g) = w;
                }
            }
        }
    }
    __syncthreads();
}


constexpr size_t WS_CD = 452 * MiB;
constexpr size_t WS_CS = 484 * MiB;
constexpr size_t WS_CL = 444 * MiB;
template <int PASS>
__device__ __forceinline__ void ph_C_chunk(const Ids& id, const Params& p, int layer, float* lds) {
    const bf16* Z = (const bf16*)(p.ws + WS_Z); bf16* YC = (bf16*)(p.ws + WS_YC);
    bf16* CD = (bf16*)(p.ws + WS_CD); const bf16* CS = (const bf16*)(p.ws + WS_CS); float* CL = (float*)(p.ws + WS_CL);
    const int tid = id.tid, lane = tid & 63, wave = tid >> 6, r = lane & 31, hf = lane >> 5, i16 = lane & 15;
    lds_u8* L = (lds_u8*)lds;
    typedef __attribute__((address_space(3))) unsigned short lds_u16; typedef __attribute__((address_space(3))) float lds_f32;
    lds_f32* F = (lds_f32*)(L + C_F32);
    const float* walp = p.c_w_alpha + layer * 16 * 256; const float* balp = p.c_b_alpha + layer * 256; const float* gainp = p.c_on_g + layer * 512;
    const int kt = wave & 1, vt2 = wave >> 1, tt = wave & 1, vt = wave >> 1;
    const int trrow = 8 * hf + (i16 >> 2), trcol = ((lane >> 4) & 1) * 16 + (i16 & 3) * 4, prow = 4 * hf + (i16 >> 2);
    typedef unsigned u4v __attribute__((ext_vector_type(4)));
    int h_loaded = -1;
    u4v cspre[2];
    if (PASS == 3 && id.bid < 2048) {
#pragma unroll
        for (int i = 0; i < 2; ++i) { const int idx = tid + i * 512, row = idx >> 4, ch = idx & 15; cspre[i] = *(const u4v*)(CS + (size_t)id.bid * 8192 + row * 128 + ch * 8); } }
    for (int item = id.bid; item < 2048; item += gridDim.x) {
        const int c = item & 31, bh = item >> 5, b = bh >> 2, h = bh & 3; const bf16* zb = Z + (size_t)b * SEQ * ZC;
        const int t0c = c * 64, k = lane;
        u4v vpre[2];
#pragma unroll
        for (int i = 0; i < 2; ++i) { const int idx = tid + i * 512, row = idx >> 4, ch = idx & 15; vpre[i] = *(const u4v*)(zb + (size_t)(t0c + row) * ZC + Z_CV + h * 128 + ch * 8); }
        const unsigned apre = *(const unsigned*)(zb + (size_t)(t0c + 8 * wave + (lane >> 3)) * ZC + Z_CA + (lane & 7) * 2);
        bf16 qpre[8], kpre[8];
#pragma unroll
        for (int i = 0; i < 8; ++i) { const bf16* zr = zb + (size_t)(t0c + 8 * wave + i) * ZC; if (PASS == 3) qpre[i] = zr[Z_CQ + h * 64 + k]; kpre[i] = zr[Z_CK + h * 64 + k]; }
        uint2 rpre[4];
        if (PASS == 3) { const bf16* rrow0 = zb + (size_t)(t0c + tt * 32 + r) * ZC + Z_CR + h * 128 + vt * 32 + 4 * hf;
#pragma unroll
            for (int g = 0; g < 4; ++g) rpre[g] = *(const uint2*)(rrow0 + 8 * g); }
        __syncthreads();
        if (h != h_loaded) {
            for (int i = tid; i < 1024; i += NTHR) F[960 + i] = walp[(i >> 6) * 256 + h * 64 + (i & 63)];
            if (tid < 64) F[1984 + tid] = balp[h * 64 + tid];
            if (PASS == 3 && tid < 128) F[2048 + tid] = gainp[h * 128 + tid];
            h_loaded = h;
        }
        if (PASS == 3) {
#pragma unroll
            for (int i = 0; i < 2; ++i) { const int idx = tid + i * 512, row = idx >> 4, ch = idx & 15;
                *(__attribute__((address_space(3))) u4v*)(L + C_SS + row * 272 + ch * 16) = cspre[i]; }
            const int nitem = item + (int)gridDim.x;
            if (nitem < 2048) {
#pragma unroll
                for (int i = 0; i < 2; ++i) { const int idx = tid + i * 512, row = idx >> 4, ch = idx & 15; cspre[i] = *(const u4v*)(CS + (size_t)nitem * 8192 + row * 128 + ch * 8); } }
        }
        __syncthreads();
        float bb[8], qv[8], kv[8];
        {
            float run = 0.f;
#pragma unroll
            for (int i = 0; i < 8; ++i) {
                float a[16];
#pragma unroll
                for (int pp = 0; pp < 8; ++pp) { const unsigned ap = (unsigned)__builtin_amdgcn_readlane((int)apre, 8 * i + pp); a[2 * pp] = __uint_as_float(ap << 16); a[2 * pp + 1] = __uint_as_float(ap & 0xffff0000u); }
                float x = F[1984 + k];
#pragma unroll
                for (int rr = 0; rr < 16; ++rr) x += a[rr] * F[960 + rr * 64 + k];
                const float la = (fminf(x, 0.f) - __logf(1.f + __expf(-fabsf(x)))) * (1.f / 16.f);
                run += la; bb[i] = run;
                if (PASS == 3) qv[i] = bf2f(qpre[i]) * 0.125f;
                kv[i] = bf2f(kpre[i]); }
            F[wave * 64 + k] = run;
#pragma unroll
            for (int i = 0; i < 2; ++i) { const int idx = tid + i * 512, row = idx >> 4, ch = idx & 15;
                *(__attribute__((address_space(3))) u4v*)(L + C_VV + row * 272 + ch * 16) = vpre[i]; }
        }
        __syncthreads();
        {   float pre = 0.f;
            for (int g = 0; g < wave; ++g) pre += F[g * 64 + k];
#pragma unroll
            for (int i = 0; i < 8; ++i) bb[i] += pre;
            if (wave == 3) F[512 + k] = bb[7];
            if (wave == 7) { F[576 + k] = bb[7]; if (PASS == 1) CL[(size_t)item * 64 + k] = __expf(bb[7]); }
        }
        __syncthreads();
        {   const float bmid = F[512 + k], blast = F[576 + k];
#pragma unroll
            for (int i = 0; i < 8; ++i) { const int t = 8 * wave + i;
                if (PASS == 3) { const float e1 = __expf(fminf(fmaxf(bb[i] - bmid, -80.f), 80.f)), e2 = __expf(fminf(fmaxf(bmid - bb[i], -80.f), 80.f));
                    ((lds_u16*)(L + C_QT))[t * 72 + k] = f2bf(qv[i] * e1); ((lds_u16*)(L + C_KT))[t * 72 + k] = f2bf(kv[i] * e2);
                    ((lds_u16*)(L + C_QH))[t * 72 + k] = f2bf(qv[i] * __expf(bb[i])); }
                else ((lds_u16*)(L + C_KH))[t * 72 + k] = f2bf(kv[i] * __expf(blast - bb[i])); }
        }
        __syncthreads();
        if (PASS == 1) {
            f32x16 S;
#pragma unroll
            for (int i = 0; i < 16; ++i) S[i] = 0.f;
#pragma unroll
            for (int ks = 0; ks < 4; ++ks) {
                const lds_u8* ap = L + C_KH + (16 * ks + trrow) * 144 + (kt * 32 + trcol) * 2;
                const lds_u8* bp = L + C_VV + (16 * ks + trrow) * 272 + (vt2 * 32 + trcol) * 2;
                const s16x4 al = lds_tr_read(ap), ah = lds_tr_read(ap + 4 * 144), bl = lds_tr_read(bp), bh2 = lds_tr_read(bp + 4 * 272);
                S = __builtin_amdgcn_mfma_f32_32x32x16_bf16(__builtin_shufflevector(al, ah, 0, 1, 2, 3, 4, 5, 6, 7), __builtin_shufflevector(bl, bh2, 0, 1, 2, 3, 4, 5, 6, 7), S, 0, 0, 0);
            }
            bf16* dp = CD + (size_t)item * 8192 + vt2 * 32 + r;
#pragma unroll
            for (int i = 0; i < 16; ++i) dp[(kt * 32 + (i & 3) + 8 * (i >> 2) + 4 * hf) * 128] = f2bf(S[i]);
        } else {
            f32x16 o;
#pragma unroll
            for (int i = 0; i < 16; ++i) o[i] = 0.f;
#pragma unroll
            for (int ks = 0; ks < 4; ++ks) {
                const lds_u8* ap = L + C_SS + (16 * ks + trrow) * 272 + (vt * 32 + trcol) * 2;
                const s16x4 lo = lds_tr_read(ap), hi = lds_tr_read(ap + 4 * 272);
                const s16x8 bq = ldsv8(L + C_QH + (tt * 32 + r) * 144 + (16 * ks + 8 * hf) * 2);
                o = __builtin_amdgcn_mfma_f32_32x32x16_bf16(__builtin_shufflevector(lo, hi, 0, 1, 2, 3, 4, 5, 6, 7), bq, o, 0, 0, 0);
            }
#pragma unroll
            for (int st = 0; st < 2; ++st) {
                if (st > tt) continue;
                f32x16 at;
#pragma unroll
                for (int i = 0; i < 16; ++i) at[i] = 0.f;
#pragma unroll
                for (int kk = 0; kk < 4; ++kk) at = __builtin_amdgcn_mfma_f32_32x32x16_bf16(ldsv8(L + C_KT + (st * 32 + r) * 144 + (kk * 16 + hf * 8) * 2), ldsv8(L + C_QT + (tt * 32 + r) * 144 + (kk * 16 + hf * 8) * 2), at, 0, 0, 0);
                if (st == tt) {
#pragma unroll
                    for (int i = 0; i < 16; ++i) { const int srow = (i & 3) + 8 * (i >> 2) + 4 * hf; if (srow > r) at[i] = 0.f; }
                }
                uint4 pw0, pw1;
                pw0.x = cvt_pk(at[0], at[1]); pw0.y = cvt_pk(at[2], at[3]); pw0.z = cvt_pk(at[4], at[5]); pw0.w = cvt_pk(at[6], at[7]);
                pw1.x = cvt_pk(at[8], at[9]); pw1.y = cvt_pk(at[10], at[11]); pw1.z = cvt_pk(at[12], at[13]); pw1.w = cvt_pk(at[14], at[15]);
                const s16x8 pf0 = __builtin_bit_cast(s16x8, pw0), pf1 = __builtin_bit_cast(s16x8, pw1);
                const lds_u8* vp = L + C_VV + (st * 32 + prow) * 272 + (vt * 32 + trcol) * 2;
                const s16x4 v0l = lds_tr_read(vp), v0h = lds_tr_read(vp + 8 * 272), v1l = lds_tr_read(vp + 16 * 272), v1h = lds_tr_read(vp + 24 * 272);
                o = __builtin_amdgcn_mfma_f32_32x32x16_bf16(__builtin_shufflevector(v0l, v0h, 0, 1, 2, 3, 4, 5, 6, 7), pf0, o, 0, 0, 0);
                o = __builtin_amdgcn_mfma_f32_32x32x16_bf16(__builtin_shufflevector(v1l, v1h, 0, 1, 2, 3, 4, 5, 6, 7), pf1, o, 0, 0, 0);
            }
            float ss = 0.f;
#pragma unroll
            for (int i = 0; i < 16; ++i) ss += o[i] * o[i];
            ss += __shfl_xor(ss, 32);
            if (hf == 0) F[704 + vt * 64 + tt * 32 + r] = ss;
            __syncthreads();
            const int t = tt * 32 + r;
            const float tot = F[704 + t] + F[704 + 64 + t] + F[704 + 128 + t] + F[704 + 192 + t];
            const float rn = rsqrtf(tot * (1.f / 128.f) + 1e-6f);
            const bf16* rrow = zb + (size_t)(t0c + t) * ZC + Z_CR + h * 128 + vt * 32 + 4 * hf;
            bf16* orow = YC + (size_t)(b * SEQ + t0c + t) * 512 + h * 128 + vt * 32 + 4 * hf;
#pragma unroll
            for (int g = 0; g < 4; ++g) {
                const uint2 rw = rpre[g];
                const float r0 = __uint_as_float(rw.x << 16), r1 = __uint_as_float(rw.x & 0xffff0000u), r2 = __uint_as_float(rw.y << 16), r3 = __uint_as_float(rw.y & 0xffff0000u);
                const int vb = 2048 + vt * 32 + 8 * g + 4 * hf;
                const float y0 = o[4 * g] * rn * F[vb] * (r0 / (1.f + __expf(-r0))), y1 = o[4 * g + 1] * rn * F[vb + 1] * (r1 / (1.f + __expf(-r1)));
                const float y2 = o[4 * g + 2] * rn * F[vb + 2] * (r2 / (1.f + __expf(-r2))), y3 = o[4 * g + 3] * rn * F[vb + 3] * (r3 / (1.f + __expf(-r3)));
                uint2 w; w.x = cvt_pk(y0, y1); w.y = cvt_pk(y2, y3); *(uint2*)(orow + 8 * g) = w;
            }
        }
    }
    __syncthreads();
}
__device__ __forceinline__ void ph_C_scan(const Ids& id, const Params& p) {
    const bf16* CD = (const bf16*)(p.ws + WS_CD); bf16* CS = (bf16*)(p.ws + WS_CS); const float* CL = (const float*)(p.ws + WS_CL);
    for (int e = id.bid * NTHR + id.tid; e < 64 * 64 * 32; e += gridDim.x * NTHR) {
        const int v4 = e & 31, k = (e >> 5) & 63, bh = e >> 11;
        float s0 = 0.f, s1 = 0.f, s2 = 0.f, s3 = 0.f;
#pragma unroll 8
        for (int c = 0; c < 32; ++c) {
            const size_t off = (size_t)(bh * 32 + c) * 8192 + k * 128 + v4 * 4;
            const uint2 d = *(const uint2*)(CD + off); const float dl = CL[(size_t)(bh * 32 + c) * 64 + k];
            uint2 o; o.x = cvt_pk(s0, s1); o.y = cvt_pk(s2, s3); *(uint2*)(CS + off) = o;
            s0 = dl * s0 + __uint_as_float(d.x << 16); s1 = dl * s1 + __uint_as_float(d.x & 0xffff0000u); s2 = dl * s2 + __uint_as_float(d.y << 16); s3 = dl * s3 + __uint_as_float(d.y & 0xffff0000u);
        }
    }
}

__device__ __forceinline__ void ph_C(const Ids& id, const Params& p, int layer, float* lds) {
    const bf16* Z = (const bf16*)(p.ws + WS_Z); float* OR = (float*)(p.ws + WS_CRAW);
    float* s_al = lds; float* s_k = lds + 1024; float* s_q = lds + 2048; float* s_wa = lds + 3072; float* s_ba = lds + 4096;
    const float* wal = p.c_w_alpha + layer * 16 * 256; const float* bal = p.c_b_alpha + layer * 256;
    const int tid = id.tid;
    for (int item = id.bid; item < 64; item += gridDim.x) {
        const int b = item >> 2, h = item & 3; const bf16* zb = Z + (size_t)b * SEQ * ZC;
        for (int i = tid; i < 1024; i += NTHR) { const int r = i >> 6, k = i & 63; s_wa[i] = wal[r * 256 + h * 64 + k]; }
        if (tid < 64) s_ba[tid] = bal[h * 64 + tid];
        float S[64];
#pragma unroll
        for (int k = 0; k < 64; ++k) S[k] = 0.f;
        __syncthreads();
        for (int t0 = 0; t0 < SEQ; t0 += 16) {
            for (int i = tid; i < 1024; i += NTHR) { const int st = i >> 6, k = i & 63; const bf16* zr = zb + (size_t)(t0 + st) * ZC;
                float x = s_ba[k];
#pragma unroll
                for (int r = 0; r < 16; ++r) x += bf2f(zr[Z_CA + r]) * s_wa[r * 64 + k];
                s_al[i] = expf(logsig(x) * (1.f / 16.f));
                s_k[i] = bf2f(zr[Z_CK + h * 64 + k]); s_q[i] = bf2f(zr[Z_CQ + h * 64 + k]) * 0.125f; }
            __syncthreads();
            if (tid < 128) {
                for (int st = 0; st < 16; ++st) {
                    const float vv = bf2f(zb[(size_t)(t0 + st) * ZC + Z_CV + h * 128 + tid]);
                    float o = 0.f;
#pragma unroll
                    for (int k = 0; k < 64; ++k) { S[k] = s_al[st * 64 + k] * S[k] + s_k[st * 64 + k] * vv; o += s_q[st * 64 + k] * S[k]; }
                    OR[(size_t)(b * SEQ + t0 + st) * 512 + h * 128 + tid] = o;
                }
            }
            __syncthreads();
        }
    }
}
__device__ __forceinline__ void ph_Cpost(const Ids& id, const Params& p, int layer) {
    const bf16* Z = (const bf16*)(p.ws + WS_Z); const float* OR = (const float*)(p.ws + WS_CRAW); bf16* YC = (bf16*)(p.ws + WS_YC);
    const int lane = id.tid & 63, wave = __builtin_amdgcn_readfirstlane(id.tid >> 6);
    for (int idx = id.bid * 8 + wave; idx < NTOK * 4; idx += gridDim.x * 8) {
        const int tok = idx >> 2, h = idx & 3;
        const float o0 = OR[(size_t)tok * 512 + h * 128 + lane], o1 = OR[(size_t)tok * 512 + h * 128 + 64 + lane];
        const float ss = wave_sum(o0 * o0 + o1 * o1); const float r = rsqrtf(ss * (1.f / 128.f) + 1e-6f);
        const float g0 = p.c_on_g[layer * 512 + h * 128 + lane], g1 = p.c_on_g[layer * 512 + h * 128 + 64 + lane];
        const float r0 = bf2f(Z[(size_t)tok * ZC + Z_CR + h * 128 + lane]), r1 = bf2f(Z[(size_t)tok * ZC + Z_CR + h * 128 + 64 + lane]);
        YC[(size_t)tok * 512 + h * 128 + lane] = f2bf(o0 * r * g0 * (r0 / (1.f + expf(-r0))));
        YC[(size_t)tok * 512 + h * 128 + 64 + lane] = f2bf(o1 * r * g1 * (r1 / (1.f + expf(-r1))));
    }
}

__device__ __forceinline__ void ph_peersel(const Ids& id, const Params& p, int layer, float* lds) {
    const bf16* PQ = (const bf16*)(p.ws + WS_PQ); int* PE = (int*)(p.ws + WS_PE); float* PG = (float*)(p.ws + WS_PG);
    const float* SK = p.peer_subkeys + (size_t)layer * 8 * 2 * 128 * 128;
    float* s_q = lds; float* s_sc = lds + 2048; float* s_ts = lds + 4096; int* s_ti = (int*)(lds + 4352); float* s_bs = lds + 4608; int* s_be = (int*)(lds + 4736);
    const int tid = id.tid;
    for (int tok = id.bid; tok < NTOK; tok += gridDim.x) {
        for (int i = tid; i < 2048; i += NTHR) s_q[i] = bf2f(PQ[(size_t)tok * 2048 + i]);
        __syncthreads();
        for (int idx = tid; idx < 2048; idx += NTHR) { const int list = idx >> 7;
            const float4* kr = (const float4*)(SK + (size_t)idx * 128); const float* q = s_q + list * 128; float dot = 0.f;
            for (int c = 0; c < 32; ++c) { const float4 kv = kr[c]; dot += q[c * 4] * kv.x + q[c * 4 + 1] * kv.y + q[c * 4 + 2] * kv.z + q[c * 4 + 3] * kv.w; }
            s_sc[idx] = dot; }
        __syncthreads();
        for (int idx = tid; idx < 2048; idx += NTHR) { const int list = idx >> 7, i = idx & 127; const float v = s_sc[idx]; int rank = 0;
            for (int j = 0; j < 128; ++j) { const float u = s_sc[list * 128 + j]; rank += (u > v || (u == v && j < i)) ? 1 : 0; }
            if (rank < 16) { s_ts[list * 16 + rank] = v; s_ti[list * 16 + rank] = i; } }
        __syncthreads();
        for (int idx = tid; idx < 2048; idx += NTHR) { const int h = idx >> 8, a = (idx >> 4) & 15, b = idx & 15;
            s_sc[idx] = s_ts[(2 * h) * 16 + a] + s_ts[(2 * h + 1) * 16 + b]; }
        __syncthreads();
        for (int idx = tid; idx < 2048; idx += NTHR) { const int h = idx >> 8, i = idx & 255; const float v = s_sc[idx]; int rank = 0;
            for (int j = 0; j < 256; ++j) { const float u = s_sc[h * 256 + j]; rank += (u > v || (u == v && j < i)) ? 1 : 0; }
            if (rank < 16) { s_bs[h * 16 + rank] = v; s_be[h * 16 + rank] = s_ti[(2 * h) * 16 + (i >> 4)] * 128 + s_ti[(2 * h + 1) * 16 + (i & 15)]; } }
        __syncthreads();
        if (tid < 128) { const int h = tid >> 4; const float m = s_bs[h * 16]; float sum = 0.f;
            for (int k = 0; k < 16; ++k) sum += expf(s_bs[h * 16 + k] - m);
            PG[(size_t)tok * 128 + tid] = expf(s_bs[tid] - m) / sum; PE[(size_t)tok * 128 + tid] = s_be[tid]; }
        __syncthreads();
    }
}
__device__ __forceinline__ void ph_peerexp(const Ids& id, const Params& p, int layer, float* lds) {
    const bf16* N = (const bf16*)(p.ws + WS_N); const int* PE = (const int*)(p.ws + WS_PE); const float* PG = (const float*)(p.ws + WS_PG);
    const float* U = p.peer_u + (size_t)layer * 16384 * 1024; const float* V = p.peer_v + (size_t)layer * 16384 * 1024;
    const float* mod = (const float*)(p.ws + WS_MOD) + (size_t)layer * 16 * 6144;
    float* s_x = lds; float* s_w = lds + 1024; int* s_e = (int*)(lds + 1152);
    const int tid = id.tid, lane = tid & 63, wave = tid >> 6;
    for (int tok = id.bid; tok < NTOK; tok += gridDim.x) {
        const int b = tok >> 11;
        for (int i = tid; i < 1024; i += NTHR) s_x[i] = bf2f(N[(size_t)tok * 1024 + i]);
        if (tid < 128) s_e[tid] = PE[(size_t)tok * 128 + tid];
        __syncthreads();
        for (int i = 0; i < 16; ++i) { const int slot = wave * 16 + i; const int e = s_e[slot];
            const float4* ur = (const float4*)(U + (size_t)e * 1024); float dot = 0.f;
#pragma unroll
            for (int j = 0; j < 4; ++j) { const float4 uv = ur[lane + 64 * j]; const float* xx = s_x + (lane + 64 * j) * 4; dot += xx[0] * uv.x + xx[1] * uv.y + xx[2] * uv.z + xx[3] * uv.w; }
            dot = wave_sum(dot);
            const float act = 0.5f * dot * (1.f + erff(dot * 0.70710678118654752f));
            if (lane == 0) s_w[slot] = PG[(size_t)tok * 128 + slot] * act; }
        __syncthreads();
        { float a0 = 0.f, a1 = 0.f;
          for (int j = 0; j < 128; ++j) { const float2 vv = *(const float2*)(V + (size_t)s_e[j] * 1024 + tid * 2); const float w = s_w[j]; a0 += w * vv.x; a1 += w * vv.y; }
          const float2 g = *(const float2*)(mod + (size_t)b * 6144 + 5 * 1024 + tid * 2);
          float2* o = (float2*)(p.out + (size_t)tok * 1024 + tid * 2); float2 hv = *o; hv.x += g.x * a0; hv.y += g.y * a1; *o = hv; }
        __syncthreads();
    }
}


#define LAS __attribute__((address_space(3)))
#define LDS_WAIT() asm volatile("s_waitcnt lgkmcnt(0)" ::: "memory")
__device__ __forceinline__ unsigned pk2(float lo, float hi) { return (unsigned)f2bf(lo) | ((unsigned)f2bf(hi) << 16); }
template <bool MAP>
__device__ __forceinline__ void transpose_item(const float* W, int ldw, int K, int nblk, bf16* WT, float* scr, int item, int lane) {
    const int kb = item / nblk, nb = item % nblk, k0 = 64 * kb, n0 = 32 * nb;
    const int n = n0 + (lane & 31);
    const int sc = MAP ? (n < 4052 ? inproj_src_col(n) : -1) : n;
#pragma unroll 8
    for (int i = 0; i < 32; ++i) { const int kk = 2 * i + (lane >> 5); scr[kk * 33 + (lane & 31)] = sc >= 0 ? W[(size_t)(k0 + kk) * ldw + sc] : 0.f; }
    LDS_WAIT();
    const int c = lane & 7;
#pragma unroll
    for (int j = 0; j < 4; ++j) { const int nn = (lane >> 3) + 8 * j; const float* sp = scr + (8 * c) * 33 + nn;
        uint4 o; o.x = pk2(sp[0 * 33], sp[1 * 33]); o.y = pk2(sp[2 * 33], sp[3 * 33]); o.z = pk2(sp[4 * 33], sp[5 * 33]); o.w = pk2(sp[6 * 33], sp[7 * 33]);
        *(uint4*)(WT + (size_t)(n0 + nn) * K + k0 + 8 * c) = o; }
    LDS_WAIT();
}
__device__ __forceinline__ void ph_wprep(const Ids& id, const Params& p, int layer, float* lds) {
    const int lane = id.tid & 63, wave = __builtin_amdgcn_readfirstlane(id.tid >> 6);
    float* scr = lds + wave * (64 * 33);
    unsigned char* ws = p.ws;
    {
        const float4* SK = (const float4*)(p.peer_subkeys + (size_t)layer * 262144); uint2* SKB = (uint2*)(p.ws + WS_SKB);
        for (int i = id.bid * NTHR + id.tid; i < 65536; i += gridDim.x * NTHR) { const float4 a = SK[i]; uint2 o; o.x = pk2(a.x, a.y); o.y = pk2(a.z, a.w); SKB[i] = o; }
    }
    constexpr int I_IN = 16 * 128, I_G = 16 * 96, I_O = 8 * 32, I_OUT = 16 * 32, I_PQ = 16 * 64;
    constexpr int NITEMS = I_IN + I_G + 3 * I_O + I_OUT + I_PQ;
    const float* win = p.w_in + (size_t)layer * 1024 * INC;
    for (int it = id.bid * 8 + wave; it < NITEMS; it += gridDim.x * 8) {
        int r = it;
        if (r < I_IN) { transpose_item<true>(win, INC, 1024, 128, (bf16*)(ws + WS_WIN_T), scr, r, lane); continue; } r -= I_IN;
        if (r < I_G) { transpose_item<false>(win + 4052, INC, 1024, 96, (bf16*)(ws + WS_WG_T), scr, r, lane); continue; } r -= I_G;
        if (r < I_O) { transpose_item<false>(p.w_oa + (size_t)layer * 512 * 1024, 1024, 512, 32, (bf16*)(ws + WS_WOA_T), scr, r, lane); continue; } r -= I_O;
        if (r < I_O) { transpose_item<false>(p.w_ob + (size_t)layer * 512 * 1024, 1024, 512, 32, (bf16*)(ws + WS_WOB_T), scr, r, lane); continue; } r -= I_O;
        if (r < I_O) { transpose_item<false>(p.w_oc + (size_t)layer * 512 * 1024, 1024, 512, 32, (bf16*)(ws + WS_WOC_T), scr, r, lane); continue; } r -= I_O;
        if (r < I_OUT) { transpose_item<false>(p.w_out + (size_t)layer * 1024 * 1024, 1024, 1024, 32, (bf16*)(ws + WS_WOUT_T), scr, r, lane); continue; } r -= I_OUT;
        transpose_item<false>(p.peer_wq + (size_t)layer * 1024 * 2048, 2048, 1024, 64, (bf16*)(ws + WS_WPQ_T), scr, r, lane);
    }
}

#ifndef FUSE_QK
#define FUSE_QK 1
#endif
#ifndef FUSE_GATES
#define FUSE_GATES 1
#endif
constexpr int LDG = FUSE_GATES ? 8192 : 3072;
namespace pg8 {
#define PG8_LAS __attribute__((address_space(3)))
typedef unsigned short bf16_t;
typedef short bf16x8 __attribute__((ext_vector_type(8)));
typedef float f32x4 __attribute__((ext_vector_type(4)));
typedef unsigned u32x4 __attribute__((ext_vector_type(4)));
constexpr int BM = 256, BK = 64, HALF = 128, HTB = HALF * BK * 2  , STAGE_BYTES = 8 * HTB, NXCD = 8, WGM = 8;

__host__ __device__ __forceinline__ int lds_byte(int r, int c) { const int st = (r >> 4) * 2 + (c >> 5), rr = r & 15, cc = c & 31, ob = rr * 64 + cc * 2; return st * 1024 + (ob ^ (((ob >> 9) & 1) << 5)); }
__host__ __device__ __forceinline__ void stage_rc(int b, int& R, int& C) { const int st = b / 1024, sb = b % 1024, swz = sb ^ (((sb >> 9) & 1) << 5); R = (st >> 1) * 16 + swz / 64; C = (st & 1) * 32 + (swz % 64) / 2; }
__host__ __device__ __forceinline__ int perm32(int rho) { const int n = rho >> 4, i = rho & 15; return 8 * (i >> 2) + 4 * n + (i & 3); }

struct Unit { int pm, pn; int br; };
struct Gemm { const bf16_t* A; const bf16_t* Bt; int M, N, K; const bf16_t* A1; const bf16_t* Bt1; const bf16_t* A2; const bf16_t* Bt2; };

struct StaticOrder {
    int nM, nN, nwg, G, c;
    __host__ __device__ void init(int M, int N, int G_, int c_) { nM = M / BM; nN = N / BM; nwg = nM * nN; G = G_; c = c_; }
    __host__ __device__ bool next(int i, Unit& u) const {
        const long L = (long)i * G + c; if (L >= nwg) return false;
        int wgid = (int)L; { const int q = nwg / NXCD, r = nwg % NXCD, xcd = wgid % NXCD, off = wgid / NXCD; wgid = (xcd < r ? xcd * (q + 1) : r * (q + 1) + (xcd - r) * q) + off; }
        const int nig = WGM * nN, gid = wgid / nig, fm = gid * WGM, gsz = (nM - fm) < WGM ? (nM - fm) : WGM;
        u.pm = fm + ((wgid % nig) % gsz); u.pn = (wgid % nig) / gsz; return true;
    }
    __device__ __forceinline__ void a_ready(const Unit&) const {}
    __device__ __forceinline__ void done(const Unit&) const {}
};
typedef float f32x2_t __attribute__((ext_vector_type(2))); typedef __bf16 bf16x2_t __attribute__((ext_vector_type(2)));
__device__ __forceinline__ unsigned cvt_pk_bf16(float lo, float hi) { f32x2_t v = {lo, hi}; bf16x2_t b = __builtin_convertvector(v, bf16x2_t); return __builtin_bit_cast(unsigned, b); }

__device__ __forceinline__ float fast_sigmoid(float x) { return __builtin_amdgcn_rcpf(1.0f + __builtin_amdgcn_exp2f(-1.4426950408889634f * x)); }
template <int ACT  > struct EpiBfStore {
    static constexpr bool PERM = true, AFTER_DRAIN = false;
    bf16_t* O; int ldc; const float* bias;
    __device__ __forceinline__ void operator()(const f32x4 (&acc)[2][2][4][2], const Unit& u, int wr, int wc, int fr, int fq) const {
        const int row0 = u.pm * BM + wr * 64 + fr, col0 = u.pn * BM + wc * 32 + 8 * fq;
        f32x4 bv[2][2];
#pragma unroll
        for (int bj = 0; bj < 2; ++bj)
#pragma unroll
            for (int n = 0; n < 2; ++n) bv[bj][n] = ACT ? *(const f32x4*)(bias + col0 + bj * HALF + 4 * n) : (f32x4){0.f, 0.f, 0.f, 0.f};
#pragma unroll
        for (int ai = 0; ai < 2; ++ai)
#pragma unroll
            for (int m = 0; m < 4; ++m) { bf16_t* rowp = O + (size_t)(row0 + ai * HALF + m * 16) * ldc + col0;
#pragma unroll
                for (int bj = 0; bj < 2; ++bj) { f32x4 v0 = acc[ai][bj][m][0] + bv[bj][0], v1 = acc[ai][bj][m][1] + bv[bj][1];
                    if (ACT == 1) {
#pragma unroll
                        for (int j = 0; j < 4; ++j) { v0[j] = fast_sigmoid(v0[j]); v1[j] = fast_sigmoid(v1[j]); } }
                    u32x4 w; w.x = cvt_pk_bf16(v0[0], v0[1]); w.y = cvt_pk_bf16(v0[2], v0[3]); w.z = cvt_pk_bf16(v1[0], v1[1]); w.w = cvt_pk_bf16(v1[2], v1[3]);
                    *(u32x4*)(rowp + bj * HALF) = w; } }
    }
};
__device__ __forceinline__ int qk_head_type(int c0) { return c0 < 512 ? 1 : (c0 == 512 ? 2 : ((c0 >= 960 && c0 < 1472) ? 3 : ((c0 >= 1472 && c0 < 1984) ? 4 : 0))); }
struct EpiInQK {
    static constexpr bool PERM = true, AFTER_DRAIN = false;
    bf16_t* O; int ldc; const float* gtab; PG8_LAS float* P;
    __device__ __forceinline__ void operator()(const f32x4 (&acc)[2][2][4][2], const Unit& u, int wr, int wc, int fr, int fq) const {
        const int row0 = u.pm * BM + wr * 64 + fr, col0 = u.pn * BM + wc * 32 + 8 * fq;
        const int wave = wr * 4 + wc;
        const bool normed = u.pn < 8;
        if (normed) {
#pragma unroll
            for (int bj = 0; bj < 2; ++bj)
#pragma unroll
                for (int ai = 0; ai < 2; ++ai)
#pragma unroll
                    for (int m = 0; m < 4; ++m) { const f32x4 a = acc[ai][bj][m][0], b = acc[ai][bj][m][1];
                        float s = (a[0] * a[0] + a[1] * a[1]) + (a[2] * a[2] + a[3] * a[3]) + (b[0] * b[0] + b[1] * b[1]) + (b[2] * b[2] + b[3] * b[3]);
                        { const auto r16 = __builtin_amdgcn_permlane16_swap(__float_as_uint(s), __float_as_uint(s), false, false); s = __uint_as_float(r16[0]) + __uint_as_float(r16[1]);
                          const auto r32 = __builtin_amdgcn_permlane32_swap(__float_as_uint(s), __float_as_uint(s), false, false); s = __uint_as_float(r32[0]) + __uint_as_float(r32[1]); }
                        if (fq == 0) P[wave * 256 + bj * 128 + ai * 64 + m * 16 + fr] = s; __builtin_amdgcn_sched_barrier(0); }
            asm volatile("s_waitcnt lgkmcnt(0)\n\ts_barrier" ::: "memory");
        }
#pragma unroll
        for (int bj = 0; bj < 2; ++bj) {
            const int ty = normed ? qk_head_type(u.pn * BM + bj * HALF + (wc >> 1) * 64) : 0;
            const float* gp = gtab + (ty ? ty - 1 : 0) * 64;
            f32x4 g0 = {1.f, 1.f, 1.f, 1.f}, g1 = {1.f, 1.f, 1.f, 1.f};
            if (ty) { g0 = *(const f32x4*)(gp + (wc & 1) * 32 + 8 * fq); g1 = *(const f32x4*)(gp + (wc & 1) * 32 + 8 * fq + 4); }
#pragma unroll
            for (int ai = 0; ai < 2; ++ai)
#pragma unroll
                for (int m = 0; m < 4; ++m) { bf16_t* rowp = O + (size_t)(row0 + ai * HALF + m * 16) * ldc + col0 + bj * HALF;
                    float rsv = 1.f;
                    if (ty) { const int pi = bj * 128 + ai * 64 + m * 16 + fr; rsv = __builtin_amdgcn_rsqf((P[wave * 256 + pi] + P[(wave ^ 1) * 256 + pi]) * (1.f / 64.f) + 1e-6f); }
                    const f32x4 v0 = acc[ai][bj][m][0] * g0 * rsv, v1 = acc[ai][bj][m][1] * g1 * rsv;
                    u32x4 w; w.x = cvt_pk_bf16(v0[0], v0[1]); w.y = cvt_pk_bf16(v0[2], v0[3]); w.z = cvt_pk_bf16(v1[0], v1[1]); w.w = cvt_pk_bf16(v1[2], v1[3]);
                    *(u32x4*)rowp = w; __builtin_amdgcn_sched_barrier(0); } }
    }
};
struct EpiGate8 {
    static constexpr bool PERM = true, AFTER_DRAIN = false;
    unsigned char* O; int ldc; const float* bias;
    __device__ __forceinline__ void operator()(const f32x4 (&acc)[2][2][4][2], const Unit& u, int wr, int wc, int fr, int fq) const {
        const int row0 = u.pm * BM + wr * 64 + fr, col0 = u.pn * BM + wc * 32 + 8 * fq;
        f32x4 bv[2][2];
#pragma unroll
        for (int bj = 0; bj < 2; ++bj)
#pragma unroll
            for (int n = 0; n < 2; ++n) bv[bj][n] = *(const f32x4*)(bias + col0 + bj * HALF + 4 * n);
        const int odd = fq & 1;
#pragma unroll
        for (int ai = 0; ai < 2; ++ai)
#pragma unroll
            for (int m = 0; m < 4; ++m) { unsigned char* rowp = O + (size_t)(row0 + ai * HALF + m * 16) * ldc + col0;
                unsigned wlo[2], whi[2];
#pragma unroll
                for (int bj = 0; bj < 2; ++bj) { f32x4 v0 = acc[ai][bj][m][0] + bv[bj][0], v1 = acc[ai][bj][m][1] + bv[bj][1];
#pragma unroll
                    for (int j = 0; j < 4; ++j) { v0[j] = fmaxf(fast_sigmoid(v0[j]), 0.001953125f); v1[j] = fmaxf(fast_sigmoid(v1[j]), 0.001953125f); }
                    int w0 = 0, w1 = 0;
                    w0 = __builtin_amdgcn_cvt_pk_fp8_f32(v0[0], v0[1], w0, false); w0 = __builtin_amdgcn_cvt_pk_fp8_f32(v0[2], v0[3], w0, true);
                    w1 = __builtin_amdgcn_cvt_pk_fp8_f32(v1[0], v1[1], w1, false); w1 = __builtin_amdgcn_cvt_pk_fp8_f32(v1[2], v1[3], w1, true);
                    wlo[bj] = (unsigned)w0; whi[bj] = (unsigned)w1; }
                const auto s0 = __builtin_amdgcn_permlane16_swap(wlo[0], wlo[1], false, false);
                const auto s1 = __builtin_amdgcn_permlane16_swap(whi[0], whi[1], false, false);
                u32x4 w; w.x = s0[0]; w.y = s1[0]; w.z = s0[1]; w.w = s1[1];
                *(u32x4*)(rowp + (odd ? HALF - 8 : 0)) = w; }
    }
};
template <int MODE> struct EpiProj {
    static constexpr bool PERM = true, AFTER_DRAIN = false;
    const unsigned char* G; int ldg; bf16_t* Mb; bf16_t* MG;
    __device__ __forceinline__ void operator()(const f32x4 (&acc)[2][2][4][2], const Unit& u, int wr, int wc, int fr, int fq) const {
        const int row0 = u.pm * BM + wr * 64 + fr, col0 = u.pn * BM + wc * 32 + 8 * fq;
#pragma unroll
        for (int ai = 0; ai < 2; ++ai)
#pragma unroll
            for (int m = 0; m < 4; ++m) { const size_t r = (size_t)(row0 + ai * HALF + m * 16);
#pragma unroll
                for (int bj = 0; bj < 2; ++bj) { const int c = col0 + bj * HALF;
                    const uint2 gw = *(const uint2*)(G + r * ldg + c);
                    typedef float f2g __attribute__((ext_vector_type(2)));
                    const f2g ga = __builtin_amdgcn_cvt_pk_f32_fp8((int)gw.x, false), gb = __builtin_amdgcn_cvt_pk_f32_fp8((int)gw.x, true), gc = __builtin_amdgcn_cvt_pk_f32_fp8((int)gw.y, false), gd = __builtin_amdgcn_cvt_pk_f32_fp8((int)gw.y, true);
                    const f32x4 g0 = {ga[0], ga[1], gb[0], gb[1]}, g1 = {gc[0], gc[1], gd[0], gd[1]};
                    f32x4 v0 = acc[ai][bj][m][0] * g0, v1 = acc[ai][bj][m][1] * g1;
                    bf16_t* mp = Mb + r * 1024 + c;
                    if (MODE >= 1) { const u32x4 mw = *(const u32x4*)mp;
                        v0[0] += __uint_as_float(mw.x << 16); v0[1] += __uint_as_float(mw.x & 0xffff0000u); v0[2] += __uint_as_float(mw.y << 16); v0[3] += __uint_as_float(mw.y & 0xffff0000u);
                        v1[0] += __uint_as_float(mw.z << 16); v1[1] += __uint_as_float(mw.z & 0xffff0000u); v1[2] += __uint_as_float(mw.w << 16); v1[3] += __uint_as_float(mw.w & 0xffff0000u); }
                    u32x4 w; w.x = cvt_pk_bf16(v0[0], v0[1]); w.y = cvt_pk_bf16(v0[2], v0[3]); w.z = cvt_pk_bf16(v1[0], v1[1]); w.w = cvt_pk_bf16(v1[2], v1[3]);
                    if (MODE <= 1) *(u32x4*)mp = w; else *(u32x4*)(MG + r * 1024 + c) = w; } }
    }
};
struct ChainOrder { StaticOrder S;
    __device__ bool next(int i, Unit& u) const { const int t = i / 3; if (!S.next(t, u)) return false; u.br = i - 3 * t; return true; }
    __device__ __forceinline__ void a_ready(const Unit&) const {}
    __device__ __forceinline__ void done(const Unit&) const {}
};
struct EpiChain {
    static constexpr bool PERM = true, AFTER_DRAIN = false;
    const unsigned char* G; bf16_t* MG;
    __device__ __forceinline__ void operator()(const f32x4 (&)[2][2][4][2], const Unit&, int, int, int, int) const {}
    __device__ __forceinline__ void chain(f32x4 (&acc)[2][2][4][2], const Unit& u, int wr, int wc, int fr, int fq) const {
        typedef float f2g __attribute__((ext_vector_type(2)));
        const int row0 = u.pm * BM + wr * 64 + fr, col0 = u.pn * BM + wc * 32 + 8 * fq, br = u.br;
#pragma unroll
        for (int ai = 0; ai < 2; ++ai)
#pragma unroll
            for (int m = 0; m < 4; ++m) { const size_t r = (size_t)(row0 + ai * HALF + m * 16);
#pragma unroll
                for (int bj = 0; bj < 2; ++bj) { const int c = col0 + bj * HALF;
                    const uint2 ga = *(const uint2*)(G + r * LDG + br * 1024 + c);
                    const f2g a0 = __builtin_amdgcn_cvt_pk_f32_fp8((int)ga.x, false), a1 = __builtin_amdgcn_cvt_pk_f32_fp8((int)ga.x, true), a2 = __builtin_amdgcn_cvt_pk_f32_fp8((int)ga.y, false), a3 = __builtin_amdgcn_cvt_pk_f32_fp8((int)ga.y, true);
                    f32x4 s0 = {a0[0], a0[1], a1[0], a1[1]}, s1 = {a2[0], a2[1], a3[0], a3[1]};
                    if (br < 2) { const uint2 gb = *(const uint2*)(G + r * LDG + (br + 1) * 1024 + c);
                        const f2g b0 = __builtin_amdgcn_cvt_pk_f32_fp8((int)gb.x, false), b1 = __builtin_amdgcn_cvt_pk_f32_fp8((int)gb.x, true), b2 = __builtin_amdgcn_cvt_pk_f32_fp8((int)gb.y, false), b3 = __builtin_amdgcn_cvt_pk_f32_fp8((int)gb.y, true);
                        s0[0] *= __builtin_amdgcn_rcpf(b0[0]); s0[1] *= __builtin_amdgcn_rcpf(b0[1]); s0[2] *= __builtin_amdgcn_rcpf(b1[0]); s0[3] *= __builtin_amdgcn_rcpf(b1[1]);
                        s1[0] *= __builtin_amdgcn_rcpf(b2[0]); s1[1] *= __builtin_amdgcn_rcpf(b2[1]); s1[2] *= __builtin_amdgcn_rcpf(b3[0]); s1[3] *= __builtin_amdgcn_rcpf(b3[1]);
                        acc[ai][bj][m][0] *= s0; acc[ai][bj][m][1] *= s1; }
                    else { const f32x4 v0 = acc[ai][bj][m][0] * s0, v1 = acc[ai][bj][m][1] * s1;
                        u32x4 w; w.x = cvt_pk_bf16(v0[0], v0[1]); w.y = cvt_pk_bf16(v0[2], v0[3]); w.z = cvt_pk_bf16(v1[0], v1[1]); w.w = cvt_pk_bf16(v1[2], v1[3]);
                        *(u32x4*)(MG + r * 1024 + c) = w; } } }
    }
};
template <bool HIN_BF16> struct EpiResid {
    static constexpr bool PERM = true, AFTER_DRAIN = false;
    const void* hin; bf16_t* hm; const float* gate;
    __device__ __forceinline__ void operator()(const f32x4 (&acc)[2][2][4][2], const Unit& u, int wr, int wc, int fr, int fq) const {
        const int row0 = u.pm * BM + wr * 64 + fr, col0 = u.pn * BM + wc * 32 + 8 * fq;
        const float* gp = gate + (size_t)(u.pm >> 3) * 6144 + col0;
        f32x4 gv[2][2];
#pragma unroll
        for (int bj = 0; bj < 2; ++bj)
#pragma unroll
            for (int n = 0; n < 2; ++n) gv[bj][n] = *(const f32x4*)(gp + bj * HALF + 4 * n);
#pragma unroll
        for (int ai = 0; ai < 2; ++ai)
#pragma unroll
            for (int m = 0; m < 4; ++m) { const size_t r = (size_t)(row0 + ai * HALF + m * 16);
#pragma unroll
                for (int bj = 0; bj < 2; ++bj) { const size_t o = r * 1024 + col0 + bj * HALF;
                    f32x4 h0, h1;
                    if constexpr (HIN_BF16) { const u32x4 hb = *(const u32x4*)((const bf16_t*)hin + o);
                        h0 = (f32x4){__uint_as_float(hb.x << 16), __uint_as_float(hb.x & 0xffff0000u), __uint_as_float(hb.y << 16), __uint_as_float(hb.y & 0xffff0000u)};
                        h1 = (f32x4){__uint_as_float(hb.z << 16), __uint_as_float(hb.z & 0xffff0000u), __uint_as_float(hb.w << 16), __uint_as_float(hb.w & 0xffff0000u)}; }
                    else { h0 = *(const f32x4*)((const float*)hin + o); h1 = *(const f32x4*)((const float*)hin + o + 4); }
                    const f32x4 v0 = h0 + gv[bj][0] * acc[ai][bj][m][0], v1 = h1 + gv[bj][1] * acc[ai][bj][m][1];
                    u32x4 w; w.x = cvt_pk_bf16(v0[0], v0[1]); w.y = cvt_pk_bf16(v0[2], v0[3]); w.z = cvt_pk_bf16(v1[0], v1[1]); w.w = cvt_pk_bf16(v1[2], v1[3]);
                    *(u32x4*)(hm + o) = w; } }
    }
};


template <class Epi, class Sched, bool ALIGN_EPI = false, bool SP2 = false, bool CHAIN = false>
__device__ __forceinline__ void gemm_phase(PG8_LAS unsigned char* lds, const Gemm g, const Sched& S, const Epi& E, const int tid) {
    const int wid = __builtin_amdgcn_readfirstlane(tid >> 6), lane = tid & 63, wr = wid >> 2, wc = wid & 3, fr = lane & 15, fq = lane >> 4;
    const int K = g.K, nt = K / BK;
    unsigned voffA[2], voffB[2];
#pragma unroll
    for (int i = 0; i < 2; ++i) { int R, C; stage_rc(tid * 16 + i * 8192, R, C); const int Rb = Epi::PERM ? ((R & ~31) + perm32(R & 31)) : R;
        voffA[i] = (unsigned)(R * K + C) * 2u; voffB[i] = (unsigned)(Rb * K + C) * 2u; }
    const size_t kstep = (size_t)(BK * 2);
    const size_t hstep = (size_t)HALF * K * 2;
    const size_t tstep = 2 * hstep;
    const unsigned ldsw = (unsigned)wid * 1024u;
    const int aoff = lds_byte(wr * 64 + fr, fq * 8), boff = lds_byte(wc * 32 + fr, fq * 8);
#define PG8_SA(b, h) (((b) * 2 + (h)) * HTB)
#define PG8_SB(b, h) ((4 + (b) * 2 + (h)) * HTB)
#define PG8_STAGE(bufoff, gbase, voff) do { _Pragma("unroll") for (int _i = 0; _i < 2; ++_i) \
        __builtin_amdgcn_global_load_lds((const unsigned*)((const char*)(gbase) + (voff)[_i]), (PG8_LAS unsigned*)(lds + (bufoff) + ldsw + _i * 8192), 16, 0, 0); } while (0)
#define PG8_LDA(dst, b, h) do { _Pragma("unroll") for (int m = 0; m < 4; ++m) _Pragma("unroll") for (int k = 0; k < 2; ++k) dst[m][k] = *(const PG8_LAS bf16x8*)(lds + PG8_SA(b, h) + aoff + m * 2048 + k * 1024); } while (0)
#define PG8_LDB(dst, b, h) do { _Pragma("unroll") for (int n = 0; n < 2; ++n) _Pragma("unroll") for (int k = 0; k < 2; ++k) dst[n][k] = *(const PG8_LAS bf16x8*)(lds + PG8_SB(b, h) + boff + n * 2048 + k * 1024); } while (0)
#define PG8_MMA(ai, bj, At, Bt) do { __builtin_amdgcn_s_setprio(1); _Pragma("unroll") for (int m = 0; m < 4; ++m) _Pragma("unroll") for (int n = 0; n < 2; ++n) _Pragma("unroll") for (int k = 0; k < 2; ++k) \
        acc[ai][bj][m][n] = __builtin_amdgcn_mfma_f32_16x16x32_bf16(Bt[n][k], At[m][k], acc[ai][bj][m][n], 0, 0, 0); __builtin_amdgcn_s_setprio(0); } while (0)
#define PG8_WAIT_V(n) asm volatile("s_waitcnt vmcnt(" #n ")" ::: "memory")
#define PG8_WAIT_L(n) asm volatile("s_waitcnt lgkmcnt(" #n ")" ::: "memory")
#define PG8_BAR __builtin_amdgcn_s_barrier()
#define PG8_SCHED __builtin_amdgcn_sched_barrier(0)
    Unit cur, nxt; int ui = 0;
    if (!S.next(0, cur)) return;
    f32x4 acc[2][2][4][2];
#pragma unroll
    for (int a = 0; a < 2; ++a)
#pragma unroll
        for (int b = 0; b < 2; ++b)
#pragma unroll
            for (int m = 0; m < 4; ++m)
#pragma unroll
                for (int n = 0; n < 2; ++n) acc[a][b][m][n] = (f32x4){0.f, 0.f, 0.f, 0.f};
    bf16x8 At[4][2], B0[2][2], B1[2][2];
#define PG8_SELA(u_) (!CHAIN || (u_).br == 0 ? g.A : ((u_).br == 1 ? g.A1 : g.A2))
#define PG8_SELB(u_) (!CHAIN || (u_).br == 0 ? g.Bt : ((u_).br == 1 ? g.Bt1 : g.Bt2))
    const char* cA = (const char*)PG8_SELA(cur) + (size_t)cur.pm * tstep; const char* cB = (const char*)PG8_SELB(cur) + (size_t)cur.pn * tstep;
    S.a_ready(cur);
    if constexpr (SP2) {
        PG8_STAGE(PG8_SB(0, 0), cB, voffB); PG8_STAGE(PG8_SB(0, 1), cB + hstep, voffB); PG8_STAGE(PG8_SA(0, 0), cA, voffA); PG8_STAGE(PG8_SA(0, 1), cA + hstep, voffA);
        if (wr == 1) PG8_BAR;
        PG8_WAIT_V(2); PG8_BAR;
        PG8_STAGE(PG8_SB(1, 0), cB + kstep, voffB); PG8_STAGE(PG8_SA(1, 0), cA + kstep, voffA); PG8_STAGE(PG8_SB(1, 1), cB + hstep + kstep, voffB);
        PG8_WAIT_V(6); PG8_BAR;
    } else {
        PG8_STAGE(PG8_SB(0, 0), cB, voffB); PG8_STAGE(PG8_SA(0, 0), cA, voffA); PG8_STAGE(PG8_SB(0, 1), cB + hstep, voffB); PG8_STAGE(PG8_SA(0, 1), cA + hstep, voffA);
        if (wr == 1) PG8_BAR;
        PG8_WAIT_V(4); PG8_BAR;
        PG8_STAGE(PG8_SB(1, 0), cB + kstep, voffB); PG8_STAGE(PG8_SA(1, 0), cA + kstep, voffA); PG8_STAGE(PG8_SB(1, 1), cB + hstep + kstep, voffB);
        PG8_WAIT_V(6); PG8_BAR;
    }
    for (;;) {
        const bool has_next = S.next(ui + 1, nxt);
        const char* nA = has_next ? (const char*)PG8_SELA(nxt) + (size_t)nxt.pm * tstep : cA; const char* nB = has_next ? (const char*)PG8_SELB(nxt) + (size_t)nxt.pn * tstep : cB;
        for (int t = 0; t < nt; t += 2) {
            const bool last = (t == nt - 2);
            const char* a1 = cA + (size_t)(t + 1) * kstep;
            const char* a2 = last ? nA : cA + (size_t)(t + 2) * kstep; const char* b2 = last ? nB : cB + (size_t)(t + 2) * kstep;
            const char* a3 = a2 + kstep; const char* b3 = b2 + kstep;
            if (last && has_next) S.a_ready(nxt);
            if constexpr (SP2) {
            PG8_LDB(B0, 0, 0); PG8_LDB(B1, 0, 1); PG8_SCHED; PG8_LDA(At, 0, 0); PG8_STAGE(PG8_SA(1, 1), a1 + hstep, voffA);
            PG8_WAIT_V(8); PG8_WAIT_L(0); PG8_BAR; PG8_MMA(0, 0, At, B0); PG8_MMA(0, 1, At, B1); PG8_BAR; PG8_SCHED;
            PG8_LDA(At, 0, 1); PG8_STAGE(PG8_SB(0, 0), b2, voffB); PG8_STAGE(PG8_SB(0, 1), b2 + hstep, voffB); PG8_STAGE(PG8_SA(0, 0), a2, voffA);
            PG8_WAIT_V(8); PG8_WAIT_L(0); PG8_BAR; PG8_MMA(1, 0, At, B0); PG8_MMA(1, 1, At, B1); PG8_BAR; PG8_SCHED;
            PG8_LDB(B0, 1, 0); PG8_LDB(B1, 1, 1); PG8_SCHED; PG8_LDA(At, 1, 0); PG8_STAGE(PG8_SA(0, 1), a2 + hstep, voffA);
            PG8_WAIT_V(8); PG8_WAIT_L(0); PG8_BAR; PG8_MMA(0, 0, At, B0); PG8_MMA(0, 1, At, B1); PG8_BAR; PG8_SCHED;
            PG8_LDA(At, 1, 1); PG8_STAGE(PG8_SB(1, 0), b3, voffB); PG8_STAGE(PG8_SB(1, 1), b3 + hstep, voffB); PG8_STAGE(PG8_SA(1, 0), a3, voffA);
            PG8_WAIT_V(8); PG8_WAIT_L(0); PG8_BAR; PG8_MMA(1, 0, At, B0); PG8_MMA(1, 1, At, B1); PG8_BAR; PG8_SCHED;
            } else {
            PG8_LDB(B0, 0, 0); PG8_SCHED; PG8_LDA(At, 0, 0); PG8_STAGE(PG8_SA(1, 1), a1 + hstep, voffA);
            PG8_WAIT_L(8); PG8_BAR; PG8_WAIT_L(0); PG8_MMA(0, 0, At, B0); PG8_BAR; PG8_SCHED;
            PG8_LDB(B1, 0, 1); PG8_STAGE(PG8_SB(0, 0), b2, voffB);
            PG8_BAR; PG8_WAIT_L(0); PG8_MMA(0, 1, At, B1); PG8_BAR;
            PG8_LDA(At, 0, 1); PG8_STAGE(PG8_SA(0, 0), a2, voffA);
            PG8_BAR; PG8_WAIT_L(0); PG8_MMA(1, 0, At, B0); PG8_BAR; PG8_SCHED;
            PG8_STAGE(PG8_SB(0, 1), b2 + hstep, voffB);
            PG8_WAIT_V(6); PG8_BAR; PG8_MMA(1, 1, At, B1); PG8_BAR;
            PG8_LDB(B0, 1, 0); PG8_SCHED; PG8_LDA(At, 1, 0); PG8_STAGE(PG8_SA(0, 1), a2 + hstep, voffA);
            PG8_WAIT_L(8); PG8_BAR; PG8_WAIT_L(0); PG8_MMA(0, 0, At, B0); PG8_BAR; PG8_SCHED;
            PG8_LDB(B1, 1, 1); PG8_STAGE(PG8_SB(1, 0), b3, voffB);
            PG8_BAR; PG8_WAIT_L(0); PG8_MMA(0, 1, At, B1); PG8_BAR;
            PG8_LDA(At, 1, 1); PG8_STAGE(PG8_SA(1, 0), a3, voffA);
            PG8_BAR; PG8_WAIT_L(0); PG8_MMA(1, 0, At, B0); PG8_BAR; PG8_SCHED;
            PG8_STAGE(PG8_SB(1, 1), b3 + hstep, voffB);
            PG8_WAIT_V(6); PG8_BAR; PG8_MMA(1, 1, At, B1); PG8_BAR;
            }
        }
        if constexpr (ALIGN_EPI) { if (wr == 0) PG8_BAR; }
        if constexpr (CHAIN) { E.chain(acc, cur, wr, wc, fr, fq); } else
        if constexpr (!Epi::AFTER_DRAIN) { E(acc, cur, wr, wc, fr, fq); S.done(cur); }
        if (!has_next) break;
        if (!CHAIN || cur.br == 2)
#pragma unroll
        for (int a = 0; a < 2; ++a)
#pragma unroll
            for (int b = 0; b < 2; ++b)
#pragma unroll
                for (int m = 0; m < 4; ++m)
#pragma unroll
                    for (int n = 0; n < 2; ++n) acc[a][b][m][n] = (f32x4){0.f, 0.f, 0.f, 0.f};
        cur = nxt; cA = nA; cB = nB; ++ui;
        if constexpr (ALIGN_EPI) { if (wr == 1) PG8_BAR; }
    }
    PG8_WAIT_V(0);
    if constexpr (!ALIGN_EPI) { if (wr == 0) PG8_BAR; }
    PG8_BAR;
    if constexpr (Epi::AFTER_DRAIN) { E.fused(acc, cur, wr, wc, fr, fq, lds, wid, lane); S.done(cur); }
#undef PG8_SELA
#undef PG8_SELB
#undef PG8_SA
#undef PG8_SB
#undef PG8_STAGE
#undef PG8_LDA
#undef PG8_LDB
#undef PG8_MMA
#undef PG8_WAIT_V
#undef PG8_WAIT_L
#undef PG8_BAR
#undef PG8_SCHED
}
}


constexpr size_t WS_UB = WS_Z + 160 * MiB;
constexpr size_t WS_VB = WS_Z + 192 * MiB;
__device__ __forceinline__ void ph_uvprep(const Ids& id, const Params& p, int layer) {
    const float4* U = (const float4*)(p.peer_u + (size_t)layer * 16384 * 1024); const float4* V = (const float4*)(p.peer_v + (size_t)layer * 16384 * 1024);
    uint2* UB = (uint2*)(p.ws + WS_UB); uint2* VB = (uint2*)(p.ws + WS_VB);
    const size_t n4 = (size_t)16384 * 1024 / 4;
    for (size_t i = (size_t)id.bid * NTHR + id.tid; i < n4; i += (size_t)gridDim.x * NTHR) {
        const float4 a = U[i], b = V[i];
        uint2 oa, ob; oa.x = cvt_pk(a.x, a.y); oa.y = cvt_pk(a.z, a.w); ob.x = cvt_pk(b.x, b.y); ob.y = cvt_pk(b.z, b.w);
        UB[i] = oa; VB[i] = ob;
    }
}
__device__ __forceinline__ float wave_sum_dpp(float v) {
#pragma unroll
    for (int o = 32; o >= 1; o >>= 1) v += __shfl_xor(v, o);
    return v;
}
__device__ __forceinline__ void ph_peerexp2(const Ids& id, const Params& p, int layer) {
    const bf16* N = (const bf16*)(p.ws + WS_N); const int* PE = (const int*)(p.ws + WS_PE); const float* PG = (const float*)(p.ws + WS_PG);
    const bf16* UB = (const bf16*)(p.ws + WS_UB); const bf16* VB = (const bf16*)(p.ws + WS_VB);
    const float* mod = (const float*)(p.ws + WS_MOD) + (size_t)layer * 16 * 6144;
    const int lane = id.tid & 63, wave = __builtin_amdgcn_readfirstlane(id.tid >> 6);
    for (int tok = id.bid * 8 + wave; tok < NTOK; tok += gridDim.x * 8) {
        const int b = tok >> 11;
        float x[16];
        { const uint4 x0 = *(const uint4*)(N + (size_t)tok * 1024 + lane * 8), x1 = *(const uint4*)(N + (size_t)tok * 1024 + 512 + lane * 8); unpack8(x0, x); unpack8(x1, x + 8); }
        const int e0 = PE[(size_t)tok * 128 + lane], e1 = PE[(size_t)tok * 128 + 64 + lane];
        const float g0 = PG[(size_t)tok * 128 + lane], g1 = PG[(size_t)tok * 128 + 64 + lane];
        float d0 = 0.f, d1 = 0.f;
#pragma unroll 4
        for (int j = 0; j < 64; ++j) {
            const int ea = __shfl(e0, j), eb = __shfl(e1, j);
            const bf16* ua = UB + (size_t)ea * 1024 + lane * 8; const bf16* ub = UB + (size_t)eb * 1024 + lane * 8;
            const uint4 a0 = *(const uint4*)ua, a1 = *(const uint4*)(ua + 512), b0 = *(const uint4*)ub, b1 = *(const uint4*)(ub + 512);
            float f[8]; float sa = 0.f, sb = 0.f;
            unpack8(a0, f);
#pragma unroll
            for (int i = 0; i < 8; ++i) sa += x[i] * f[i];
            unpack8(a1, f);
#pragma unroll
            for (int i = 0; i < 8; ++i) sa += x[8 + i] * f[i];
            unpack8(b0, f);
#pragma unroll
            for (int i = 0; i < 8; ++i) sb += x[i] * f[i];
            unpack8(b1, f);
#pragma unroll
            for (int i = 0; i < 8; ++i) sb += x[8 + i] * f[i];
            sa = wave_sum_dpp(sa); sb = wave_sum_dpp(sb);
            if (lane == j) { d0 = sa; d1 = sb; }
        }
        const float w0 = g0 * (0.5f * d0 * (1.f + erff(d0 * 0.70710678118654752f))), w1 = g1 * (0.5f * d1 * (1.f + erff(d1 * 0.70710678118654752f)));
        float acc[16];
#pragma unroll
        for (int i = 0; i < 16; ++i) acc[i] = 0.f;
#pragma unroll 4
        for (int j = 0; j < 64; ++j) {
            const int ea = __shfl(e0, j), eb = __shfl(e1, j); const float wa = __shfl(w0, j), wb = __shfl(w1, j);
            const bf16* va = VB + (size_t)ea * 1024 + lane * 8; const bf16* vb = VB + (size_t)eb * 1024 + lane * 8;
            const uint4 a0 = *(const uint4*)va, a1 = *(const uint4*)(va + 512), b0 = *(const uint4*)vb, b1 = *(const uint4*)(vb + 512);
            float f[8];
            unpack8(a0, f);
#pragma unroll
            for (int i = 0; i < 8; ++i) acc[i] += wa * f[i];
            unpack8(a1, f);
#pragma unroll
            for (int i = 0; i < 8; ++i) acc[8 + i] += wa * f[i];
            unpack8(b0, f);
#pragma unroll
            for (int i = 0; i < 8; ++i) acc[i] += wb * f[i];
            unpack8(b1, f);
#pragma unroll
            for (int i = 0; i < 8; ++i) acc[8 + i] += wb * f[i];
        }
        const float* gp = mod + (size_t)b * 6144 + 5 * 1024;
        float* op = p.out + (size_t)tok * 1024;
#pragma unroll
        for (int hh = 0; hh < 2; ++hh)
#pragma unroll
            for (int q = 0; q < 2; ++q) { const int c = hh * 512 + lane * 8 + q * 4;
                const float4 g = *(const float4*)(gp + c); float4 o = *(const float4*)(op + c);
                o.x += g.x * acc[hh * 8 + q * 4 + 0]; o.y += g.y * acc[hh * 8 + q * 4 + 1]; o.z += g.z * acc[hh * 8 + q * 4 + 2]; o.w += g.w * acc[hh * 8 + q * 4 + 3];
                *(float4*)(op + c) = o; }
    }
}


__device__ __forceinline__ unsigned f2key(float x) { const unsigned b = __float_as_uint(x); return (b & 0x80000000u) ? ~b : (b | 0x80000000u); }
__device__ __forceinline__ float key2f(unsigned k) { return __uint_as_float((k & 0x80000000u) ? (k & 0x7fffffffu) : ~k); }
__device__ __forceinline__ void sort16_desc(unsigned (&v)[16]) {
#pragma unroll
    for (int k = 2; k <= 16; k <<= 1)
#pragma unroll
        for (int j = k >> 1; j > 0; j >>= 1)
#pragma unroll
            for (int i = 0; i < 16; ++i) { const int l = i ^ j;
                if (l > i) { const bool desc = (i & k) == 0; const unsigned mx = max(v[i], v[l]), mn = min(v[i], v[l]); v[i] = desc ? mx : mn; v[l] = desc ? mn : mx; } }
}
__device__ __forceinline__ void merge16_desc(unsigned (&R)[16], const unsigned (&G)[16]) {
#pragma unroll
    for (int i = 0; i < 16; ++i) R[i] = max(R[i], G[15 - i]);
#pragma unroll
    for (int j = 8; j > 0; j >>= 1)
#pragma unroll
        for (int i = 0; i < 16; ++i) { const int l = i ^ j; if (l > i) { const unsigned mx = max(R[i], R[l]), mn = min(R[i], R[l]); R[i] = mx; R[l] = mn; } }
}
__device__ __forceinline__ void cross_half_top16(unsigned (&T)[16], const unsigned (&R)[16], int hf) {
    unsigned O[16];
#pragma unroll
    for (int i = 0; i < 16; ++i) O[i] = __shfl_xor(R[i], 32);
#pragma unroll
    for (int i = 0; i < 16; ++i) { unsigned oi = O[i], ri = R[i], rj = R[15 - i], oj = O[15 - i]; asm volatile("" : "+v"(oi), "+v"(ri), "+v"(rj), "+v"(oj)); const unsigned a = hf ? oi : ri, b = hf ? rj : oj; T[i] = max(a, b); }
}
__device__ __forceinline__ void ph_peersel2(const Ids& id, const Params& p, int layer, float* lds) {
    const bf16* PQ = (const bf16*)(p.ws + WS_PQ); int* PE = (int*)(p.ws + WS_PE); float* PG = (float*)(p.ws + WS_PG);
    const bf16* SKB = (const bf16*)(p.ws + WS_SKB);
    const int lane = id.tid & 63, wave = __builtin_amdgcn_readfirstlane(id.tid >> 6), r = lane & 31, hf = lane >> 5;
    typedef __attribute__((address_space(3))) unsigned lds_u32;
    lds_u32* tl = (lds_u32*)((lds_u8*)lds + wave * 8192) + lane;
    typedef unsigned u4v __attribute__((ext_vector_type(4)));
    const int hg = id.bid & 1, tid_ = id.tid;
    lds_u8* skl = (lds_u8*)lds + 65536;
    for (int tile = (id.bid >> 1) * 8 + wave; tile < 1024; tile += ((int)gridDim.x >> 1) * 8) {
        const int tok0 = tile * 32;
#define SK_DMA(step, bufo) do { _Pragma("unroll") for (int i_ = 0; i_ < 4; ++i_) { int P = (wave * 4 + i_) * 64 + lane; asm volatile("" : "+v"(P));     \
        const int row = P >> 4, col = (P & 15) ^ (row & 15); \
        __builtin_amdgcn_global_load_lds((const __attribute__((address_space(1))) unsigned*)(SKB + (size_t)(hg * 8 + (step)) * 16384 + row * 128 + col * 8), \
            (__attribute__((address_space(3))) unsigned*)(skl + (bufo) + (wave * 4 + i_) * 1024), 16, 0, 0); } } while (0)
        __syncthreads();
        SK_DMA(0, 0);
        __syncthreads();
        for (int hh = 0; hh < 4; ++hh) {
            const int h = hg * 4 + hh;
            unsigned T0[16], T1[16];
#pragma unroll
            for (int pp = 0; pp < 2; ++pp) {
                const int step = hh * 2 + pp, bufo = (step & 1) * 32768;
                s16x8 bq[8];
#pragma unroll
                for (int kk = 0; kk < 8; ++kk) bq[kk] = *(const s16x8*)(PQ + (size_t)(tok0 + r) * 2048 + h * 256 + pp * 128 + kk * 16 + hf * 8);
                if (step < 7) SK_DMA(step + 1, 32768 - bufo);
                const lds_u8* skp = skl + bufo + r * 256;
                unsigned R[16];
#pragma unroll
                for (int kb = 0; kb < 4; ++kb) {
                    f32x16 acc;
#pragma unroll
                    for (int i = 0; i < 16; ++i) acc[i] = 0.f;
#pragma unroll
                    for (int kk = 0; kk < 8; ++kk) acc = __builtin_amdgcn_mfma_f32_32x32x16_bf16(ldsv8(skp + kb * 32 * 256 + (((kk * 2 + hf) ^ (r & 15)) << 4)), bq[kk], acc, 0, 0, 0);
                    __builtin_amdgcn_sched_barrier(0);
                    unsigned G[16];
#pragma unroll
                    for (int i = 0; i < 16; ++i) { const int kidx = kb * 32 + (i & 3) + 8 * (i >> 2) + 4 * hf; G[i] = (f2key(acc[i]) & ~127u) | (unsigned)(127 - kidx); }
                    sort16_desc(G);
                    if (kb == 0) {
#pragma unroll
                        for (int i = 0; i < 16; ++i) R[i] = G[i];
                    } else merge16_desc(R, G);
                }
                __syncthreads();
                if (pp == 0) cross_half_top16(T0, R, hf); else cross_half_top16(T1, R, hf);
            }
            {
#pragma unroll
              for (int j = 8; j > 0; j >>= 1)
#pragma unroll
                for (int i = 0; i < 16; ++i) { const int l = i ^ j; if (l > i) { const unsigned mx0 = max(T0[i], T0[l]), mn0 = min(T0[i], T0[l]), mx1 = max(T1[i], T1[l]), mn1 = min(T1[i], T1[l]); T0[i] = mx0; T0[l] = mn0; T1[i] = mx1; T1[l] = mn1; } }
            }
            float v0[16], v1[16];
#pragma unroll
            for (int i = 0; i < 16; ++i) { tl[i * 64] = T0[i]; tl[(16 + i) * 64] = T1[i]; v0[i] = key2f(T0[i] & ~127u); v1[i] = key2f(T1[i] & ~127u); }
            unsigned R2[16];
            {
                static constexpr unsigned char PA0[32] = {0, 0, 0, 0, 0, 0, 0, 0, 1, 1, 1, 1, 2, 2, 2, 3, 3, 4, 5, 6, 7, 8, 10, 12, 14, 0, 0, 0, 0, 0, 0, 0}; static constexpr unsigned char PB0[32] = {0, 2, 4, 6, 8, 10, 12, 14, 0, 2, 4, 6, 0, 2, 4, 1, 3, 1, 0, 0, 0, 0, 0, 0, 0, 0, 0, 0, 0, 0, 0, 0};
                static constexpr unsigned char PA1[32] = {0, 0, 0, 0, 0, 0, 0, 0, 1, 1, 1, 1, 2, 2, 3, 3, 4, 4, 5, 6, 7, 9, 11, 13, 15, 0, 0, 0, 0, 0, 0, 0}; static constexpr unsigned char PB1[32] = {1, 3, 5, 7, 9, 11, 13, 15, 1, 3, 5, 7, 1, 3, 0, 2, 0, 2, 1, 1, 1, 0, 0, 0, 0, 0, 0, 0, 0, 0, 0, 0};
#pragma unroll
                for (int g = 0; g < 2; ++g) {
                    unsigned G[16];
#pragma unroll
                    for (int i = 0; i < 16; ++i) { const int sidx = g * 16 + i;
                        if (sidx < 25) { const float s_lo = v0[PA0[sidx]] + v1[PB0[sidx]], s_hi = v0[PA1[sidx]] + v1[PB1[sidx]];
                            const unsigned k_lo = (f2key(s_lo) & ~255u) | (unsigned)(255 - (PA0[sidx] * 16 + PB0[sidx])), k_hi = (f2key(s_hi) & ~255u) | (unsigned)(255 - (PA1[sidx] * 16 + PB1[sidx]));
                            G[i] = hf ? k_hi : k_lo; }
                        else G[i] = 0u; }
                    sort16_desc(G);
                    if (g == 0) {
#pragma unroll
                        for (int i = 0; i < 16; ++i) R2[i] = G[i];
                    } else merge16_desc(R2, G);
                }
            }
            unsigned W[16];
            cross_half_top16(W, R2, hf);
            float sv[16]; int ex[16]; float m = -3.0e38f;
#pragma unroll
            for (int i = 0; i < 16; ++i) { const unsigned ci = 255u - (W[i] & 255u); const unsigned t0 = tl[(ci >> 4) * 64], t1 = tl[(16 + (ci & 15)) * 64];
                sv[i] = key2f(t0 & ~127u) + key2f(t1 & ~127u); ex[i] = (int)((127u - (t0 & 127u)) * 128u + (127u - (t1 & 127u))); m = fmaxf(m, sv[i]); }
            float sum = 0.f;
#pragma unroll
            for (int i = 0; i < 16; ++i) { sv[i] = __expf(sv[i] - m); sum += sv[i]; }
            const float inv = 1.f / sum;
            { unsigned ew[4], gw[4];
#pragma unroll
              for (int q = 0; q < 4; ++q) {
                  int ea0 = ex[2 * q], ea1 = ex[8 + 2 * q], eb0 = ex[1 + 2 * q], eb1 = ex[9 + 2 * q]; float ga0 = sv[2 * q], ga1 = sv[8 + 2 * q], gb0 = sv[1 + 2 * q], gb1 = sv[9 + 2 * q];
                  asm volatile("" : "+v"(ea0), "+v"(ea1), "+v"(eb0), "+v"(eb1), "+v"(ga0), "+v"(ga1), "+v"(gb0), "+v"(gb1));
                  const int ea = hf ? ea1 : ea0, eb = hf ? eb1 : eb0; const float ga = hf ? ga1 : ga0, gb = hf ? gb1 : gb0;
                  ew[q] = (unsigned)ea | ((unsigned)eb << 16); gw[q] = pg8::cvt_pk_bf16(ga * inv, gb * inv); }
              uint4 e4, g4; e4.x = ew[0]; e4.y = ew[1]; e4.z = ew[2]; e4.w = ew[3]; g4.x = gw[0]; g4.y = gw[1]; g4.z = gw[2]; g4.w = gw[3];
              const size_t o16 = ((size_t)(tok0 + r) * 128 + h * 16 + hf * 8) * 2;
              *(uint4*)((unsigned char*)PE + o16) = e4; *(uint4*)((unsigned char*)PG + o16) = g4; }
        }
    }
    __syncthreads();
}
#undef SK_DMA


constexpr size_t WS_U8 = WS_Z + 160 * MiB, WS_V8 = WS_Z + 176 * MiB;
constexpr size_t WS_SU = WS_Z + 192 * MiB, WS_SV = WS_SU + 65536;
constexpr size_t WS_PW = WS_Z + 193 * MiB;
typedef float f32x2v __attribute__((ext_vector_type(2)));
__device__ __forceinline__ void ph_uvprep8(const Ids& id, const Params& p, int layer, int part = 0, int nparts = 1) {
    const float* U = p.peer_u + (size_t)layer * 16384 * 1024; const float* V = p.peer_v + (size_t)layer * 16384 * 1024;
    const int lane = id.tid & 63, wave = __builtin_amdgcn_readfirstlane(id.tid >> 6);
    const int rlo = part * (32768 / nparts), rhi = rlo + 32768 / nparts;
    for (int row = rlo + id.bid * 8 + wave; row < rhi; row += gridDim.x * 8) {
        const bool isv = row >= 16384; const int e = isv ? row - 16384 : row;
        const float4* src = (const float4*)((isv ? V : U) + (size_t)e * 1024 + lane * 16);
        const float4 a = src[0], b = src[1], c = src[2], d = src[3];
        float am = fmaxf(fmaxf(fmaxf(fabsf(a.x), fabsf(a.y)), fmaxf(fabsf(a.z), fabsf(a.w))), fmaxf(fmaxf(fabsf(b.x), fabsf(b.y)), fmaxf(fabsf(b.z), fabsf(b.w))));
        am = fmaxf(am, fmaxf(fmaxf(fmaxf(fabsf(c.x), fabsf(c.y)), fmaxf(fabsf(c.z), fabsf(c.w))), fmaxf(fmaxf(fabsf(d.x), fabsf(d.y)), fmaxf(fabsf(d.z), fabsf(d.w)))));
        am = wave_max(am);
        const float sc = am > 0.f ? am * (1.f / 440.f) : 1.f, inv = 1.f / sc;
        int w0 = 0, w1 = 0, w2 = 0, w3 = 0;
        w0 = __builtin_amdgcn_cvt_pk_fp8_f32(a.x * inv, a.y * inv, w0, false); w0 = __builtin_amdgcn_cvt_pk_fp8_f32(a.z * inv, a.w * inv, w0, true);
        w1 = __builtin_amdgcn_cvt_pk_fp8_f32(b.x * inv, b.y * inv, w1, false); w1 = __builtin_amdgcn_cvt_pk_fp8_f32(b.z * inv, b.w * inv, w1, true);
        w2 = __builtin_amdgcn_cvt_pk_fp8_f32(c.x * inv, c.y * inv, w2, false); w2 = __builtin_amdgcn_cvt_pk_fp8_f32(c.z * inv, c.w * inv, w2, true);
        w3 = __builtin_amdgcn_cvt_pk_fp8_f32(d.x * inv, d.y * inv, w3, false); w3 = __builtin_amdgcn_cvt_pk_fp8_f32(d.z * inv, d.w * inv, w3, true);
        uint4 o; o.x = (unsigned)w0; o.y = (unsigned)w1; o.z = (unsigned)w2; o.w = (unsigned)w3;
        *(uint4*)(p.ws + (isv ? WS_V8 : WS_U8) + (size_t)e * 1024 + lane * 16) = o;
        if (lane == 0) ((float*)(p.ws + (isv ? WS_SV : WS_SU)))[e] = sc;
    }
}
__device__ __forceinline__ void unpack_fp8x16(const uint4 q, float* f) {
    const unsigned w[4] = {q.x, q.y, q.z, q.w};
#pragma unroll
    for (int i = 0; i < 4; ++i) { const f32x2v lo = __builtin_amdgcn_cvt_pk_f32_fp8((int)w[i], false), hi = __builtin_amdgcn_cvt_pk_f32_fp8((int)w[i], true);
        f[4 * i] = lo[0]; f[4 * i + 1] = lo[1]; f[4 * i + 2] = hi[0]; f[4 * i + 3] = hi[1]; }
}
__device__ __forceinline__ float dot16_fp8(const uint4 q, const float* x) {
    const unsigned w[4] = {q.x, q.y, q.z, q.w}; f32x2v acc = {0.f, 0.f};
#pragma unroll
    for (int i = 0; i < 4; ++i) { const f32x2v lo = __builtin_amdgcn_cvt_pk_f32_fp8((int)w[i], false), hi = __builtin_amdgcn_cvt_pk_f32_fp8((int)w[i], true);
        const f32x2v x0 = {x[4 * i], x[4 * i + 1]}, x1 = {x[4 * i + 2], x[4 * i + 3]};
        acc = __builtin_elementwise_fma(x0, lo, acc); acc = __builtin_elementwise_fma(x1, hi, acc); }
    return acc[0] + acc[1]; }
__device__ __forceinline__ void dot16_fp8_acc(const uint4 q, const float* x, f32x2v& acc) {
    const unsigned w[4] = {q.x, q.y, q.z, q.w};
#pragma unroll
    for (int i = 0; i < 4; ++i) { const f32x2v lo = __builtin_amdgcn_cvt_pk_f32_fp8((int)w[i], false), hi = __builtin_amdgcn_cvt_pk_f32_fp8((int)w[i], true);
        const f32x2v x0 = {x[4 * i], x[4 * i + 1]}, x1 = {x[4 * i + 2], x[4 * i + 3]};
        acc = __builtin_elementwise_fma(x0, lo, acc); acc = __builtin_elementwise_fma(x1, hi, acc); } }
__device__ __forceinline__ float dot64_fp8(const uint4 q0, const uint4 q1, const uint4 q2, const uint4 q3, const float* x) {
    f32x2v a = {0.f, 0.f}, b = {0.f, 0.f};
    dot16_fp8_acc(q0, x, a); dot16_fp8_acc(q1, x + 16, b); dot16_fp8_acc(q2, x + 32, a); dot16_fp8_acc(q3, x + 48, b);
    a += b; return a[0] + a[1]; }
__device__ __forceinline__ float swap32_add(float a, float b) { const auto r = __builtin_amdgcn_permlane32_swap(__float_as_uint(a), __float_as_uint(b), false, false); return __uint_as_float(r[0]) + __uint_as_float(r[1]); }
__device__ __forceinline__ float swap16_add(float a, float b) { const auto r = __builtin_amdgcn_permlane16_swap(__float_as_uint(a), __float_as_uint(b), false, false); return __uint_as_float(r[0]) + __uint_as_float(r[1]); }
__device__ __forceinline__ float dpp_ror8(float v) { return __uint_as_float(__builtin_amdgcn_update_dpp(0u, __float_as_uint(v), 0x128, 0xf, 0xf, true)); }
__device__ __forceinline__ float sum8_dpp(float v) {
    v += __uint_as_float(__builtin_amdgcn_update_dpp(0u, __float_as_uint(v), 0x141, 0xf, 0xf, true));
    v += __uint_as_float(__builtin_amdgcn_update_dpp(0u, __float_as_uint(v), 0xb1, 0xf, 0xf, true));
    v += __uint_as_float(__builtin_amdgcn_update_dpp(0u, __float_as_uint(v), 0x4e, 0xf, 0xf, true));
    return v;
}

__device__ __forceinline__ float gelu_erf(float v) {
    const float av = fabsf(v), t = __builtin_amdgcn_rcpf(av * 0.2316418882f + 1.0f);
    float q = t * 0.5307027145f + (-0.7265760135f); q = q * t + 0.7107068705f; q = q * t + (-0.142248368f); q = q * t + 0.127414796f; q = q * t;
    const float e = __builtin_amdgcn_exp2f((v * v) * (-0.72134752044f));
    const float m = v * (q * e);
    return v < 0.f ? m : v - m;
}
__device__ __forceinline__ float row16_sum_dpp(float v) {
    v += __uint_as_float(__builtin_amdgcn_update_dpp(0u, __float_as_uint(v), 0x128, 0xf, 0xf, true));
    v += __uint_as_float(__builtin_amdgcn_update_dpp(0u, __float_as_uint(v), 0x124, 0xf, 0xf, true));
    v += __uint_as_float(__builtin_amdgcn_update_dpp(0u, __float_as_uint(v), 0x122, 0xf, 0xf, true));
    v += __uint_as_float(__builtin_amdgcn_update_dpp(0u, __float_as_uint(v), 0x121, 0xf, 0xf, true));
    return v;
}
__device__ __forceinline__ void ph_peer_u(const Ids& id, const Params& p, int layer, float* lds, int emask = 0x7fffffff) {
    const bf16* N = (const bf16*)(p.ws + WS_N); const int* PE = (const int*)(p.ws + WS_PE); const float* PG = (const float*)(p.ws + WS_PG); float* PW = (float*)(p.ws + WS_PW);
    const float* SU = (const float*)(p.ws + WS_SU); const float* SV = (const float*)(p.ws + WS_SV);
    const int lane = id.tid & 63, wave = __builtin_amdgcn_readfirstlane(id.tid >> 6), s16 = lane & 15, rg = lane >> 4;
    const unsigned char* U8b = p.ws + WS_U8; const unsigned uoff = (unsigned)(s16 * 16);
    const int j = id.bid & 7, widx = (id.bid >> 3) * 8 + wave, nw = ((int)gridDim.x >> 3) * 8;
    typedef __attribute__((address_space(3))) unsigned lds_u32;
    lds_u32* Le = (lds_u32*)((lds_u8*)lds + wave * 2048); lds_u32* Ls = Le + 128; lds_u32* Ld = Le + 256;
    unsigned nep = ((const unsigned*)PE)[(size_t)widx * 64 + lane], ngp = ((const unsigned*)PG)[(size_t)widx * 64 + lane];
    for (int tok = widx; tok < NTOK; tok += nw) {
        const int e0 = (int)(nep & 0xffffu), e1 = (int)(nep >> 16); const float g0 = __uint_as_float(ngp << 16), g1 = __uint_as_float(ngp & 0xffff0000u);
        uint4 xr[8];
#pragma unroll
        for (int i = 0; i < 4; ++i) { const bf16* xp = N + (size_t)tok * 1024 + i * 256 + s16 * 16; xr[2 * i] = *(const uint4*)xp; xr[2 * i + 1] = *(const uint4*)(xp + 8); }
        { const int tn = (tok + nw < NTOK) ? tok + nw : tok;
          nep = ((const unsigned*)PE)[(size_t)tn * 64 + lane]; ngp = ((const unsigned*)PG)[(size_t)tn * 64 + lane]; }
        const bool own0 = (e0 >> 11) == j, own1 = (e1 >> 11) == j;
        const unsigned long long m0 = __builtin_amdgcn_ballot_w64(own0), m1 = __builtin_amdgcn_ballot_w64(own1);
        const int n0 = __builtin_popcountll(m0), n = n0 + __builtin_popcountll(m1);
        const int pos0 = (int)__builtin_amdgcn_mbcnt_hi((unsigned)(m0 >> 32), __builtin_amdgcn_mbcnt_lo((unsigned)m0, 0u));
        const int pos1 = n0 + (int)__builtin_amdgcn_mbcnt_hi((unsigned)(m1 >> 32), __builtin_amdgcn_mbcnt_lo((unsigned)m1, 0u));
        if (own0) { Le[pos0] = (unsigned)e0; Ls[pos0] = (unsigned)(2 * lane); }
        if (own1) { Le[pos1] = (unsigned)e1; Ls[pos1] = (unsigned)(2 * lane + 1); }
        const int ef = (int)Le[lane < n ? lane : 0] & 16383; const float suf = SU[ef];
        const float svf = SV[ef];
        const int npass = (n + 3) >> 2;
        {
            uint4 q[6][4]; bool vld[6];
#pragma unroll
            for (int k = 0; k < 6; ++k) { const int idx = 4 * k + rg; vld[k] = idx < n;
                const int e = (int)Le[vld[k] ? idx : 0] & emask; const unsigned ro = ((unsigned)e << 10) + uoff;
                if (k < npass) { q[k][0] = *(const uint4*)(U8b + ro); q[k][1] = *(const uint4*)(U8b + ro + 256); q[k][2] = *(const uint4*)(U8b + ro + 512); q[k][3] = *(const uint4*)(U8b + ro + 768); } }
            float x[64];
#pragma unroll
            for (int i = 0; i < 8; ++i) unpack8(xr[i], x + 8 * i);
#pragma unroll
            for (int k = 0; k < 6; ++k) if (k < npass) {
                float d = dot64_fp8(q[k][0], q[k][1], q[k][2], q[k][3], x);
                d = row16_sum_dpp(d);
                if (vld[k] && s16 == 0) Ld[4 * k + rg] = __float_as_uint(d); }
        }
        for (int k = 6; k < npass; ++k) {
            float x[64];
#pragma unroll
            for (int i = 0; i < 8; ++i) unpack8(xr[i], x + 8 * i);
            const int idx = 4 * k + rg; const bool valid = idx < n;
            const int e = (int)Le[valid ? idx : 0] & emask;
            const unsigned ro = ((unsigned)e << 10) + uoff;
            const uint4 q0 = *(const uint4*)(U8b + ro), q1 = *(const uint4*)(U8b + ro + 256), q2 = *(const uint4*)(U8b + ro + 512), q3 = *(const uint4*)(U8b + ro + 768);
            float d = dot64_fp8(q0, q1, q2, q3, x);
            d = row16_sum_dpp(d);
            if (valid && s16 == 0) Ld[idx] = __float_as_uint(d);
        }
#pragma unroll
        for (int hh = 0; hh < 2; ++hh) { const int i = hh * 64 + lane;
            if (hh == 1 && n <= 64) break;
            const int slot = (i < n) ? (int)Ls[i] : 0; const float gsa = __shfl(g0, slot >> 1), gsb = __shfl(g1, slot >> 1); const float gs = (slot & 1) ? gsb : gsa;
            if (i < n) { const float dv = __uint_as_float(Ld[i]) * (hh == 0 ? suf : SU[(int)Le[i] & 16383]); const float g = gs * (hh == 0 ? svf : SV[(int)Le[i] & 16383]);
                ((bf16*)PW)[(size_t)tok * 128 + slot] = f2bf(g * gelu_erf(dv)); } }
    }
    __syncthreads();
}
struct TokV { int e0, e1; float ws0, ws1; float acc[16]; };
__device__ __forceinline__ void peerv_issue(const TokV& t, int hb, uint4 (&q)[8], float (&wsl)[8], const unsigned char* V8b, unsigned voff, int rg) {
#pragma unroll
    for (int it = 0; it < 8; ++it) { const int sl = it * 8 + rg;
        const int e = hb ? __shfl(t.e1, sl) : __shfl(t.e0, sl); wsl[it] = hb ? __shfl(t.ws1, sl) : __shfl(t.ws0, sl);
        q[it] = *(const uint4*)(V8b + (((unsigned)e << 10) + voff)); }
}
__device__ __forceinline__ void peerv_compute(TokV& t, const uint4 (&q)[8], const float (&wsl)[8]) {
#pragma unroll
    for (int it = 0; it < 8; ++it) { const unsigned w[4] = {q[it].x, q[it].y, q[it].z, q[it].w}; const f32x2v ws2 = {wsl[it], wsl[it]};
#pragma unroll
        for (int i = 0; i < 4; ++i) { const f32x2v lo = __builtin_amdgcn_cvt_pk_f32_fp8((int)w[i], false), hi = __builtin_amdgcn_cvt_pk_f32_fp8((int)w[i], true);
            f32x2v a0 = {t.acc[4 * i], t.acc[4 * i + 1]}, a1 = {t.acc[4 * i + 2], t.acc[4 * i + 3]};
            a0 = __builtin_elementwise_fma(ws2, lo, a0); a1 = __builtin_elementwise_fma(ws2, hi, a1);
            t.acc[4 * i] = a0[0]; t.acc[4 * i + 1] = a0[1]; t.acc[4 * i + 2] = a1[0]; t.acc[4 * i + 3] = a1[1]; } }
}
__device__ __forceinline__ void peerv_finish(const TokV& t, const Params& p, const float* modg, int tok, int dimoff, int lane, float gmul, bool last) {
    float r8[8], r4[4], r2[2];
#pragma unroll
    for (int i = 0; i < 8; ++i) r8[i] = swap32_add(t.acc[i], t.acc[8 + i]);
#pragma unroll
    for (int i = 0; i < 4; ++i) r4[i] = swap16_add(r8[i], r8[4 + i]);
    const bool b3 = (lane >> 3) & 1;
#pragma unroll
    for (int i = 0; i < 2; ++i) r2[i] = (b3 ? r4[2 + i] : r4[i]) + dpp_ror8(b3 ? r4[i] : r4[2 + i]);
    const unsigned off = (unsigned)tok * 1024u + (unsigned)dimoff;
    const float2 g = *(const float2*)((const char*)modg + (((unsigned)(tok >> 11) * 6144u + (unsigned)dimoff) << 2)); const unsigned hb = *(const unsigned*)((const char*)(p.ws + WS_HM) + (off << 1));
    const float o0 = __uint_as_float(hb << 16) + gmul * g.x * r2[0], o1 = __uint_as_float(hb & 0xffff0000u) + gmul * g.y * r2[1];
    if (last) { float2 o; o.x = o0; o.y = o1; *(float2*)((char*)p.out + (off << 2)) = o; }
    else *(unsigned*)((char*)p.out + (off << 1)) = pg8::cvt_pk_bf16(o0, o1);
}
__device__ __forceinline__ void ph_peer_v(const Ids& id, const Params& p, int layer, float gmul = 1.f) {
    const int* PE = (const int*)(p.ws + WS_PE); const float* PW = (const float*)(p.ws + WS_PW);
    const float* SV = (const float*)(p.ws + WS_SV);
    const float* mod = (const float*)(p.ws + WS_MOD) + (size_t)layer * 16 * 6144;
    const int lane = id.tid & 63, wave = __builtin_amdgcn_readfirstlane(id.tid >> 6), sub = lane & 7, rg = lane >> 3;
    const int j = id.bid & 7, widx = (id.bid >> 3) * 8 + wave, nw = ((int)gridDim.x >> 3) * 8;
    const unsigned char* V8b = p.ws + WS_V8; const unsigned voff = (unsigned)(j * 128 + sub * 16);
    const int dimoff = j * 128 + sub * 16 + 8 * ((lane >> 5) & 1) + 4 * ((lane >> 4) & 1) + 2 * ((lane >> 3) & 1);
#define PV_UNPACK(T, ew, ww) do { T.e0 = (int)((ew) & 0xffffu); T.e1 = (int)((ew) >> 16); T.ws0 = __uint_as_float((ww) << 16); T.ws1 = __uint_as_float((ww) & 0xffff0000u); } while (0)
#define PV_REC(tn_) do { nea = ((const unsigned*)PE)[(size_t)(tn_) * 64 + lane]; neb = ((const unsigned*)PE)[(size_t)((tn_) + nw) * 64 + lane]; \
                         nwa = ((const unsigned*)PW)[(size_t)(tn_) * 64 + lane]; nwb = ((const unsigned*)PW)[(size_t)((tn_) + nw) * 64 + lane]; } while (0)
    unsigned nea, neb, nwa, nwb;
    TokV A, B;
    PV_REC(widx);
    unsigned pea = nea, peb = neb, pwa = nwa, pwb = nwb;
    PV_UNPACK(A, pea, pwa); PV_UNPACK(B, peb, pwb);
    { const int t1 = (widx + 2 * nw < NTOK) ? widx + 2 * nw : widx; PV_REC(t1); }
    uint4 qa[8], qb[8]; float wa[8], wb[8];
    peerv_issue(A, 0, qa, wa, V8b, voff, rg); peerv_issue(B, 0, qb, wb, V8b, voff, rg);
    for (int tok = widx; tok < NTOK; tok += 2 * nw) {
        const int tokB = tok + nw;
        PV_UNPACK(A, pea, pwa); PV_UNPACK(B, peb, pwb);
#pragma unroll
        for (int i = 0; i < 16; ++i) { A.acc[i] = 0.f; B.acc[i] = 0.f; }
        peerv_compute(A, qa, wa); peerv_issue(A, 1, qa, wa, V8b, voff, rg); __builtin_amdgcn_sched_barrier(0);
        peerv_compute(B, qb, wb); peerv_issue(B, 1, qb, wb, V8b, voff, rg); __builtin_amdgcn_sched_barrier(0);
        peerv_compute(A, qa, wa);
        { TokV An; PV_UNPACK(An, nea, nwa); peerv_issue(An, 0, qa, wa, V8b, voff, rg); } __builtin_amdgcn_sched_barrier(0);
        peerv_compute(B, qb, wb);
        { TokV Bn; PV_UNPACK(Bn, neb, nwb); peerv_issue(Bn, 0, qb, wb, V8b, voff, rg); } __builtin_amdgcn_sched_barrier(0);
        pea = nea; peb = neb; pwa = nwa; pwb = nwb;
        { const int t2 = (tok + 4 * nw < NTOK) ? tok + 4 * nw : tok; PV_REC(t2); }
        peerv_finish(A, p, mod + 5 * 1024, tok, dimoff, lane, gmul, layer == 1);
        peerv_finish(B, p, mod + 5 * 1024, tokB, dimoff, lane, gmul, layer == 1);
    }
#undef PV_UNPACK
#undef PV_REC
}

#ifndef PROBE_A
#define PROBE_A 0
#endif
#ifndef PROBE_GAIN
#define PROBE_GAIN 1.0f
#endif
#if PROBE_A
constexpr size_t WS_Y2 = 516 * MiB;
__device__ __forceinline__ void ph_probe_diff(const Ids& id, const Params& p, int layer, float* lds) {
    const bf16* Y1 = (const bf16*)(p.ws + WS_YA); const bf16* Y2 = (const bf16*)(p.ws + WS_Y2);
    float e = 0.f, n = 0.f;
    for (size_t i = (size_t)id.bid * NTHR + id.tid; i < (size_t)8192 * 512; i += (size_t)gridDim.x * NTHR) { const float a = bf2f(Y1[i]), b = bf2f(Y2[i]); e += (a - b) * (a - b); n += a * a; }
    e = wave_sum(e); n = wave_sum(n);
    __syncthreads();
    if ((id.tid & 63) == 0) { lds[(id.tid >> 6) * 2] = e; lds[(id.tid >> 6) * 2 + 1] = n; }
    __syncthreads();
    if (id.tid == 0) { float es = 0.f, ns = 0.f; for (int w = 0; w < 8; ++w) { es += lds[w * 2]; ns += lds[w * 2 + 1]; }
        float* o = (float*)(p.ws + WS_CTL) + (layer * 256 + id.bid) * 2; o[0] = es; o[1] = ns; }
    __syncthreads();
}
__device__ __forceinline__ void ph_probe_scale(const Ids& id, const Params& p) {
    float e = 0.f, n = 0.f; const float* c = (const float*)(p.ws + WS_CTL);
    for (int i = 0; i < 2 * (int)gridDim.x; ++i) { e += c[2 * i]; n += c[2 * i + 1]; }
    const float f = 1.f + PROBE_GAIN * sqrtf(e / n);
    for (size_t i = (size_t)id.bid * NTHR + id.tid; i < (size_t)NTOK * 1024; i += (size_t)gridDim.x * NTHR) p.out[i] *= f;
}
#endif

#define XB_TMO      128
#define XB_XCNT(j)  (256  + 64 * (j))
#define XB_XSUB(j)  (1280 + 64 * (j))
#define XB_XGEN(j)  (2304 + 64 * (j))
#define XB_TOP      3328
#define XB_TOPGEN   3392
#define XCD_BAR_WORDS 3456
#define XB_SPIN_CAP (1u << 18)

__device__ __forceinline__ unsigned xb_ld(unsigned* p)              { return __hip_atomic_load(p, __ATOMIC_RELAXED, __HIP_MEMORY_SCOPE_AGENT); }
__device__ __forceinline__ unsigned xb_add(unsigned* p, unsigned v) { return __hip_atomic_fetch_add(p, v, __ATOMIC_RELAXED, __HIP_MEMORY_SCOPE_AGENT); }
__device__ __forceinline__ unsigned xb_xcc_id() { return (unsigned)__builtin_amdgcn_s_getreg((3 << 11) | 20) & 0xFu; }
#define XB_SPIN(cond, bar) do { unsigned _sp = 0; while (cond) { __builtin_amdgcn_s_sleep(1); \
    if ((++_sp & 255u) == 0u) { if (xb_ld(&(bar)[XB_TMO])) break; if (_sp > XB_SPIN_CAP) { atomicAdd(&(bar)[XB_TMO], 1u); break; } } } } while (0)

struct XcdBarrier {
    unsigned* bar; unsigned x;
    volatile __attribute__((address_space(3))) unsigned* st;
};

__device__ __forceinline__ XcdBarrier xcd_barrier_post(unsigned* bar, volatile __attribute__((address_space(3))) unsigned* st) {
    XcdBarrier b; b.bar = bar; b.x = xb_xcc_id(); b.st = st;
    if (threadIdx.x == 0) (void)xb_add(&bar[XB_XCNT(b.x)], 1u);
    return b;
}
__device__ __forceinline__ void xcd_barrier_complete(unsigned* bar, unsigned x, unsigned& nloc, unsigned& nx) {
    const unsigned G = gridDim.x * gridDim.y * gridDim.z;
    unsigned sum, cnt, mine, sp = 0u;
    for (;;) {
        sum = 0u; cnt = 0u; mine = 0u;
#pragma unroll
        for (unsigned j = 0; j < 16; ++j) { const unsigned c = xb_ld(&bar[XB_XCNT(j)]); sum += c; cnt += (c > 0u) ? 1u : 0u; mine = (j == x) ? c : mine; }
        if (sum == G) break;
        __builtin_amdgcn_s_sleep(1);
        if ((++sp & 255u) == 0u) { if (xb_ld(&bar[XB_TMO])) break; if (sp > XB_SPIN_CAP) { atomicAdd(&bar[XB_TMO], 1u); break; } }
    }
    nloc = mine > 0u ? mine : 1u; nx = cnt > 0u ? cnt : 1u;
}


__device__ __forceinline__ void xcd_barrier_arrive(const XcdBarrier& b) {
    asm volatile("s_waitcnt vmcnt(0)" ::: "memory");
    __syncthreads();
    if (threadIdx.x == 0) {
        unsigned* bar = b.bar;
        __builtin_amdgcn_s_waitcnt(0);
        unsigned nloc = b.st[0], nx = b.st[1];
        if (nloc == 0u) { xcd_barrier_complete(bar, b.x, nloc, nx); b.st[0] = nloc; b.st[1] = nx; }
        const unsigned old = xb_add(&bar[XB_XSUB(b.x)], 1u);
        const unsigned gen = old / nloc;
        b.st[2] = gen;
        if (old + 1u == (gen + 1u) * nloc) {
            __builtin_amdgcn_fence(__ATOMIC_RELEASE, "agent");
            asm volatile("s_waitcnt vmcnt(0)" ::: "memory");
            const unsigned og = xb_add(&bar[XB_TOP], 1u);
            const unsigned tg = og / nx;
            if (og + 1u == (tg + 1u) * nx) {
#pragma unroll
                for (unsigned jx = 0; jx < 16; ++jx) (void)xb_add(&bar[XB_XGEN(jx)], 1u);
            }
        }
    }
}
__device__ __forceinline__ void xcd_barrier_wait(const XcdBarrier& b) {
    if (threadIdx.x == 0) {
        unsigned* bar = b.bar; const unsigned gen = b.st[2];
        XB_SPIN(xb_ld(&bar[XB_XGEN(b.x)]) == gen, bar);
        __builtin_amdgcn_fence(__ATOMIC_ACQUIRE, "agent");
        asm volatile("s_waitcnt vmcnt(0)" ::: "memory");
    }
    __syncthreads();
}

__device__ __forceinline__ void xcd_barrier(const XcdBarrier& b) { xcd_barrier_arrive(b); xcd_barrier_wait(b); }

constexpr int PH_PER_LAYER = 14;
#ifndef REP_PEERSEL
#define REP_PEERSEL 1
#endif
#ifndef REP_C
#define REP_C 1
#endif
#ifndef PROBE_NOGATHER
#define PROBE_NOGATHER 0
#endif
#ifndef USE_XCD_BARRIER
#define USE_XCD_BARRIER 1
#endif
#ifndef USE_PEER8
#define USE_PEER8 1
#endif
#ifndef REP_A
#define REP_A 1
#endif
#ifndef REP_B
#define REP_B 1
#endif
#ifndef REP_C2
#define REP_C2 1
#endif
#ifndef REP_Q
#define REP_Q -100
#endif
#ifndef REP_N
#define REP_N 2
#endif
#ifndef USE_C_MFMA
#define USE_C_MFMA 1
#endif
#ifndef USE_PEERSEL2
#define USE_PEERSEL2 1
#endif
#ifndef USE_PEEREXP2
#define USE_PEEREXP2 1
#endif
#ifndef USE_A_MFMA
#define USE_A_MFMA 1
#endif
#ifndef USE_B_MFMA
#define USE_B_MFMA 1
#endif
#ifndef GATE_ACT
#define GATE_ACT 1
#endif
#ifndef GEMM_PG8
#define GEMM_PG8 31
#endif

template <class Epi>
__device__ __forceinline__ void run_gemm(const Ids& id, float* lds, const bf16* A, const bf16* Bt, int N, int K, const Epi& E) {
    pg8::Gemm g{A, Bt, NTOK, N, K, nullptr, nullptr, nullptr, nullptr}; pg8::StaticOrder S; S.init(NTOK, N, (int)gridDim.x, id.bid);
    pg8::gemm_phase<Epi, pg8::StaticOrder, true, true>((PG8_LAS unsigned char*)lds, g, S, E, id.tid);
}

template <int Q>
__device__ __forceinline__ void run_phase_body(const Params& p, int layer, float* lds, const int rep_) {
    {
    Ids id; id.tid = threadIdx.x; id.bid = blockIdx.x;
    asm volatile("" : "+v"(id.tid), "+s"(id.bid));
    if constexpr (Q < 0) { ph_mod(id, p, lds); if (rep_ + 1 < ((Q == REP_Q) ? REP_N : 1)) return;
#if PROBE_A
        if (id.bid == 0 && id.tid < 2) ((float*)(p.ws + WS_CTL))[id.tid] = 0.f;
#endif
        return; }
    unsigned char* ws = p.ws;
    bf16* N = (bf16*)(ws + WS_N); bf16* Z = (bf16*)(ws + WS_Z);
    const float* mod = (const float*)(ws + WS_MOD) + (size_t)layer * 16 * 6144;
    float* M = (float*)(ws + WS_M); bf16* G = (bf16*)(ws + WS_G);
    const float* win = p.w_in + (size_t)layer * 1024 * INC;
    if constexpr (Q == 0) { ph_wprep(id, p, layer, lds); ph_norm(id, p, layer, 0);
        if (id.bid == 0 && id.tid < 256) { const int t4 = id.tid >> 6, c = id.tid & 63; const float* sp = t4 == 0 ? p.a_qn_g : (t4 == 1 ? p.a_kn_g : (t4 == 2 ? p.b_qn_g : p.b_kn_g));
            ((float*)(ws + WS_QKG))[layer * 256 + id.tid] = sp[layer * 64 + c]; } }
    if constexpr (Q == 1) { if constexpr (GEMM_PG8 & 1) { if constexpr (FUSE_QK) run_gemm(id, lds, N, (const bf16*)(ws + WS_WIN_T), 4096, 1024, pg8::EpiInQK{Z, ZC, (const float*)(ws + WS_QKG) + layer * 256, (PG8_LAS float*)((PG8_LAS unsigned char*)lds + pg8::STAGE_BYTES)});
                              else run_gemm(id, lds, N, (const bf16*)(ws + WS_WIN_T), 4096, 1024, pg8::EpiBfStore<0>{Z, ZC, nullptr}); }
                            else gemm_naive<true>(id, N, 1024, win, INC, 4052, 1024, EpiBf{Z, ZC, 0}, lds); }
    if constexpr (Q == 2 && !FUSE_QK) ph_qknorm(id, p, layer);
    if constexpr (Q == 3) {
#if PROBE_A
        ph_A(id, p, lds); ph_A_mfma(id, p, layer, lds, WS_Y2, 4);
#else
        if constexpr (USE_A_MFMA) { for (int ra = 0; ra < REP_A; ++ra) { asm volatile("" : "+s"(ra)); ph_A_mfma(id, p, layer, lds); } } else ph_A(id, p, lds);
#endif
 if constexpr (USE_B_MFMA) { for (int rb = 0; rb < REP_B; ++rb) { asm volatile("" : "+s"(rb)); ph_B_mfma(id, p, lds); } } else ph_B(id, p, lds); ph_C_chunk<1>(id, p, layer, lds); }
    if constexpr (Q == 5) ph_C_chunk<3>(id, p, layer, lds);
    if constexpr (Q == 4) { ph_C_scan(id, p);
        if constexpr (FUSE_GATES) run_gemm(id, lds, N, (const bf16*)(ws + WS_WG_T), 3072, 1024, pg8::EpiGate8{(unsigned char*)G, LDG, p.b_gate + layer * 3072});
#if PROBE_A
        ph_probe_diff(id, p, layer, lds);
#endif
    }
    if constexpr (Q == 6 && !FUSE_GATES) { if constexpr (GEMM_PG8 & 2) run_gemm(id, lds, N, (const bf16*)(ws + WS_WG_T), 3072, 1024, pg8::EpiGate8{(unsigned char*)G, LDG, p.b_gate + layer * 3072});
                            else gemm_naive<false>(id, N, 1024, win + 4052, INC, 3072, 1024, EpiSigBfN{G, p.b_gate + layer * 3072}, lds); }
    if constexpr (Q == 7) {
        if constexpr (GEMM_PG8 & 4) {
        {   pg8::Gemm g{(const bf16*)(ws + WS_YA), (const bf16*)(ws + WS_WOA_T), NTOK, 1024, 512, (const bf16*)(ws + WS_YB), (const bf16*)(ws + WS_WOB_T), (const bf16*)(ws + WS_YC), (const bf16*)(ws + WS_WOC_T)};
            pg8::ChainOrder S; S.S.init(NTOK, 1024, (int)gridDim.x, id.bid);
            pg8::gemm_phase<pg8::EpiChain, pg8::ChainOrder, true, true, true>((PG8_LAS unsigned char*)lds, g, S, pg8::EpiChain{(const unsigned char*)G, N}, id.tid); }
        } else {
        gemm_naive<false>(id, (const bf16*)(ws + WS_YA), 512, p.w_oa + (size_t)layer * 512 * 1024, 1024, 1024, 512, EpiProjN{G, M, N, 0, GATE_ACT ? nullptr : p.b_gate + layer * 3072}, lds);
        gemm_naive<false>(id, (const bf16*)(ws + WS_YB), 512, p.w_ob + (size_t)layer * 512 * 1024, 1024, 1024, 512, EpiProjN{G + 1024, M, N, 1, GATE_ACT ? nullptr : p.b_gate + layer * 3072 + 1024}, lds);
        gemm_naive<false>(id, (const bf16*)(ws + WS_YC), 512, p.w_oc + (size_t)layer * 512 * 1024, 1024, 1024, 512, EpiProjN{G + 2048, M, N, 2, GATE_ACT ? nullptr : p.b_gate + layer * 3072 + 2048}, lds);
        }
    }
    if constexpr (Q == 8) { if constexpr (GEMM_PG8 & 8) { if (layer == 0) run_gemm(id, lds, N, (const bf16*)(ws + WS_WOUT_T), 1024, 1024, pg8::EpiResid<false>{(const void*)p.x, (bf16*)(ws + WS_HM), mod + 2 * 1024});
                              else run_gemm(id, lds, N, (const bf16*)(ws + WS_WOUT_T), 1024, 1024, pg8::EpiResid<true>{(const void*)p.out, (bf16*)(ws + WS_HM), mod + 2 * 1024}); }
                            else gemm_naive<false>(id, N, 1024, p.w_out + (size_t)layer * 1024 * 1024, 1024, 1024, 1024, EpiRes{layer == 0 ? p.x : p.out, p.out, mod + 2 * 1024}, lds); }
    if constexpr (Q == 9) { ph_norm(id, p, layer, 1); if constexpr (USE_PEER8) ph_uvprep8(id, p, layer, 1, 4); else ph_uvprep(id, p, layer); }
    if constexpr (Q == 10) { if constexpr (GEMM_PG8 & 16) run_gemm(id, lds, N, (const bf16*)(ws + WS_WPQ_T), 2048, 1024, pg8::EpiBfStore<0>{(bf16*)(ws + WS_PQ), 2048, nullptr});
                            else gemm_naive<false>(id, N, 1024, p.peer_wq + (size_t)layer * 1024 * 2048, 2048, 2048, 1024, EpiBf{(bf16*)(ws + WS_PQ), 2048, 0}, lds); }
    if constexpr (Q == 11) { for (int rep = 0; rep < REP_PEERSEL; ++rep) { asm volatile("" : "+s"(rep)); if constexpr (USE_PEERSEL2) ph_peersel2(id, p, layer, lds); else ph_peersel(id, p, layer, lds); } }
    if constexpr (Q == 12) { if constexpr (USE_PEER8) ph_peer_u(id, p, layer, lds, (PROBE_NOGATHER && rep_ + 1 < REP_N) ? 0x3800 : 0x7fffffff); else if constexpr (USE_PEEREXP2) ph_peerexp2(id, p, layer); else ph_peerexp(id, p, layer, lds); }
    if constexpr (Q == 13) { if constexpr (USE_PEER8) ph_peer_v(id, p, layer, (rep_ + 1 < ((Q == REP_Q) ? REP_N : 1)) ? 0.f : 1.f); }
    }
}

template <int Q>
__device__ __forceinline__ void run_phase(const Params& p_unused, int layer, float* lds) {
    if constexpr (Q == REP_Q) { for (int rep_ = 0; rep_ < REP_N; ++rep_) { asm volatile("" : "+s"(rep_)); run_phase_body<Q>(p_unused, layer, lds, rep_); } }
    else run_phase_body<Q>(p_unused, layer, lds, 0);
}

#if MK_COOP
constexpr int CW_BAR = 4096;
constexpr int LDS_MISC = LDS_BYTES - 64;
#if USE_XCD_BARRIER
#define GSYNC() xcd_barrier(xbar)
#else
#define GSYNC() cg::this_grid().sync()
#endif
template <int Q> __device__ __forceinline__ void layer_phases(const Params& p, int layer, float* lds, const XcdBarrier& xbar) {
    if constexpr ((FUSE_QK && Q == 2) || (FUSE_GATES && Q == 6)) { layer_phases<Q + 1>(p, layer, lds, xbar); }
    else {
    run_phase<Q>(p, layer, lds);
    if constexpr (Q + 1 < PH_PER_LAYER) {
        if constexpr (USE_XCD_BARRIER && USE_PEER8 && (Q == 8 || Q == 9 || Q == 10)) {
            xcd_barrier_arrive(xbar);
            { Ids id; id.tid = threadIdx.x; id.bid = blockIdx.x; asm volatile("" : "+v"(id.tid), "+s"(id.bid)); ph_uvprep8(id, p, layer, Q == 8 ? 0 : (Q == 9 ? 2 : 3), 4); }
            xcd_barrier_wait(xbar);
        } else GSYNC();
        layer_phases<Q + 1>(p, layer, lds, xbar); }
    }
}
__global__ void __launch_bounds__(NTHR, 2) k_mega(Params p) {
    extern __shared__ __attribute__((aligned(16))) unsigned char lds_raw[];
    float* lds = (float*)lds_raw;
    volatile __attribute__((address_space(3))) unsigned* misc = (volatile __attribute__((address_space(3))) unsigned*)((__attribute__((address_space(3))) unsigned char*)lds_raw + LDS_MISC);
    if (threadIdx.x < 16) misc[threadIdx.x] = 0u;
    __syncthreads();
    XcdBarrier xbar = xcd_barrier_post((unsigned*)p.ws + CW_BAR, misc);
    run_phase<-1>(p, 0, lds);
    cg::this_grid().sync();
    layer_phases<0>(p, 0, lds, xbar); GSYNC();
    layer_phases<0>(p, 1, lds, xbar);
#if PROBE_A
    GSYNC(); { Ids id; id.tid = threadIdx.x; id.bid = blockIdx.x; ph_probe_scale(id, p); }
#endif
}
#else
template <int Q> __global__ void __launch_bounds__(NTHR, 2) k_phase(Params p) {
    extern __shared__ __attribute__((aligned(16))) unsigned char lds_raw[];
    run_phase<Q>(p, p.ph_lo, (float*)lds_raw);
}
template <int Q> static void launch_phase(Params p, int layer, int grid, hipStream_t stream) {
    static bool attr = false;
    if (!attr) { (void)hipFuncSetAttribute((const void*)k_phase<Q>, hipFuncAttributeMaxDynamicSharedMemorySize, LDS_BYTES); attr = true; }
    p.ph_lo = layer; p.ph_hi = 0;
    hipLaunchKernelGGL(k_phase<Q>, dim3(grid), dim3(NTHR), LDS_BYTES, stream, p);
}
template <int Q> static void launch_layer(const Params& p, int layer, int grid, hipStream_t stream) {
    launch_phase<Q>(p, layer, grid, stream);
    if constexpr (Q + 1 < PH_PER_LAYER) launch_layer<Q + 1>(p, layer, grid, stream);
}
#endif

extern "C" void kernel_launch(void* const* d_in, const int* in_sizes, int n_in, void* d_out, int out_size, void* d_ws, size_t ws_size, hipStream_t stream) {
    static int grid = 0;
    if (grid == 0) {
        if (n_in != 23 || out_size != NTOK * D || ws_size < WS_END) { fprintf(stderr, "kernel_launch: unexpected problem: n_in %d out %d ws %zu (need %zu)\n", n_in, out_size, ws_size, (size_t)WS_END); grid = -1; return; }
        int dev = 0, cus = 0;
        (void)hipGetDevice(&dev); (void)hipDeviceGetAttribute(&cus, hipDeviceAttributeMultiprocessorCount, dev);
#if MK_COOP
        int per_cu = 0;
        if (hipFuncSetAttribute((const void*)k_mega, hipFuncAttributeMaxDynamicSharedMemorySize, LDS_BYTES) != hipSuccess) { fprintf(stderr, "hipFuncSetAttribute failed\n"); grid = -1; return; }
        if (hipOccupancyMaxActiveBlocksPerMultiprocessor(&per_cu, (const void*)k_mega, NTHR, LDS_BYTES) != hipSuccess || per_cu < 1) { fprintf(stderr, "occupancy query: %d\n", per_cu); per_cu = 1; }
        (void)hipGetLastError();
        grid = cus * per_cu;
#else
        grid = cus;
#endif
        fprintf(stderr, "kernel_launch: grid %d (cus %d), ws %zu\n", grid, cus, ws_size);
    }
    if (grid < 0) return;
    Params p{};
    const float** pp = (const float**)&p;
    for (int i = 0; i < 23; ++i) pp[i] = (const float*)d_in[i];
    p.out = (float*)d_out; p.ws = (unsigned char*)d_ws;
#if MK_COOP
    if (hipMemsetAsync(d_ws, 0, 65536, stream) != hipSuccess) { fprintf(stderr, "kernel_launch: hipMemsetAsync failed\n"); return; }
    void* args[] = {&p};
    hipError_t e = hipLaunchCooperativeKernel((const void*)k_mega, dim3(grid), dim3(NTHR), args, LDS_BYTES, stream);
    if (e != hipSuccess) fprintf(stderr, "cooperative launch failed: %s (grid %d)\n", hipGetErrorString(e), grid);
#else
    launch_phase<-1>(p, 0, grid, stream);
    launch_layer<0>(p, 0, grid, stream);
    launch_layer<0>(p, 1, grid, stream);
#endif
}
```

```cpp
#include <hip/hip_runtime.h>
#include <hip/hip_cooperative_groups.h>
#include <cstdio>
#include <cstdint>
namespace cg = cooperative_groups;

#ifndef MK_COOP
#define MK_COOP 1
#endif

typedef unsigned short bf16;

constexpr int D = 1024, BATCH = 16, SEQ = 2048, DEPTH = 2, NTOK = BATCH * SEQ;
constexpr int INC = 7124;
constexpr int ZC = 4096;
constexpr int Z_AQ = 0, Z_AK = 512, Z_AV = 576, Z_IQ = 640, Z_IK = 896, Z_BQ = 960, Z_BK = 1472, Z_BV = 1984,
              Z_CQ = 2496, Z_CK = 2752, Z_CV = 3008, Z_CR = 3520, Z_IW = 4032, Z_CA = 4036;
constexpr int NTHR = 512;
constexpr int LDS_BYTES = 147456;

constexpr size_t MiB = 1u << 20;
constexpr size_t WS_CTL = 0;
constexpr size_t WS_MOD = 1 * MiB;
constexpr size_t WS_WIN_T = 2 * MiB;
constexpr size_t WS_WG_T = 10 * MiB;
constexpr size_t WS_WOA_T = 16 * MiB, WS_WOB_T = 17 * MiB, WS_WOC_T = 18 * MiB;
constexpr size_t WS_WOUT_T = 19 * MiB;
constexpr size_t WS_WPQ_T = 21 * MiB;
constexpr size_t WS_SKB = 25 * MiB;
constexpr size_t WS_N = 28 * MiB;
constexpr size_t WS_YA = 92 * MiB, WS_YB = 124 * MiB, WS_YC = 156 * MiB;
constexpr size_t WS_Z = 188 * MiB;
constexpr size_t WS_G = WS_Z;
constexpr size_t WS_M = 380 * MiB;
constexpr size_t WS_PQ = WS_Z;
constexpr size_t WS_PE = WS_Z + 128 * MiB;
constexpr size_t WS_PG = WS_Z + 144 * MiB;
constexpr size_t WS_CRAW = 452 * MiB;
constexpr size_t WS_END = 516 * MiB;
constexpr size_t WS_QKG = WS_CTL + 131072;
constexpr size_t WS_HM = WS_YA;

struct Ids { int tid, bid; };
struct Params {
    const float *x, *c, *norm1_g, *norm2_g, *w_mod, *b_mod, *w_in, *b_gate, *a_qn_g, *a_kn_g, *b_qn_g, *b_kn_g,
                *c_w_alpha, *c_b_alpha, *c_on_g, *w_oa, *w_ob, *w_oc, *w_out, *peer_wq, *peer_subkeys, *peer_u, *peer_v;
    float* out; unsigned char* ws;
    int ph_lo, ph_hi;
};

__device__ __forceinline__ float bf2f(bf16 v) { return __uint_as_float(((unsigned)v) << 16); }
__device__ __forceinline__ bf16 f2bf(float f) { unsigned u = __float_as_uint(f); return (bf16)((u + 0x7fffu + ((u >> 16) & 1u)) >> 16); }
__device__ __forceinline__ unsigned cvt_pk(float lo, float hi) { typedef float f2 __attribute__((ext_vector_type(2))); typedef __bf16 b2 __attribute__((ext_vector_type(2))); f2 v = {lo, hi}; b2 b = __builtin_convertvector(v, b2); return __builtin_bit_cast(unsigned, b); }
__device__ __forceinline__ float wave_sum(float v) {
#pragma unroll
    for (int o = 1; o < 64; o <<= 1) v += __shfl_xor(v, o);
    return v;
}
__device__ __forceinline__ float wave_max(float v) {
#pragma unroll
    for (int o = 1; o < 64; o <<= 1) v = fmaxf(v, __shfl_xor(v, o));
    return v;
}
__device__ __forceinline__ float logsig(float x) { return fminf(x, 0.f) - log1pf(expf(-fabsf(x))); }
__device__ __forceinline__ void unpack8(uint4 u, float* f) {
    f[0] = __uint_as_float(u.x << 16); f[1] = __uint_as_float(u.x & 0xffff0000u);
    f[2] = __uint_as_float(u.y << 16); f[3] = __uint_as_float(u.y & 0xffff0000u);
    f[4] = __uint_as_float(u.z << 16); f[5] = __uint_as_float(u.z & 0xffff0000u);
    f[6] = __uint_as_float(u.w << 16); f[7] = __uint_as_float(u.w & 0xffff0000u);
}

__device__ __forceinline__ void ph_mod(const Ids& id, const Params& p, float* lds) {
    float* s_c = lds; float* s_red = lds + 16384;
    const int tid = id.tid;
    for (int i = tid; i < 16384; i += NTHR) { float v = p.c[i]; s_c[i] = v / (1.f + expf(-v)); }
    __syncthreads();
    float* mod = (float*)(p.ws + WS_MOD);
    const int j = tid & 63, ks = tid >> 6;
    for (int item = id.bid; item < 2 * 96; item += gridDim.x) {
        const int l = item / 96, jt = item % 96, col = jt * 64 + j;
        const float* w = p.w_mod + (size_t)l * 1024 * 6144 + col;
        float acc[16];
#pragma unroll
        for (int b = 0; b < 16; ++b) acc[b] = 0.f;
        for (int k = ks * 128; k < ks * 128 + 128; ++k) {
            const float wv = w[(size_t)k * 6144];
#pragma unroll
            for (int b = 0; b < 16; ++b) acc[b] += s_c[b * 1024 + k] * wv;
        }
#pragma unroll
        for (int b = 0; b < 16; ++b) s_red[(ks * 64 + j) * 16 + b] = acc[b];
        __syncthreads();
        for (int o = tid; o < 1024; o += NTHR) {
            const int jj = o & 63, b = o >> 6; float s = 0.f;
            for (int q = 0; q < 8; ++q) s += s_red[(q * 64 + jj) * 16 + b];
            const int c2 = jt * 64 + jj;
            mod[((size_t)l * 16 + b) * 6144 + c2] = s + p.b_mod[l * 6144 + c2];
        }
        __syncthreads();
    }
}

__device__ __forceinline__ void ph_norm(const Ids& id, const Params& p, int layer, int which) {
    const float* g = (which == 0 ? p.norm1_g : p.norm2_g) + layer * 1024;
    const float* mod = (const float*)(p.ws + WS_MOD) + (size_t)layer * 16 * 6144;
    bf16* N = (bf16*)(p.ws + WS_N);
    const int lane = id.tid & 63, wave = __builtin_amdgcn_readfirstlane(id.tid >> 6);
    if (which == 0 && layer == 0) {
    const float* hin = p.x;
    for (int tok = id.bid * 8 + wave; tok < NTOK; tok += gridDim.x * 8) {
        const int b = tok >> 11;
        const float* shift = mod + b * 6144 + (which ? 3 : 0) * 1024; const float* scale = shift + 1024;
        const float4* hr = (const float4*)(hin + (size_t)tok * 1024);
        float4 v[4]; float ss = 0.f;
#pragma unroll
        for (int j = 0; j < 4; ++j) { v[j] = hr[lane + 64 * j]; ss += v[j].x * v[j].x + v[j].y * v[j].y + v[j].z * v[j].z + v[j].w * v[j].w; }
        ss = wave_sum(ss);
        const float r = rsqrtf(ss * (1.f / 1024.f) + 1e-6f);
#pragma unroll
        for (int j = 0; j < 4; ++j) {
            const int c = (lane + 64 * j) * 4;
            const float4 gg = *(const float4*)(g + c), sc = *(const float4*)(scale + c), sh = *(const float4*)(shift + c);
            const float o0 = v[j].x * r * gg.x * (1.f + sc.x) + sh.x, o1 = v[j].y * r * gg.y * (1.f + sc.y) + sh.y;
            const float o2 = v[j].z * r * gg.z * (1.f + sc.z) + sh.z, o3 = v[j].w * r * gg.w * (1.f + sc.w) + sh.w;
            uint2 pk; pk.x = (unsigned)f2bf(o0) | ((unsigned)f2bf(o1) << 16); pk.y = (unsigned)f2bf(o2) | ((unsigned)f2bf(o3) << 16);
            *(uint2*)(N + (size_t)tok * 1024 + c) = pk;
        }
    }
    } else {
    const bf16* hin = which ? (const bf16*)(p.ws + WS_HM) : (const bf16*)p.out;
    for (int tok = id.bid * 8 + wave; tok < NTOK; tok += gridDim.x * 8) {
        const int b = tok >> 11;
        const float* shift = mod + b * 6144 + (which ? 3 : 0) * 1024; const float* scale = shift + 1024;
        const uint4* hr = (const uint4*)(hin + (size_t)tok * 1024);
        float v[2][8]; float ss = 0.f;
#pragma unroll
        for (int j = 0; j < 2; ++j) { unpack8(hr[lane + 64 * j], v[j]);
#pragma unroll
            for (int i = 0; i < 8; ++i) ss += v[j][i] * v[j][i]; }
        ss = wave_sum(ss);
        const float r = rsqrtf(ss * (1.f / 1024.f) + 1e-6f);
#pragma unroll
        for (int j = 0; j < 2; ++j) {
            const int c = (lane + 64 * j) * 8; float o[8];
#pragma unroll
            for (int q = 0; q < 2; ++q) { const float4 gg = *(const float4*)(g + c + 4 * q), sc = *(const float4*)(scale + c + 4 * q), sh = *(const float4*)(shift + c + 4 * q);
                o[4 * q] = v[j][4 * q] * r * gg.x * (1.f + sc.x) + sh.x; o[4 * q + 1] = v[j][4 * q + 1] * r * gg.y * (1.f + sc.y) + sh.y;
                o[4 * q + 2] = v[j][4 * q + 2] * r * gg.z * (1.f + sc.z) + sh.z; o[4 * q + 3] = v[j][4 * q + 3] * r * gg.w * (1.f + sc.w) + sh.w; }
            uint4 pk; pk.x = (unsigned)f2bf(o[0]) | ((unsigned)f2bf(o[1]) << 16); pk.y = (unsigned)f2bf(o[2]) | ((unsigned)f2bf(o[3]) << 16);
            pk.z = (unsigned)f2bf(o[4]) | ((unsigned)f2bf(o[5]) << 16); pk.w = (unsigned)f2bf(o[6]) | ((unsigned)f2bf(o[7]) << 16);
            *(uint4*)(N + (size_t)tok * 1024 + c) = pk;
        }
    }
    }
}

__device__ __forceinline__ int inproj_src_col(int n) { return n < 960 ? n : (n < 4032 ? n + 4 : (n < 4036 ? n - 4032 + 960 : n)); }
template <bool MAP, class Epi>
__device__ void gemm_naive(const Ids& id, const bf16* A, int lda, const float* W, int ldb, int N, int K, const Epi& epi, float* lds) {
    float* As = lds;
    float* Bs = lds + 16 * 132;
    const int tid = id.tid, tx = tid & 31, ty = tid >> 5;
    const int ntn = (N + 127) / 128, ntm = NTOK / 128;
    for (int tile = id.bid; tile < ntm * ntn; tile += gridDim.x) {
        const int tm = tile / ntn, tn = tile % ntn, m0 = tm * 128, n0 = tn * 128;
        float acc[8][4];
#pragma unroll
        for (int i = 0; i < 8; ++i)
#pragma unroll
            for (int j = 0; j < 4; ++j) acc[i][j] = 0.f;
        for (int k0 = 0; k0 < K; k0 += 16) {
            {
                const int row = tid >> 2, kq = (tid & 3) * 4;
                const uint2 raw = *(const uint2*)(A + (size_t)(m0 + row) * lda + k0 + kq);
                As[(kq + 0) * 132 + row] = __uint_as_float(raw.x << 16);
                As[(kq + 1) * 132 + row] = __uint_as_float(raw.x & 0xffff0000u);
                As[(kq + 2) * 132 + row] = __uint_as_float(raw.y << 16);
                As[(kq + 3) * 132 + row] = __uint_as_float(raw.y & 0xffff0000u);
            }
            {
                const int k = tid >> 5, nq = (tid & 31) * 4;
                float4 v = make_float4(0.f, 0.f, 0.f, 0.f);
                if (n0 + nq < N) v = *(const float4*)(W + (size_t)(k0 + k) * ldb + (MAP ? inproj_src_col(n0 + nq) : n0 + nq));
                *(float4*)(Bs + k * 128 + nq) = v;
            }
            __syncthreads();
#pragma unroll
            for (int kk = 0; kk < 16; ++kk) {
                const float4 a0 = *(const float4*)(As + kk * 132 + ty * 8), a1 = *(const float4*)(As + kk * 132 + ty * 8 + 4);
                const float4 bb = *(const float4*)(Bs + kk * 128 + tx * 4);
                const float a[8] = {a0.x, a0.y, a0.z, a0.w, a1.x, a1.y, a1.z, a1.w};
                const float b[4] = {bb.x, bb.y, bb.z, bb.w};
#pragma unroll
                for (int i = 0; i < 8; ++i)
#pragma unroll
                    for (int j = 0; j < 4; ++j) acc[i][j] += a[i] * b[j];
            }
            __syncthreads();
        }
        const int n = n0 + tx * 4;
        if (n < N) {
#pragma unroll
            for (int i = 0; i < 8; ++i) epi(m0 + ty * 8 + i, n, acc[i][0], acc[i][1], acc[i][2], acc[i][3]);
        }
    }
}

struct EpiBf { bf16* O; int ldo; int dcol0;
    __device__ __forceinline__ void operator()(int m, int n, float v0, float v1, float v2, float v3) const {
        uint2 pk; pk.x = (unsigned)f2bf(v0) | ((unsigned)f2bf(v1) << 16); pk.y = (unsigned)f2bf(v2) | ((unsigned)f2bf(v3) << 16);
        *(uint2*)(O + (size_t)m * ldo + dcol0 + n) = pk; } };
struct EpiF32 { float* T;
    __device__ __forceinline__ void operator()(int m, int n, float v0, float v1, float v2, float v3) const {
        *(float4*)(T + (size_t)m * 1024 + n) = make_float4(v0, v1, v2, v3); } };
__device__ __forceinline__ float sigm(float x) { return 1.f / (1.f + expf(-x)); }
struct EpiGate { const float* T; float* M; const float* bias; bf16* merged; int mode;
    __device__ __forceinline__ void operator()(int m, int n, float v0, float v1, float v2, float v3) const {
        const float4 t = *(const float4*)(T + (size_t)m * 1024 + n); const float4 bb = *(const float4*)(bias + n);
        float4 r = make_float4(sigm(v0 + bb.x) * t.x, sigm(v1 + bb.y) * t.y, sigm(v2 + bb.z) * t.z, sigm(v3 + bb.w) * t.w);
        if (mode >= 1) { const float4 o = *(const float4*)(M + (size_t)m * 1024 + n); r.x += o.x; r.y += o.y; r.z += o.z; r.w += o.w; }
        if (mode <= 1) *(float4*)(M + (size_t)m * 1024 + n) = r;
        else { uint2 pk; pk.x = (unsigned)f2bf(r.x) | ((unsigned)f2bf(r.y) << 16); pk.y = (unsigned)f2bf(r.z) | ((unsigned)f2bf(r.w) << 16);
               *(uint2*)(merged + (size_t)m * 1024 + n) = pk; } } };
struct EpiRes { const float* hin; float* out; const float* gate;
    __device__ __forceinline__ void operator()(int m, int n, float v0, float v1, float v2, float v3) const {
        const int b = m >> 11; const float4 g = *(const float4*)(gate + (size_t)b * 6144 + n); const float4 h = *(const float4*)(hin + (size_t)m * 1024 + n);
        *(float4*)(out + (size_t)m * 1024 + n) = make_float4(h.x + g.x * v0, h.y + g.y * v1, h.z + g.z * v2, h.w + g.w * v3); } };


struct EpiSigBfN { bf16* G; const float* bias;
    __device__ __forceinline__ void operator()(int m, int n, float v0, float v1, float v2, float v3) const {
        const float4 bb = *(const float4*)(bias + n);
        uint2 pk; pk.x = (unsigned)f2bf(sigm(v0 + bb.x)) | ((unsigned)f2bf(sigm(v1 + bb.y)) << 16); pk.y = (unsigned)f2bf(sigm(v2 + bb.z)) | ((unsigned)f2bf(sigm(v3 + bb.w)) << 16);
        *(uint2*)(G + (size_t)m * 3072 + n) = pk; } };
struct EpiProjN { const bf16* G; float* M; bf16* MG; int mode; const float* rawbias;
    __device__ __forceinline__ void operator()(int m, int n, float v0, float v1, float v2, float v3) const {
        const uint2 gw = *(const uint2*)(G + (size_t)m * 3072 + n);
        float g0 = __uint_as_float(gw.x << 16), g1 = __uint_as_float(gw.x & 0xffff0000u), g2 = __uint_as_float(gw.y << 16), g3 = __uint_as_float(gw.y & 0xffff0000u);
        if (rawbias) { g0 = sigm(g0 + rawbias[n]); g1 = sigm(g1 + rawbias[n + 1]); g2 = sigm(g2 + rawbias[n + 2]); g3 = sigm(g3 + rawbias[n + 3]); }
        float4 r = make_float4(v0 * g0, v1 * g1, v2 * g2, v3 * g3);
        if (mode >= 1) { const float4 o = *(const float4*)(M + (size_t)m * 1024 + n); r.x += o.x; r.y += o.y; r.z += o.z; r.w += o.w; }
        if (mode <= 1) *(float4*)(M + (size_t)m * 1024 + n) = r;
        else { uint2 pk; pk.x = (unsigned)f2bf(r.x) | ((unsigned)f2bf(r.y) << 16); pk.y = (unsigned)f2bf(r.z) | ((unsigned)f2bf(r.w) << 16);
               *(uint2*)(MG + (size_t)m * 1024 + n) = pk; } } };

__device__ __forceinline__ void ph_qknorm(const Ids& id, const Params& p, int layer) {
    bf16* Z = (bf16*)(p.ws + WS_Z);
    const int lane = id.tid & 63, wave = __builtin_amdgcn_readfirstlane(id.tid >> 6), sub = lane & 7;
    float gaq[8], gak[8], gbq[8], gbk[8];
#pragma unroll
    for (int i = 0; i < 8; ++i) { gaq[i] = p.a_qn_g[layer * 64 + sub * 8 + i]; gak[i] = p.a_kn_g[layer * 64 + sub * 8 + i]; gbq[i] = p.b_qn_g[layer * 64 + sub * 8 + i]; gbk[i] = p.b_kn_g[layer * 64 + sub * 8 + i]; }
    for (int tok = id.bid * 8 + wave; tok < NTOK; tok += gridDim.x * 8) {
        bf16* zr = Z + (size_t)tok * ZC;
        uint4* p0 = (uint4*)(zr + Z_AQ + lane * 8); uint4* p1 = (uint4*)(zr + Z_AK + sub * 8); uint4* p2 = (uint4*)(zr + Z_BQ + lane * 8); uint4* p3 = (uint4*)(zr + Z_BK + lane * 8);
        const uint4 r0 = *p0, r1 = *p1, r2 = *p2, r3 = *p3;
        float v0[8], v1[8], v2[8], v3[8]; unpack8(r0, v0); unpack8(r1, v1); unpack8(r2, v2); unpack8(r3, v3);
        float s0 = 0.f, s1 = 0.f, s2 = 0.f, s3 = 0.f;
#pragma unroll
        for (int i = 0; i < 8; ++i) { s0 += v0[i] * v0[i]; s1 += v1[i] * v1[i]; s2 += v2[i] * v2[i]; s3 += v3[i] * v3[i]; }
#pragma unroll
        for (int o = 1; o < 8; o <<= 1) { s0 += __shfl_xor(s0, o); s1 += __shfl_xor(s1, o); s2 += __shfl_xor(s2, o); s3 += __shfl_xor(s3, o); }
        const float n0 = rsqrtf(s0 * (1.f / 64.f) + 1e-6f), n1 = rsqrtf(s1 * (1.f / 64.f) + 1e-6f), n2 = rsqrtf(s2 * (1.f / 64.f) + 1e-6f), n3 = rsqrtf(s3 * (1.f / 64.f) + 1e-6f);
        uint4 o0, o1, o2, o3;
        o0.x = cvt_pk(v0[0] * n0 * gaq[0], v0[1] * n0 * gaq[1]); o0.y = cvt_pk(v0[2] * n0 * gaq[2], v0[3] * n0 * gaq[3]); o0.z = cvt_pk(v0[4] * n0 * gaq[4], v0[5] * n0 * gaq[5]); o0.w = cvt_pk(v0[6] * n0 * gaq[6], v0[7] * n0 * gaq[7]);
        o1.x = cvt_pk(v1[0] * n1 * gak[0], v1[1] * n1 * gak[1]); o1.y = cvt_pk(v1[2] * n1 * gak[2], v1[3] * n1 * gak[3]); o1.z = cvt_pk(v1[4] * n1 * gak[4], v1[5] * n1 * gak[5]); o1.w = cvt_pk(v1[6] * n1 * gak[6], v1[7] * n1 * gak[7]);
        o2.x = cvt_pk(v2[0] * n2 * gbq[0], v2[1] * n2 * gbq[1]); o2.y = cvt_pk(v2[2] * n2 * gbq[2], v2[3] * n2 * gbq[3]); o2.z = cvt_pk(v2[4] * n2 * gbq[4], v2[5] * n2 * gbq[5]); o2.w = cvt_pk(v2[6] * n2 * gbq[6], v2[7] * n2 * gbq[7]);
        o3.x = cvt_pk(v3[0] * n3 * gbk[0], v3[1] * n3 * gbk[1]); o3.y = cvt_pk(v3[2] * n3 * gbk[2], v3[3] * n3 * gbk[3]); o3.z = cvt_pk(v3[4] * n3 * gbk[4], v3[5] * n3 * gbk[5]); o3.w = cvt_pk(v3[6] * n3 * gbk[6], v3[7] * n3 * gbk[7]);
        *p0 = o0; if (lane < 8) *p1 = o1; *p2 = o2; *p3 = o3;
    }
}

__device__ __forceinline__ void ph_A(const Ids& id, const Params& p, float* lds) {
    const bf16* Z = (const bf16*)(p.ws + WS_Z); bf16* YA = (bf16*)(p.ws + WS_YA);
    float* s_iq = lds; float* s_iw = lds + 256; float* s_q = lds + 264; float* s_sc = lds + 776; int* s_sel = (int*)(lds + 2824); float* s_lg = lds + 3080;
    const int tid = id.tid, lane = tid & 63, wave = tid >> 6;
    for (int tok = id.bid; tok < NTOK; tok += gridDim.x) {
        const int b = tok >> 11, t = tok & 2047, limit = ((t >> 6) + 1) << 6;
        const bf16* zr = Z + (size_t)tok * ZC; const bf16* zb = Z + (size_t)b * SEQ * ZC;
        if (tid < 256) s_iq[tid] = bf2f(zr[Z_IQ + tid]);
        if (tid < 4) s_iw[tid] = bf2f(zr[Z_IW + tid]);
        s_q[tid] = bf2f(zr[Z_AQ + tid]);
        __syncthreads();
        for (int s = tid; s < limit; s += NTHR) {
            const uint4* kr = (const uint4*)(zb + (size_t)s * ZC + Z_IK);
            float d0 = 0.f, d1 = 0.f, d2 = 0.f, d3 = 0.f;
#pragma unroll 1
            for (int c = 0; c < 8; ++c) { float kv[8]; unpack8(kr[c], kv);
#pragma unroll
                for (int e = 0; e < 8; ++e) { const int d = c * 8 + e; d0 += s_iq[d] * kv[e]; d1 += s_iq[64 + d] * kv[e]; d2 += s_iq[128 + d] * kv[e]; d3 += s_iq[192 + d] * kv[e]; } }
            s_sc[s] = s_iw[0] * fmaxf(d0, 0.f) + s_iw[1] * fmaxf(d1, 0.f) + s_iw[2] * fmaxf(d2, 0.f) + s_iw[3] * fmaxf(d3, 0.f);
        }
        __syncthreads();
        int nk;
        if (limit <= 256) { nk = limit; if (tid < limit) s_sel[tid] = tid; }
        else { nk = 256;
            for (int s = tid; s < limit; s += NTHR) { const float v = s_sc[s]; int rank = 0;
                for (int j = 0; j < limit; ++j) { const float u = s_sc[j]; rank += (u > v || (u == v && j < s)) ? 1 : 0; }
                if (rank < 256) s_sel[rank] = s; } }
        __syncthreads();
        for (int idx = tid; idx < 2048; idx += NTHR) { const int h = idx >> 8, j = idx & 255;
            if (j < nk) { const uint4* kr = (const uint4*)(zb + (size_t)s_sel[j] * ZC + Z_AK); float dot = 0.f;
#pragma unroll 1
                for (int c = 0; c < 8; ++c) { float kv[8]; unpack8(kr[c], kv);
#pragma unroll
                    for (int e = 0; e < 8; ++e) dot += s_q[h * 64 + c * 8 + e] * kv[e]; }
                s_lg[idx] = dot * 0.125f; } }
        __syncthreads();
        { float* lg = s_lg + wave * 256; float m = -INFINITY;
          for (int j = lane; j < nk; j += 64) m = fmaxf(m, lg[j]);
          m = wave_max(m); float sum = 0.f;
          for (int j = lane; j < nk; j += 64) { const float e = expf(lg[j] - m); lg[j] = e; sum += e; }
          sum = wave_sum(sum); const float inv = 1.f / sum;
          for (int j = lane; j < nk; j += 64) lg[j] *= inv; }
        __syncthreads();
        { const int h = tid >> 6, d = tid & 63; float acc = 0.f;
          for (int j = 0; j < nk; ++j) acc += s_lg[h * 256 + j] * bf2f(zb[(size_t)s_sel[j] * ZC + Z_AV + d]);
          YA[(size_t)tok * 512 + tid] = f2bf(acc); }
        __syncthreads();
    }
}

__device__ __forceinline__ void ph_B(const Ids& id, const Params& p, float* lds) {
    const bf16* Z = (const bf16*)(p.ws + WS_Z); bf16* YB = (bf16*)(p.ws + WS_YB);
    const int tid = id.tid, lane = tid & 63, wave = tid >> 6;
    float* s_q = lds + wave * 64;
    for (int tok = id.bid; tok < NTOK; tok += gridDim.x) {
        const int b = tok >> 11, t = tok & 2047;
        const bf16* zr = Z + (size_t)tok * ZC; const bf16* zb = Z + (size_t)b * SEQ * ZC;
        s_q[lane] = bf2f(zr[Z_BQ + wave * 64 + lane]);
        __syncthreads();
        float acc = 0.f, carry = 0.f;
        for (int shi = t - 1; shi >= 0; shi -= 64) {
            const int s = shi - lane; const bool valid = s >= 0; const int sc = valid ? s : 0;
            const uint4* kr = (const uint4*)(zb + (size_t)sc * ZC + Z_BK + wave * 64);
            float dot = 0.f;
#pragma unroll
            for (int c = 0; c < 8; ++c) { float kv[8]; unpack8(kr[c], kv);
#pragma unroll
                for (int e = 0; e < 8; ++e) dot += s_q[c * 8 + e] * kv[e]; }
            const float zz = dot * 0.125f;
            const float lk = valid ? logsig(-zz) : 0.f, lb = logsig(zz);
            float incl = lk;
#pragma unroll
            for (int off = 1; off < 64; off <<= 1) { const float y = __shfl_up(incl, off); if (lane >= off) incl += y; }
            const float later = carry + incl - lk;
            const float a = valid ? expf(lb + later) : 0.f;
            carry += __shfl(incl, 63);
            const int cnt = (shi + 1 < 64) ? shi + 1 : 64;
            for (int l2 = 0; l2 < cnt; ++l2) { const float al = __shfl(a, l2); acc += al * bf2f(zb[(size_t)(shi - l2) * ZC + Z_BV + wave * 64 + lane]); }
        }
        YB[(size_t)tok * 512 + wave * 64 + lane] = f2bf(acc);
        __syncthreads();
    }
}


typedef short s16x8 __attribute__((ext_vector_type(8)));
typedef short s16x4 __attribute__((ext_vector_type(4)));
typedef float f32x16 __attribute__((ext_vector_type(16)));
typedef __attribute__((address_space(3))) unsigned char lds_u8;
constexpr float SB_EXIT = 30.0f;
__device__ __forceinline__ s16x8 ldsv8(const lds_u8* p) { return *(const __attribute__((address_space(3))) s16x8*)p; }
__device__ __forceinline__ s16x4 lds_tr_read(const lds_u8* p) { return __builtin_bit_cast(s16x4, __builtin_amdgcn_ds_read_tr16_b64_v4i16((__attribute__((address_space(3))) s16x4*)p)); }
__device__ __forceinline__ void ph_B_mfma(const Ids& id, const Params& p, float* lds) {
    const bf16* Z = (const bf16*)(p.ws + WS_Z); bf16* YB = (bf16*)(p.ws + WS_YB);
    const int lane = id.tid & 63, wave = __builtin_amdgcn_readfirstlane(id.tid >> 6), r = lane & 31, hf = lane >> 5;
    lds_u8* vl = (lds_u8*)lds + wave * 4096;
    const int i16 = lane & 15;
    const lds_u8* vrd = vl + (4 * hf + (i16 >> 2)) * 128 + ((lane >> 4) & 1) * 32 + (i16 & 3) * 8;
    for (int item = id.bid; item < 1024; item += gridDim.x) {
        const int b = item >> 6, h = (item >> 3) & 7, qt = (item & 7) * 8 + wave, t0 = qt * 32;
        const bf16* zb = Z + (size_t)b * SEQ * ZC;
        s16x8 qf[4];
#pragma unroll
        for (int kk = 0; kk < 4; ++kk) qf[kk] = *(const s16x8*)(zb + (size_t)(t0 + r) * ZC + Z_BQ + h * 64 + kk * 16 + hf * 8);
        f32x16 o0, o1;
#pragma unroll
        for (int i = 0; i < 16; ++i) { o0[i] = 0.f; o1[i] = 0.f; }
        float carry = 0.f;
        for (int s0 = t0; s0 >= 0; s0 -= 32) {
            s16x8 kf[4];
#pragma unroll
            for (int kk = 0; kk < 4; ++kk) kf[kk] = *(const s16x8*)(zb + (size_t)(s0 + r) * ZC + Z_BK + h * 64 + kk * 16 + hf * 8);
#pragma unroll
            for (int i = 0; i < 4; ++i) { const int row = (lane >> 3) + 8 * i;
                typedef unsigned u4v __attribute__((ext_vector_type(4)));
                const u4v v = *(const u4v*)(zb + (size_t)(s0 + row) * ZC + Z_BV + h * 64 + (lane & 7) * 8);
                *(__attribute__((address_space(3))) u4v*)(vl + row * 128 + (lane & 7) * 16) = v; }
            f32x16 sacc;
#pragma unroll
            for (int i = 0; i < 16; ++i) sacc[i] = 0.f;
#pragma unroll
            for (int kk = 0; kk < 4; ++kk) sacc = __builtin_amdgcn_mfma_f32_32x32x16_bf16(kf[kk], qf[kk], sacc, 0, 0, 0);
            float lk[16], lb[16];
            const int tq = t0 + r;
#pragma unroll
            for (int i = 0; i < 16; ++i) { const float zz = sacc[i] * 0.125f; const int key = s0 + (i & 3) + 8 * (i >> 2) + 4 * hf;
                const float l = fminf(zz, 0.f) - __logf(1.f + __expf(-fabsf(zz)));
                lb[i] = l; lk[i] = (key < tq) ? l - zz : 0.f; }
            float gs[4], go[4], base[4];
#pragma unroll
            for (int g = 0; g < 4; ++g) { gs[g] = (lk[4 * g] + lk[4 * g + 1]) + (lk[4 * g + 2] + lk[4 * g + 3]); go[g] = __shfl_xor(gs[g], 32); }
            float run = carry;
#pragma unroll
            for (int g = 3; g >= 0; --g) { base[g] = hf ? run : run + go[g]; run += gs[g] + go[g]; }
            carry = run;
            float a[16];
#pragma unroll
            for (int g = 0; g < 4; ++g) {
                const float l3 = base[g], l2 = l3 + lk[4 * g + 3], l1 = l2 + lk[4 * g + 2], l0 = l1 + lk[4 * g + 1];
                const int key0 = s0 + 8 * g + 4 * hf;
                a[4 * g + 0] = (key0 + 0 < tq) ? __expf(lb[4 * g + 0] + l0) : 0.f;
                a[4 * g + 1] = (key0 + 1 < tq) ? __expf(lb[4 * g + 1] + l1) : 0.f;
                a[4 * g + 2] = (key0 + 2 < tq) ? __expf(lb[4 * g + 2] + l2) : 0.f;
                a[4 * g + 3] = (key0 + 3 < tq) ? __expf(lb[4 * g + 3] + l3) : 0.f;
            }
            uint4 pw0, pw1;
            pw0.x = cvt_pk(a[0], a[1]); pw0.y = cvt_pk(a[2], a[3]); pw0.z = cvt_pk(a[4], a[5]); pw0.w = cvt_pk(a[6], a[7]);
            pw1.x = cvt_pk(a[8], a[9]); pw1.y = cvt_pk(a[10], a[11]); pw1.z = cvt_pk(a[12], a[13]); pw1.w = cvt_pk(a[14], a[15]);
            const s16x8 pf0 = __builtin_bit_cast(s16x8, pw0), pf1 = __builtin_bit_cast(s16x8, pw1);
            {
                const s16x4 a00l = lds_tr_read(vrd), a00h = lds_tr_read(vrd + 1024), a01l = lds_tr_read(vrd + 2048), a01h = lds_tr_read(vrd + 2048 + 1024);
                const s16x4 a10l = lds_tr_read(vrd + 64), a10h = lds_tr_read(vrd + 64 + 1024), a11l = lds_tr_read(vrd + 64 + 2048), a11h = lds_tr_read(vrd + 64 + 2048 + 1024);
                o0 = __builtin_amdgcn_mfma_f32_32x32x16_bf16(__builtin_shufflevector(a00l, a00h, 0, 1, 2, 3, 4, 5, 6, 7), pf0, o0, 0, 0, 0);
                o0 = __builtin_amdgcn_mfma_f32_32x32x16_bf16(__builtin_shufflevector(a01l, a01h, 0, 1, 2, 3, 4, 5, 6, 7), pf1, o0, 0, 0, 0);
                o1 = __builtin_amdgcn_mfma_f32_32x32x16_bf16(__builtin_shufflevector(a10l, a10h, 0, 1, 2, 3, 4, 5, 6, 7), pf0, o1, 0, 0, 0);
                o1 = __builtin_amdgcn_mfma_f32_32x32x16_bf16(__builtin_shufflevector(a11l, a11h, 0, 1, 2, 3, 4, 5, 6, 7), pf1, o1, 0, 0, 0);
            }
            if (__all(carry < -SB_EXIT)) break;
        }
        bf16* orow = YB + (size_t)(b * SEQ + t0 + r) * 512 + h * 64 + 4 * hf;
#pragma unroll
        for (int g = 0; g < 4; ++g) {
            uint2 w0, w1; w0.x = cvt_pk(o0[4 * g], o0[4 * g + 1]); w0.y = cvt_pk(o0[4 * g + 2], o0[4 * g + 3]);
            w1.x = cvt_pk(o1[4 * g], o1[4 * g + 1]); w1.y = cvt_pk(o1[4 * g + 2], o1[4 * g + 3]);
            *(uint2*)(orow + 8 * g) = w0; *(uint2*)(orow + 32 + 8 * g) = w1;
        }
    }
    __syncthreads();
}


__device__ __forceinline__ int wave_sum_i32(int v) {
    v += __builtin_amdgcn_update_dpp(0, v, 0x128, 0xf, 0xf, true);
    v += __builtin_amdgcn_update_dpp(0, v, 0x124, 0xf, 0xf, true);
    v += __builtin_amdgcn_update_dpp(0, v, 0x122, 0xf, 0xf, true);
    v += __builtin_amdgcn_update_dpp(0, v, 0x121, 0xf, 0xf, true);
    return __builtin_amdgcn_readlane(v, 0) + __builtin_amdgcn_readlane(v, 16) + __builtin_amdgcn_readlane(v, 32) + __builtin_amdgcn_readlane(v, 48);
}
#ifndef REP_SEL
#define REP_SEL 1
#endif
#ifndef REP_ATT
#define REP_ATT 1
#endif
constexpr int SC_STRIDE = 2052;

template <int NJ>
__device__ __forceinline__ void select_emit(const unsigned (&u)[NJ], unsigned T, int lane, unsigned* mrow) {
    int cg = 0, ce = 0;
#pragma unroll
    for (int j = 0; j < NJ; ++j) { cg += (u[j] > T) ? 1 : 0; ce += (u[j] == T) ? 1 : 0; }
    const int cpk = wave_sum_i32(cg | (ce << 16)); const int cgt = cpk & 0xffff, ceq = cpk >> 16, need = 256 - cgt;
    if (ceq == need) {
#pragma unroll 4
        for (int j = 0; j < NJ; ++j) { const unsigned long long bal = __builtin_amdgcn_ballot_w64(u[j] >= T); if (lane == 0) { mrow[2 * j] = (unsigned)bal; mrow[2 * j + 1] = (unsigned)(bal >> 32); } }
    } else {
        int running = 0;
#pragma unroll 4
        for (int j = 0; j < NJ; ++j) { const unsigned long long eqm = __builtin_amdgcn_ballot_w64(u[j] == T);
            const int pre = running + (int)__builtin_amdgcn_mbcnt_hi((unsigned)(eqm >> 32), __builtin_amdgcn_mbcnt_lo((unsigned)eqm, 0u));
            const unsigned long long bal = __builtin_amdgcn_ballot_w64(u[j] > T || (u[j] == T && pre < need));
            if (lane == 0) { mrow[2 * j] = (unsigned)bal; mrow[2 * j + 1] = (unsigned)(bal >> 32); }
            running += __builtin_popcountll(eqm); }
    }
    if (lane < 32 - NJ) { mrow[2 * (NJ + lane)] = 0u; mrow[2 * (NJ + lane) + 1] = 0u; }
}
template <int NJ>
__device__ __forceinline__ void select2(const float* scq, int nj, int lane, unsigned* mrow0) {
    unsigned u0[NJ], u1[NJ];
#pragma unroll
    for (int j = 0; j < NJ; ++j) { unsigned k0 = 0u, k1 = 0u;
        if (j < nj) { const float x0 = scq[j * 64 + lane] + 0.0f, x1 = scq[SC_STRIDE + j * 64 + lane] + 0.0f; const unsigned b0 = __float_as_uint(x0), b1 = __float_as_uint(x1);
            k0 = (b0 & 0x80000000u) ? ~b0 : (b0 | 0x80000000u); k1 = (b1 & 0x80000000u) ? ~b1 : (b1 | 0x80000000u); }
        u0[j] = k0; u1[j] = k1; }
    unsigned T0 = 0u, T1 = 0u;
    for (int bit = 31; bit >= 0; --bit) {
        const unsigned Tc0 = T0 | (1u << bit), Tc1 = T1 | (1u << bit); int c0 = 0, c1 = 0;
#pragma unroll
        for (int j = 0; j < NJ; ++j) { c0 += (u0[j] >= Tc0) ? 1 : 0; c1 += (u1[j] >= Tc1) ? 1 : 0; }
        const int sp = wave_sum_i32(c0 | (c1 << 16));
        const int s0 = sp & 0xffff, s1 = sp >> 16;
        if (s0 >= 256) T0 = Tc0;
        if (s1 >= 256) T1 = Tc1;
    }
    select_emit<NJ>(u0, T0, lane, mrow0); select_emit<NJ>(u1, T1, lane, mrow0 + 64);
}
typedef float f32x4v __attribute__((ext_vector_type(4)));

__device__ __forceinline__ void ph_A_mfma(const Ids& id, const Params& p, int layer, float* lds, size_t ya_off = WS_YA, int bmax = 16) {
    const bf16* Z = (const bf16*)(p.ws + WS_Z); bf16* YA = (bf16*)(p.ws + ya_off);
    const int lane = id.tid & 63, wave = __builtin_amdgcn_readfirstlane(id.tid >> 6), r = lane & 31, hf = lane >> 5;
    float* sc = lds;
    unsigned* msk = (unsigned*)(lds + 16 * SC_STRIDE);
    lds_u8* vl = (lds_u8*)lds + wave * 4096;
    const int i16 = lane & 15;
    const lds_u8* vrd = vl + (4 * hf + (i16 >> 2)) * 128 + ((lane >> 4) & 1) * 32 + (i16 & 3) * 8;
    float Mref2; bool fixref;
    { const float gq = wave_max(fabsf(p.a_qn_g[layer * 64 + lane])), gk = wave_max(fabsf(p.a_kn_g[layer * 64 + lane]));
      Mref2 = 8.f * gq * gk * 1.001f * 1.4426950408889634f + 0.01f; fixref = Mref2 < 40.f; }
    for (int it = id.bid; it < 1024; it += gridDim.x) {
        const int c = it & 255, k4 = it >> 8, qp = c & 63, qt = (k4 & 1) ? 63 - qp : qp, b = (c >> 6) + 4 * k4;
        const int t0 = qt * 32, limit = ((t0 >> 6) + 1) << 6, nj = limit >> 6;
        const bf16* zb = Z + (size_t)b * SEQ * ZC;
        for (int half = 0; half < 2; ++half) {
            const int tq0 = t0 + 16 * half, qc = lane & 15, kg = lane >> 4;
            {
                s16x8 bq[4][2]; float w[4];
#pragma unroll
                for (int h = 0; h < 4; ++h) {
#pragma unroll
                    for (int kk = 0; kk < 2; ++kk) bq[h][kk] = *(const s16x8*)(zb + (size_t)(tq0 + qc) * ZC + Z_IQ + h * 64 + kk * 32 + kg * 8);
                    w[h] = bf2f(zb[(size_t)(tq0 + qc) * ZC + Z_IW + h]); }
                for (int kt0 = wave; kt0 * 16 < limit; kt0 += 32) {
                    s16x8 ak[4][2]; int key0[4]; bool ok[4];
#pragma unroll
                    for (int jt = 0; jt < 4; ++jt) { const int kt = kt0 + 8 * jt; ok[jt] = kt * 16 < limit; key0[jt] = (ok[jt] ? kt : kt0) * 16;
                        ak[jt][0] = *(const s16x8*)(zb + (size_t)(key0[jt] + qc) * ZC + Z_IK + kg * 8); ak[jt][1] = *(const s16x8*)(zb + (size_t)(key0[jt] + qc) * ZC + Z_IK + 32 + kg * 8); }
#pragma unroll
                    for (int jt = 0; jt < 4; ++jt) {
                        f32x4v score = {0.f, 0.f, 0.f, 0.f};
#pragma unroll
                        for (int h = 0; h < 4; ++h) { f32x4v d = {0.f, 0.f, 0.f, 0.f};
                            d = __builtin_amdgcn_mfma_f32_16x16x32_bf16(ak[jt][0], bq[h][0], d, 0, 0, 0); d = __builtin_amdgcn_mfma_f32_16x16x32_bf16(ak[jt][1], bq[h][1], d, 0, 0, 0);
#pragma unroll
                            for (int e = 0; e < 4; ++e) score[e] += w[h] * fmaxf(d[e], 0.f); }
                        if (ok[jt]) *(f32x4v*)(sc + qc * SC_STRIDE + key0[jt] + 4 * kg) = score;
                    }
                }
            }
            __syncthreads();
            for (int rsel = 0; rsel < REP_SEL; ++rsel) {
                asm volatile("" : "+s"(rsel));
                unsigned* mrow0 = msk + (16 * half + wave * 2) * 64;
                if (nj <= 4) {
                    if (lane < 32) { const unsigned v = (lane < nj) ? 0xffffffffu : 0u; mrow0[2 * lane] = v; mrow0[2 * lane + 1] = v; mrow0[64 + 2 * lane] = v; mrow0[64 + 2 * lane + 1] = v; }
                } else if (nj <= 8) select2<8>(sc + (wave * 2) * SC_STRIDE, nj, lane, mrow0);
                else if (nj <= 16) select2<16>(sc + (wave * 2) * SC_STRIDE, nj, lane, mrow0);
                else if (nj <= 24) select2<24>(sc + (wave * 2) * SC_STRIDE, nj, lane, mrow0);
                else select2<32>(sc + (wave * 2) * SC_STRIDE, nj, lane, mrow0);
            }
            __syncthreads();
        }
        for (int ratt = 0; ratt < REP_ATT; ++ratt) {
            asm volatile("" : "+s"(ratt));
            const int h = wave;
            s16x8 qf[4];
#pragma unroll
            for (int kk = 0; kk < 4; ++kk) qf[kk] = *(const s16x8*)(zb + (size_t)(t0 + r) * ZC + Z_AQ + h * 64 + kk * 16 + hf * 8);
            f32x16 o0, o1;
#pragma unroll
            for (int i = 0; i < 16; ++i) { o0[i] = 0.f; o1[i] = 0.f; }
            float m = -1e30f, l = 0.f;
            typedef unsigned u4v __attribute__((ext_vector_type(4)));
            const int tid_ = id.tid;
            u4v stg[8];
#define ATT_LOAD(c0) do { _Pragma("unroll") for (int i_ = 0; i_ < 4; ++i_) { const int pc = tid_ + 512 * i_, row = pc >> 3, col = pc & 7; const int key = (c0) + row; \
        const size_t go = (size_t)(key < limit ? key : 0) * ZC + col * 8; stg[i_] = *(const u4v*)(zb + go + Z_AK); stg[4 + i_] = *(const u4v*)(zb + go + Z_AV); } } while (0)
#define ATT_STORE(bufo) do { _Pragma("unroll") for (int i_ = 0; i_ < 4; ++i_) { const int pc = tid_ + 512 * i_, row = pc >> 3, col = pc & 7; \
        *(__attribute__((address_space(3))) u4v*)((lds_u8*)lds + (bufo) + row * 128 + ((col ^ (row & 7)) << 4)) = stg[i_]; \
        *(__attribute__((address_space(3))) u4v*)((lds_u8*)lds + (bufo) + 32768 + row * 128 + (col << 4)) = stg[4 + i_]; } } while (0)
            ATT_LOAD(0); ATT_STORE(0);
            __syncthreads();
            for (int c0 = 0; c0 < limit; c0 += 256) {
                const int bufo = ((c0 >> 8) & 1) * 65536;
                if (c0 + 256 < limit) ATT_LOAD(c0 + 256);
                const int ntile = (limit - c0 < 256) ? ((limit - c0) >> 5) : 8;
                for (int tl = 0; tl < ntile; ++tl) {
                    const int s0 = c0 + tl * 32;
                    const unsigned mw = msk[r * 64 + (s0 >> 5)];
                    if (!__any(mw != 0u)) continue;
                    const lds_u8* kb = (const lds_u8*)lds + bufo + (tl * 32 + r) * 128;
                    f32x16 sacc;
#pragma unroll
                    for (int i = 0; i < 16; ++i) sacc[i] = 0.f;
#pragma unroll
                    for (int kk = 0; kk < 4; ++kk) sacc = __builtin_amdgcn_mfma_f32_32x32x16_bf16(ldsv8(kb + (((kk * 2 + hf) ^ (r & 7)) << 4)), qf[kk], sacc, 0, 0, 0);
                    float a[16]; const unsigned mwh = mw >> (4 * hf);
                    if (fixref) {
                        float ps = 0.f;
#pragma unroll
                        for (int i = 0; i < 16; ++i) { const bool on = (mwh >> ((i & 3) + 8 * (i >> 2))) & 1u;
                            a[i] = on ? __builtin_amdgcn_exp2f(sacc[i] * (0.125f * 1.4426950408889634f) - Mref2) : 0.f; ps += a[i]; }
                        l += ps;
                    } else {
                        float sv[16]; float mx = -1e30f;
#pragma unroll
                        for (int i = 0; i < 16; ++i) { const bool on = (mwh >> ((i & 3) + 8 * (i >> 2))) & 1u;
                            sv[i] = on ? sacc[i] * (0.125f * 1.4426950408889634f) : -1e30f; mx = fmaxf(mx, sv[i]); }
                        mx = fmaxf(mx, __shfl_xor(mx, 32));
                        const float mn = fmaxf(m, mx), alpha = __builtin_amdgcn_exp2f(m - mn);
                        m = mn;
                        float ps = 0.f;
#pragma unroll
                        for (int i = 0; i < 16; ++i) { a[i] = __builtin_amdgcn_exp2f(sv[i] - mn); ps += a[i]; }
                        l = l * alpha + ps;
#pragma unroll
                        for (int i = 0; i < 16; ++i) { o0[i] *= alpha; o1[i] *= alpha; }
                    }
                    uint4 pw0, pw1;
                    pw0.x = cvt_pk(a[0], a[1]); pw0.y = cvt_pk(a[2], a[3]); pw0.z = cvt_pk(a[4], a[5]); pw0.w = cvt_pk(a[6], a[7]);
                    pw1.x = cvt_pk(a[8], a[9]); pw1.y = cvt_pk(a[10], a[11]); pw1.z = cvt_pk(a[12], a[13]); pw1.w = cvt_pk(a[14], a[15]);
                    const s16x8 pf0 = __builtin_bit_cast(s16x8, pw0), pf1 = __builtin_bit_cast(s16x8, pw1);
                    const lds_u8* vr2 = (const lds_u8*)lds + bufo + 32768 + tl * 4096 + (4 * hf + (i16 >> 2)) * 128 + ((lane >> 4) & 1) * 32 + (i16 & 3) * 8;
                    const s16x4 a00l = lds_tr_read(vr2), a00h = lds_tr_read(vr2 + 1024), a01l = lds_tr_read(vr2 + 2048), a01h = lds_tr_read(vr2 + 2048 + 1024);
                    const s16x4 a10l = lds_tr_read(vr2 + 64), a10h = lds_tr_read(vr2 + 64 + 1024), a11l = lds_tr_read(vr2 + 64 + 2048), a11h = lds_tr_read(vr2 + 64 + 2048 + 1024);
                    o0 = __builtin_amdgcn_mfma_f32_32x32x16_bf16(__builtin_shufflevector(a00l, a00h, 0, 1, 2, 3, 4, 5, 6, 7), pf0, o0, 0, 0, 0);
                    o0 = __builtin_amdgcn_mfma_f32_32x32x16_bf16(__builtin_shufflevector(a01l, a01h, 0, 1, 2, 3, 4, 5, 6, 7), pf1, o0, 0, 0, 0);
                    o1 = __builtin_amdgcn_mfma_f32_32x32x16_bf16(__builtin_shufflevector(a10l, a10h, 0, 1, 2, 3, 4, 5, 6, 7), pf0, o1, 0, 0, 0);
                    o1 = __builtin_amdgcn_mfma_f32_32x32x16_bf16(__builtin_shufflevector(a11l, a11h, 0, 1, 2, 3, 4, 5, 6, 7), pf1, o1, 0, 0, 0);
                }
                if (c0 + 256 < limit) ATT_STORE(65536 - bufo);
                __syncthreads();
            }
#undef ATT_LOAD
#undef ATT_STORE
            l += __shfl_xor(l, 32);
            const float inv = 1.f / l;
            bf16* orow = YA + (size_t)(b * SEQ + t0 + r) * 512 + h * 64 + 4 * hf;
            if (b < bmax)
#pragma unroll
            for (int g = 0; g < 4; ++g) {
                uint2 w0, w1; w0.x = cvt_pk(o0[4 * g] * inv, o0[4 * g + 1] * inv); w0.y = cvt_pk(o0[4 * g + 2] * inv, o0[4 * g + 3] * inv);
                w1.x = cvt_pk(o1[4 * g] * inv, o1[4 * g + 1] * inv); w1.y = cvt_pk(o1[4 * g + 2] * inv, o1[4 * g + 3] * inv);
                *(uint2*)(orow + 8 * g) = w0; *(uint2*)(orow + 32 + 8 * g) = w1;
            }
        }
        __syncthreads();
    }
}


constexpr int C_QT = 0, C_KT = 9216, C_QH = 18432, C_KH = 27648, C_VV = 36864, C_SS = 54272, C_F32 = 71680;
__device__ __forceinline__ void ph_C_mfma(const Ids& id, const Params& p, int layer, float* lds) {
    const bf16* Z = (const bf16*)(p.ws + WS_Z); bf16* YC = (bf16*)(p.ws + WS_YC);
    const int tid = id.tid, lane = tid & 63, wave = tid >> 6, r = lane & 31, hf = lane >> 5, i16 = lane & 15;
    lds_u8* L = (lds_u8*)lds;
    typedef __attribute__((address_space(3))) unsigned short lds_u16; typedef __attribute__((address_space(3))) float lds_f32;
    lds_f32* F = (lds_f32*)(L + C_F32);
    const float* walp = p.c_w_alpha + layer * 16 * 256; const float* balp = p.c_b_alpha + layer * 256; const float* gainp = p.c_on_g + layer * 512;
    const int kt = wave & 1, vt2 = wave >> 1;
    const int tt = wave & 1, vt = wave >> 1;
    const int trrow = 8 * hf + (i16 >> 2), trcol = ((lane >> 4) & 1) * 16 + (i16 & 3) * 4;
    const int prow = 4 * hf + (i16 >> 2);
    for (int item = id.bid; item < 64; item += gridDim.x) {
        const int b = item >> 2, h = item & 3; const bf16* zb = Z + (size_t)b * SEQ * ZC;
        __syncthreads();
        for (int i = tid; i < 1024; i += NTHR) F[960 + i] = walp[(i >> 6) * 256 + h * 64 + (i & 63)];
        if (tid < 64) F[1984 + tid] = balp[h * 64 + tid];
        if (tid < 128) F[2048 + tid] = gainp[h * 128 + tid];
        for (int i = tid; i < 64 * 136 / 2; i += NTHR) ((__attribute__((address_space(3))) unsigned*)(L + C_SS))[i] = 0u;
        f32x16 S;
#pragma unroll
        for (int i = 0; i < 16; ++i) S[i] = 0.f;
        __syncthreads();
        for (int c = 0; c < 32; ++c) {
            const int t0c = c * 64; const int k = lane;
            float bb[8], qv[8], kv[8];
            {
                float run = 0.f;
#pragma unroll
                for (int i = 0; i < 8; ++i) { const bf16* zr = zb + (size_t)(t0c + 8 * wave + i) * ZC;
                    float a[16];
                    { const uint2 a0 = *(const uint2*)(zr + Z_CA), a1 = *(const uint2*)(zr + Z_CA + 4), a2 = *(const uint2*)(zr + Z_CA + 8), a3 = *(const uint2*)(zr + Z_CA + 12);
                      uint4 lo4, hi4; lo4.x = a0.x; lo4.y = a0.y; lo4.z = a1.x; lo4.w = a1.y; hi4.x = a2.x; hi4.y = a2.y; hi4.z = a3.x; hi4.w = a3.y; unpack8(lo4, a); unpack8(hi4, a + 8); }
                    float x = F[1984 + k];
#pragma unroll
                    for (int rr = 0; rr < 16; ++rr) x += a[rr] * F[960 + rr * 64 + k];
                    const float la = (fminf(x, 0.f) - __logf(1.f + __expf(-fabsf(x)))) * (1.f / 16.f);
                    run += la; bb[i] = run;
                    qv[i] = bf2f(zr[Z_CQ + h * 64 + k]) * 0.125f; kv[i] = bf2f(zr[Z_CK + h * 64 + k]); }
                F[wave * 64 + k] = run;
                typedef unsigned u4v __attribute__((ext_vector_type(4)));
#pragma unroll
                for (int i = 0; i < 2; ++i) { const int idx = tid + i * 512, row = idx >> 4, ch = idx & 15;
                    const u4v v = *(const u4v*)(zb + (size_t)(t0c + row) * ZC + Z_CV + h * 128 + ch * 8);
                    *(__attribute__((address_space(3))) u4v*)(L + C_VV + row * 272 + ch * 16) = v; }
            }
            __syncthreads();
            {   float pre = 0.f;
                for (int g = 0; g < wave; ++g) pre += F[g * 64 + k];
#pragma unroll
                for (int i = 0; i < 8; ++i) bb[i] += pre;
                if (wave == 3) F[512 + k] = bb[7];
                if (wave == 7) { F[576 + k] = bb[7]; F[640 + k] = __expf(bb[7]); }
            }
            __syncthreads();
            {   const float bmid = F[512 + k], blast = F[576 + k];
#pragma unroll
                for (int i = 0; i < 8; ++i) { const int t = 8 * wave + i;
                    const float e1 = __expf(fminf(fmaxf(bb[i] - bmid, -80.f), 80.f)), e2 = __expf(fminf(fmaxf(bmid - bb[i], -80.f), 80.f));
                    ((lds_u16*)(L + C_QT))[t * 72 + k] = f2bf(qv[i] * e1); ((lds_u16*)(L + C_KT))[t * 72 + k] = f2bf(kv[i] * e2);
                    ((lds_u16*)(L + C_QH))[t * 72 + k] = f2bf(qv[i] * __expf(bb[i])); ((lds_u16*)(L + C_KH))[t * 72 + k] = f2bf(kv[i] * __expf(blast - bb[i])); }
            }
            __syncthreads();
            f32x16 o;
#pragma unroll
            for (int i = 0; i < 16; ++i) o[i] = 0.f;
            {
#pragma unroll
                for (int ks = 0; ks < 4; ++ks) {
                    const lds_u8* ap = L + C_SS + (16 * ks + trrow) * 272 + (vt * 32 + trcol) * 2;
                    const s16x4 lo = lds_tr_read(ap), hi = lds_tr_read(ap + 4 * 272);
                    const s16x8 bq = ldsv8(L + C_QH + (tt * 32 + r) * 144 + (16 * ks + 8 * hf) * 2);
                    o = __builtin_amdgcn_mfma_f32_32x32x16_bf16(__builtin_shufflevector(lo, hi, 0, 1, 2, 3, 4, 5, 6, 7), bq, o, 0, 0, 0);
                }
            }
#pragma unroll
            for (int st = 0; st < 2; ++st) {
                if (st > tt) continue;
                f32x16 at;
#pragma unroll
                for (int i = 0; i < 16; ++i) at[i] = 0.f;
#pragma unroll
                for (int kk = 0; kk < 4; ++kk) at = __builtin_amdgcn_mfma_f32_32x32x16_bf16(ldsv8(L + C_KT + (st * 32 + r) * 144 + (kk * 16 + hf * 8) * 2), ldsv8(L + C_QT + (tt * 32 + r) * 144 + (kk * 16 + hf * 8) * 2), at, 0, 0, 0);
                if (st == tt) {
#pragma unroll
                    for (int i = 0; i < 16; ++i) { const int srow = (i & 3) + 8 * (i >> 2) + 4 * hf; if (srow > r) at[i] = 0.f; }
                }
                uint4 pw0, pw1;
                pw0.x = cvt_pk(at[0], at[1]); pw0.y = cvt_pk(at[2], at[3]); pw0.z = cvt_pk(at[4], at[5]); pw0.w = cvt_pk(at[6], at[7]);
                pw1.x = cvt_pk(at[8], at[9]); pw1.y = cvt_pk(at[10], at[11]); pw1.z = cvt_pk(at[12], at[13]); pw1.w = cvt_pk(at[14], at[15]);
                const s16x8 pf0 = __builtin_bit_cast(s16x8, pw0), pf1 = __builtin_bit_cast(s16x8, pw1);
                const lds_u8* vp = L + C_VV + (st * 32 + prow) * 272 + (vt * 32 + trcol) * 2;
                const s16x4 v0l = lds_tr_read(vp), v0h = lds_tr_read(vp + 8 * 272), v1l = lds_tr_read(vp + 16 * 272), v1h = lds_tr_read(vp + 24 * 272);
                o = __builtin_amdgcn_mfma_f32_32x32x16_bf16(__builtin_shufflevector(v0l, v0h, 0, 1, 2, 3, 4, 5, 6, 7), pf0, o, 0, 0, 0);
                o = __builtin_amdgcn_mfma_f32_32x32x16_bf16(__builtin_shufflevector(v1l, v1h, 0, 1, 2, 3, 4, 5, 6, 7), pf1, o, 0, 0, 0);
            }
            {
#pragma unroll
                for (int i = 0; i < 16; ++i) S[i] *= F[640 + kt * 32 + (i & 3) + 8 * (i >> 2) + 4 * hf];
#pragma unroll
                for (int ks = 0; ks < 4; ++ks) {
                    const lds_u8* ap = L + C_KH + (16 * ks + trrow) * 144 + (kt * 32 + trcol) * 2;
                    const lds_u8* bp = L + C_VV + (16 * ks + trrow) * 272 + (vt2 * 32 + trcol) * 2;
                    const s16x4 al = lds_tr_read(ap), ah = lds_tr_read(ap + 4 * 144), bl = lds_tr_read(bp), bh = lds_tr_read(bp + 4 * 272);
                    S = __builtin_amdgcn_mfma_f32_32x32x16_bf16(__builtin_shufflevector(al, ah, 0, 1, 2, 3, 4, 5, 6, 7), __builtin_shufflevector(bl, bh, 0, 1, 2, 3, 4, 5, 6, 7), S, 0, 0, 0);
                }
            }
            {   float ss = 0.f;
#pragma unroll
                for (int i = 0; i < 16; ++i) ss += o[i] * o[i];
                ss += __shfl_xor(ss, 32);
                __syncthreads();
                if (hf == 0) F[704 + vt * 64 + tt * 32 + r] = ss;
#pragma unroll
                for (int i = 0; i < 16; ++i) ((lds_u16*)(L + C_SS))[(kt * 32 + (i & 3) + 8 * (i >> 2) + 4 * hf) * 136 + vt2 * 32 + r] = f2bf(S[i]);
            }
            __syncthreads();
            {   const int t = tt * 32 + r;
                const float tot = F[704 + t] + F[704 + 64 + t] + F[704 + 128 + t] + F[704 + 192 + t];
                const float rn = rsqrtf(tot * (1.f / 128.f) + 1e-6f);
                const bf16* rrow = zb + (size_t)(t0c + t) * ZC + Z_CR + h * 128 + vt * 32 + 4 * hf;
                bf16* orow = YC + (size_t)(b * SEQ + t0c + t) * 512 + h * 128 + vt * 32 + 4 * hf;
#pragma unroll
                for (int g = 0; g < 4; ++g) {
                    const uint2 rw = *(const uint2*)(rrow + 8 * g);
                    const float r0 = __uint_as_float(rw.x << 16), r1 = __uint_as_float(rw.x & 0xffff0000u), r2 = __uint_as_float(rw.y << 16), r3 = __uint_as_float(rw.y & 0xffff0000u);
                    const int vb = 2048 + vt * 32 + 8 * g + 4 * hf;
                    const float y0 = o[4 * g] * rn * F[vb] * (r0 / (1.f + __expf(-r0))), y1 = o[4 * g + 1] * rn * F[vb + 1] * (r1 / (1.f + __expf(-r1)));
                    const float y2 = o[4 * g + 2] * rn * F[vb + 2] * (r2 / (1.f + __expf(-r2))), y3 = o[4 * g + 3] * rn * F[vb + 3] * (r3 / (1.f + __expf(-r3)));
                    uint2 w; w.x = cvt_pk(y0, y1); w.y = cvt_pk(y2, y3); *(uint2*)(orow + 8 * g) = w;
                }
            }
        }
    }
    __syncthreads();
}


constexpr size_t WS_CD = 452 * MiB;
constexpr size_t WS_CS = 484 * MiB;
constexpr size_t WS_CL = 444 * MiB;
template <int PASS>
__device__ __forceinline__ void ph_C_chunk(const Ids& id, const Params& p, int layer, float* lds) {
    const bf16* Z = (const bf16*)(p.ws + WS_Z); bf16* YC = (bf16*)(p.ws + WS_YC);
    bf16* CD = (bf16*)(p.ws + WS_CD); const bf16* CS = (const bf16*)(p.ws + WS_CS); float* CL = (float*)(p.ws + WS_CL);
    const int tid = id.tid, lane = tid & 63, wave = tid >> 6, r = lane & 31, hf = lane >> 5, i16 = lane & 15;
    lds_u8* L = (lds_u8*)lds;
    typedef __attribute__((address_space(3))) unsigned short lds_u16; typedef __attribute__((address_space(3))) float lds_f32;
    lds_f32* F = (lds_f32*)(L + C_F32);
    const float* walp = p.c_w_alpha + layer * 16 * 256; const float* balp = p.c_b_alpha + layer * 256; const float* gainp = p.c_on_g + layer * 512;
    const int kt = wave & 1, vt2 = wave >> 1, tt = wave & 1, vt = wave >> 1;
    const int trrow = 8 * hf + (i16 >> 2), trcol = ((lane >> 4) & 1) * 16 + (i16 & 3) * 4, prow = 4 * hf + (i16 >> 2);
    typedef unsigned u4v __attribute__((ext_vector_type(4)));
    int h_loaded = -1;
    u4v cspre[2];
    if (PASS == 3 && id.bid < 2048) {
#pragma unroll
        for (int i = 0; i < 2; ++i) { const int idx = tid + i * 512, row = idx >> 4, ch = idx & 15; cspre[i] = *(const u4v*)(CS + (size_t)id.bid * 8192 + row * 128 + ch * 8); } }
    for (int item = id.bid; item < 2048; item += gridDim.x) {
        const int c = item & 31, bh = item >> 5, b = bh >> 2, h = bh & 3; const bf16* zb = Z + (size_t)b * SEQ * ZC;
        const int t0c = c * 64, k = lane;
        u4v vpre[2];
#pragma unroll
        for (int i = 0; i < 2; ++i) { const int idx = tid + i * 512, row = idx >> 4, ch = idx & 15; vpre[i] = *(const u4v*)(zb + (size_t)(t0c + row) * ZC + Z_CV + h * 128 + ch * 8); }
        const unsigned apre = *(const unsigned*)(zb + (size_t)(t0c + 8 * wave + (lane >> 3)) * ZC + Z_CA + (lane & 7) * 2);
        bf16 qpre[8], kpre[8];
#pragma unroll
        for (int i = 0; i < 8; ++i) { const bf16* zr = zb + (size_t)(t0c + 8 * wave + i) * ZC; if (PASS == 3) qpre[i] = zr[Z_CQ + h * 64 + k]; kpre[i] = zr[Z_CK + h * 64 + k]; }
        uint2 rpre[4];
        if (PASS == 3) { const bf16* rrow0 = zb + (size_t)(t0c + tt * 32 + r) * ZC + Z_CR + h * 128 + vt * 32 + 4 * hf;
#pragma unroll
            for (int g = 0; g < 4; ++g) rpre[g] = *(const uint2*)(rrow0 + 8 * g); }
        __syncthreads();
        if (h != h_loaded) {
            for (int i = tid; i < 1024; i += NTHR) F[960 + i] = walp[(i >> 6) * 256 + h * 64 + (i & 63)];
            if (tid < 64) F[1984 + tid] = balp[h * 64 + tid];
            if (PASS == 3 && tid < 128) F[2048 + tid] = gainp[h * 128 + tid];
            h_loaded = h;
        }
        if (PASS == 3) {
#pragma unroll
            for (int i = 0; i < 2; ++i) { const int idx = tid + i * 512, row = idx >> 4, ch = idx & 15;
                *(__attribute__((address_space(3))) u4v*)(L + C_SS + row * 272 + ch * 16) = cspre[i]; }
            const int nitem = item + (int)gridDim.x;
            if (nitem < 2048) {
#pragma unroll
                for (int i = 0; i < 2; ++i) { const int idx = tid + i * 512, row = idx >> 4, ch = idx & 15; cspre[i] = *(const u4v*)(CS + (size_t)nitem * 8192 + row * 128 + ch * 8); } }
        }
        __syncthreads();
        float bb[8], qv[8], kv[8];
        {
            float run = 0.f;
#pragma unroll
            for (int i = 0; i < 8; ++i) {
                float a[16];
#pragma unroll
                for (int pp = 0; pp < 8; ++pp) { const unsigned ap = (unsigned)__builtin_amdgcn_readlane((int)apre, 8 * i + pp); a[2 * pp] = __uint_as_float(ap << 16); a[2 * pp + 1] = __uint_as_float(ap & 0xffff0000u); }
                float x = F[1984 + k];
#pragma unroll
                for (int rr = 0; rr < 16; ++rr) x += a[rr] * F[960 + rr * 64 + k];
                const float la = (fminf(x, 0.f) - __logf(1.f + __expf(-fabsf(x)))) * (1.f / 16.f);
                run += la; bb[i] = run;
                if (PASS == 3) qv[i] = bf2f(qpre[i]) * 0.125f;
                kv[i] = bf2f(kpre[i]); }
            F[wave * 64 + k] = run;
#pragma unroll
            for (int i = 0; i < 2; ++i) { const int idx = tid + i * 512, row = idx >> 4, ch = idx & 15;
                *(__attribute__((address_space(3))) u4v*)(L + C_VV + row * 272 + ch * 16) = vpre[i]; }
        }
        __syncthreads();
        {   float pre = 0.f;
            for (int g = 0; g < wave; ++g) pre += F[g * 64 + k];
#pragma unroll
            for (int i = 0; i < 8; ++i) bb[i] += pre;
            if (wave == 3) F[512 + k] = bb[7];
            if (wave == 7) { F[576 + k] = bb[7]; if (PASS == 1) CL[(size_t)item * 64 + k] = __expf(bb[7]); }
        }
        __syncthreads();
        {   const float bmid = F[512 + k], blast = F[576 + k];
#pragma unroll
            for (int i = 0; i < 8; ++i) { const int t = 8 * wave + i;
                if (PASS == 3) { const float e1 = __expf(fminf(fmaxf(bb[i] - bmid, -80.f), 80.f)), e2 = __expf(fminf(fmaxf(bmid - bb[i], -80.f), 80.f));
                    ((lds_u16*)(L + C_QT))[t * 72 + k] = f2bf(qv[i] * e1); ((lds_u16*)(L + C_KT))[t * 72 + k] = f2bf(kv[i] * e2);
                    ((lds_u16*)(L + C_QH))[t * 72 + k] = f2bf(qv[i] * __expf(bb[i])); }
                else ((lds_u16*)(L + C_KH))[t * 72 + k] = f2bf(kv[i] * __expf(blast - bb[i])); }
        }
        __syncthreads();
        if (PASS == 1) {
            f32x16 S;
#pragma unroll
            for (int i = 0; i < 16; ++i) S[i] = 0.f;
#pragma unroll
            for (int ks = 0; ks < 4; ++ks) {
                const lds_u8* ap = L + C_KH + (16 * ks + trrow) * 144 + (kt * 32 + trcol) * 2;
                const lds_u8* bp = L + C_VV + (16 * ks + trrow) * 272 + (vt2 * 32 + trcol) * 2;
                const s16x4 al = lds_tr_read(ap), ah = lds_tr_read(ap + 4 * 144), bl = lds_tr_read(bp), bh2 = lds_tr_read(bp + 4 * 272);
                S = __builtin_amdgcn_mfma_f32_32x32x16_bf16(__builtin_shufflevector(al, ah, 0, 1, 2, 3, 4, 5, 6, 7), __builtin_shufflevector(bl, bh2, 0, 1, 2, 3, 4, 5, 6, 7), S, 0, 0, 0);
            }
            bf16* dp = CD + (size_t)item * 8192 + vt2 * 32 + r;
#pragma unroll
            for (int i = 0; i < 16; ++i) dp[(kt * 32 + (i & 3) + 8 * (i >> 2) + 4 * hf) * 128] = f2bf(S[i]);
        } else {
            f32x16 o;
#pragma unroll
            for (int i = 0; i < 16; ++i) o[i] = 0.f;
#pragma unroll
            for (int ks = 0; ks < 4; ++ks) {
                const lds_u8* ap = L + C_SS + (16 * ks + trrow) * 272 + (vt * 32 + trcol) * 2;
                const s16x4 lo = lds_tr_read(ap), hi = lds_tr_read(ap + 4 * 272);
                const s16x8 bq = ldsv8(L + C_QH + (tt * 32 + r) * 144 + (16 * ks + 8 * hf) * 2);
                o = __builtin_amdgcn_mfma_f32_32x32x16_bf16(__builtin_shufflevector(lo, hi, 0, 1, 2, 3, 4, 5, 6, 7), bq, o, 0, 0, 0);
            }
#pragma unroll
            for (int st = 0; st < 2; ++st) {
                if (st > tt) continue;
                f32x16 at;
#pragma unroll
                for (int i = 0; i < 16; ++i) at[i] = 0.f;
#pragma unroll
                for (int kk = 0; kk < 4; ++kk) at = __builtin_amdgcn_mfma_f32_32x32x16_bf16(ldsv8(L + C_KT + (st * 32 + r) * 144 + (kk * 16 + hf * 8) * 2), ldsv8(L + C_QT + (tt * 32 + r) * 144 + (kk * 16 + hf * 8) * 2), at, 0, 0, 0);
                if (st == tt) {
#pragma unroll
                    for (int i = 0; i < 16; ++i) { const int srow = (i & 3) + 8 * (i >> 2) + 4 * hf; if (srow > r) at[i] = 0.f; }
                }
                uint4 pw0, pw1;
                pw0.x = cvt_pk(at[0], at[1]); pw0.y = cvt_pk(at[2], at[3]); pw0.z = cvt_pk(at[4], at[5]); pw0.w = cvt_pk(at[6], at[7]);
                pw1.x = cvt_pk(at[8], at[9]); pw1.y = cvt_pk(at[10], at[11]); pw1.z = cvt_pk(at[12], at[13]); pw1.w = cvt_pk(at[14], at[15]);
                const s16x8 pf0 = __builtin_bit_cast(s16x8, pw0), pf1 = __builtin_bit_cast(s16x8, pw1);
                const lds_u8* vp = L + C_VV + (st * 32 + prow) * 272 + (vt * 32 + trcol) * 2;
                const s16x4 v0l = lds_tr_read(vp), v0h = lds_tr_read(vp + 8 * 272), v1l = lds_tr_read(vp + 16 * 272), v1h = lds_tr_read(vp + 24 * 272);
                o = __builtin_amdgcn_mfma_f32_32x32x16_bf16(__builtin_shufflevector(v0l, v0h, 0, 1, 2, 3, 4, 5, 6, 7), pf0, o, 0, 0, 0);
                o = __builtin_amdgcn_mfma_f32_32x32x16_bf16(__builtin_shufflevector(v1l, v1h, 0, 1, 2, 3, 4, 5, 6, 7), pf1, o, 0, 0, 0);
            }
            float ss = 0.f;
#pragma unroll
            for (int i = 0; i < 16; ++i) ss += o[i] * o[i];
            ss += __shfl_xor(ss, 32);
            if (hf == 0) F[704 + vt * 64 + tt * 32 + r] = ss;
            __syncthreads();
            const int t = tt * 32 + r;
            const float tot = F[704 + t] + F[704 + 64 + t] + F[704 + 128 + t] + F[704 + 192 + t];
            const float rn = rsqrtf(tot * (1.f / 128.f) + 1e-6f);
            const bf16* rrow = zb + (size_t)(t0c + t) * ZC + Z_CR + h * 128 + vt * 32 + 4 * hf;
            bf16* orow = YC + (size_t)(b * SEQ + t0c + t) * 512 + h * 128 + vt * 32 + 4 * hf;
#pragma unroll
            for (int g = 0; g < 4; ++g) {
                const uint2 rw = rpre[g];
                const float r0 = __uint_as_float(rw.x << 16), r1 = __uint_as_float(rw.x & 0xffff0000u), r2 = __uint_as_float(rw.y << 16), r3 = __uint_as_float(rw.y & 0xffff0000u);
                const int vb = 2048 + vt * 32 + 8 * g + 4 * hf;
                const float y0 = o[4 * g] * rn * F[vb] * (r0 / (1.f + __expf(-r0))), y1 = o[4 * g + 1] * rn * F[vb + 1] * (r1 / (1.f + __expf(-r1)));
                const float y2 = o[4 * g + 2] * rn * F[vb + 2] * (r2 / (1.f + __expf(-r2))), y3 = o[4 * g + 3] * rn * F[vb + 3] * (r3 / (1.f + __expf(-r3)));
                uint2 w; w.x = cvt_pk(y0, y1); w.y = cvt_pk(y2, y3); *(uint2*)(orow + 8 * g) = w;
            }
        }
    }
    __syncthreads();
}
__device__ __forceinline__ void ph_C_scan(const Ids& id, const Params& p) {
    const bf16* CD = (const bf16*)(p.ws + WS_CD); bf16* CS = (bf16*)(p.ws + WS_CS); const float* CL = (const float*)(p.ws + WS_CL);
    for (int e = id.bid * NTHR + id.tid; e < 64 * 64 * 32; e += gridDim.x * NTHR) {
        const int v4 = e & 31, k = (e >> 5) & 63, bh = e >> 11;
        float s0 = 0.f, s1 = 0.f, s2 = 0.f, s3 = 0.f;
#pragma unroll 8
        for (int c = 0; c < 32; ++c) {
            const size_t off = (size_t)(bh * 32 + c) * 8192 + k * 128 + v4 * 4;
            const uint2 d = *(const uint2*)(CD + off); const float dl = CL[(size_t)(bh * 32 + c) * 64 + k];
            uint2 o; o.x = cvt_pk(s0, s1); o.y = cvt_pk(s2, s3); *(uint2*)(CS + off) = o;
            s0 = dl * s0 + __uint_as_float(d.x << 16); s1 = dl * s1 + __uint_as_float(d.x & 0xffff0000u); s2 = dl * s2 + __uint_as_float(d.y << 16); s3 = dl * s3 + __uint_as_float(d.y & 0xffff0000u);
        }
    }
}

__device__ __forceinline__ void ph_C(const Ids& id, const Params& p, int layer, float* lds) {
    const bf16* Z = (const bf16*)(p.ws + WS_Z); float* OR = (float*)(p.ws + WS_CRAW);
    float* s_al = lds; float* s_k = lds + 1024; float* s_q = lds + 2048; float* s_wa = lds + 3072; float* s_ba = lds + 4096;
    const float* wal = p.c_w_alpha + layer * 16 * 256; const float* bal = p.c_b_alpha + layer * 256;
    const int tid = id.tid;
    for (int item = id.bid; item < 64; item += gridDim.x) {
        const int b = item >> 2, h = item & 3; const bf16* zb = Z + (size_t)b * SEQ * ZC;
        for (int i = tid; i < 1024; i += NTHR) { const int r = i >> 6, k = i & 63; s_wa[i] = wal[r * 256 + h * 64 + k]; }
        if (tid < 64) s_ba[tid] = bal[h * 64 + tid];
        float S[64];
#pragma unroll
        for (int k = 0; k < 64; ++k) S[k] = 0.f;
        __syncthreads();
        for (int t0 = 0; t0 < SEQ; t0 += 16) {
            for (int i = tid; i < 1024; i += NTHR) { const int st = i >> 6, k = i & 63; const bf16* zr = zb + (size_t)(t0 + st) * ZC;
                float x = s_ba[k];
#pragma unroll
                for (int r = 0; r < 16; ++r) x += bf2f(zr[Z_CA + r]) * s_wa[r * 64 + k];
                s_al[i] = expf(logsig(x) * (1.f / 16.f));
                s_k[i] = bf2f(zr[Z_CK + h * 64 + k]); s_q[i] = bf2f(zr[Z_CQ + h * 64 + k]) * 0.125f; }
            __syncthreads();
            if (tid < 128) {
                for (int st = 0; st < 16; ++st) {
                    const float vv = bf2f(zb[(size_t)(t0 + st) * ZC + Z_CV + h * 128 + tid]);
                    float o = 0.f;
#pragma unroll
                    for (int k = 0; k < 64; ++k) { S[k] = s_al[st * 64 + k] * S[k] + s_k[st * 64 + k] * vv; o += s_q[st * 64 + k] * S[k]; }
                    OR[(size_t)(b * SEQ + t0 + st) * 512 + h * 128 + tid] = o;
                }
            }
            __syncthreads();
        }
    }
}
__device__ __forceinline__ void ph_Cpost(const Ids& id, const Params& p, int layer) {
    const bf16* Z = (const bf16*)(p.ws + WS_Z); const float* OR = (const float*)(p.ws + WS_CRAW); bf16* YC = (bf16*)(p.ws + WS_YC);
    const int lane = id.tid & 63, wave = __builtin_amdgcn_readfirstlane(id.tid >> 6);
    for (int idx = id.bid * 8 + wave; idx < NTOK * 4; idx += gridDim.x * 8) {
        const int tok = idx >> 2, h = idx & 3;
        const float o0 = OR[(size_t)tok * 512 + h * 128 + lane], o1 = OR[(size_t)tok * 512 + h * 128 + 64 + lane];
        const float ss = wave_sum(o0 * o0 + o1 * o1); const float r = rsqrtf(ss * (1.f / 128.f) + 1e-6f);
        const float g0 = p.c_on_g[layer * 512 + h * 128 + lane], g1 = p.c_on_g[layer * 512 + h * 128 + 64 + lane];
        const float r0 = bf2f(Z[(size_t)tok * ZC + Z_CR + h * 128 + lane]), r1 = bf2f(Z[(size_t)tok * ZC + Z_CR + h * 128 + 64 + lane]);
        YC[(size_t)tok * 512 + h * 128 + lane] = f2bf(o0 * r * g0 * (r0 / (1.f + expf(-r0))));
        YC[(size_t)tok * 512 + h * 128 + 64 + lane] = f2bf(o1 * r * g1 * (r1 / (1.f + expf(-r1))));
    }
}

__device__ __forceinline__ void ph_peersel(const Ids& id, const Params& p, int layer, float* lds) {
    const bf16* PQ = (const bf16*)(p.ws + WS_PQ); int* PE = (int*)(p.ws + WS_PE); float* PG = (float*)(p.ws + WS_PG);
    const float* SK = p.peer_subkeys + (size_t)layer * 8 * 2 * 128 * 128;
    float* s_q = lds; float* s_sc = lds + 2048; float* s_ts = lds + 4096; int* s_ti = (int*)(lds + 4352); float* s_bs = lds + 4608; int* s_be = (int*)(lds + 4736);
    const int tid = id.tid;
    for (int tok = id.bid; tok < NTOK; tok += gridDim.x) {
        for (int i = tid; i < 2048; i += NTHR) s_q[i] = bf2f(PQ[(size_t)tok * 2048 + i]);
        __syncthreads();
        for (int idx = tid; idx < 2048; idx += NTHR) { const int list = idx >> 7;
            const float4* kr = (const float4*)(SK + (size_t)idx * 128); const float* q = s_q + list * 128; float dot = 0.f;
            for (int c = 0; c < 32; ++c) { const float4 kv = kr[c]; dot += q[c * 4] * kv.x + q[c * 4 + 1] * kv.y + q[c * 4 + 2] * kv.z + q[c * 4 + 3] * kv.w; }
            s_sc[idx] = dot; }
        __syncthreads();
        for (int idx = tid; idx < 2048; idx += NTHR) { const int list = idx >> 7, i = idx & 127; const float v = s_sc[idx]; int rank = 0;
            for (int j = 0; j < 128; ++j) { const float u = s_sc[list * 128 + j]; rank += (u > v || (u == v && j < i)) ? 1 : 0; }
            if (rank < 16) { s_ts[list * 16 + rank] = v; s_ti[list * 16 + rank] = i; } }
        __syncthreads();
        for (int idx = tid; idx < 2048; idx += NTHR) { const int h = idx >> 8, a = (idx >> 4) & 15, b = idx & 15;
            s_sc[idx] = s_ts[(2 * h) * 16 + a] + s_ts[(2 * h + 1) * 16 + b]; }
        __syncthreads();
        for (int idx = tid; idx < 2048; idx += NTHR) { const int h = idx >> 8, i = idx & 255; const float v = s_sc[idx]; int rank = 0;
            for (int j = 0; j < 256; ++j) { const float u = s_sc[h * 256 + j]; rank += (u > v || (u == v && j < i)) ? 1 : 0; }
            if (rank < 16) { s_bs[h * 16 + rank] = v; s_be[h * 16 + rank] = s_ti[(2 * h) * 16 + (i >> 4)] * 128 + s_ti[(2 * h + 1) * 16 + (i & 15)]; } }
        __syncthreads();
        if (tid < 128) { const int h = tid >> 4; const float m = s_bs[h * 16]; float sum = 0.f;
            for (int k = 0; k < 16; ++k) sum += expf(s_bs[h * 16 + k] - m);
            PG[(size_t)tok * 128 + tid] = expf(s_bs[tid] - m) / sum; PE[(size_t)tok * 128 + tid] = s_be[tid]; }
        __syncthreads();
    }
}
__device__ __forceinline__ void ph_peerexp(const Ids& id, const Params& p, int layer, float* lds) {
    const bf16* N = (const bf16*)(p.ws + WS_N); const int* PE = (const int*)(p.ws + WS_PE); const float* PG = (const float*)(p.ws + WS_PG);
    const float* U = p.peer_u + (size_t)layer * 16384 * 1024; const float* V = p.peer_v + (size_t)layer * 16384 * 1024;
    const float* mod = (const float*)(p.ws + WS_MOD) + (size_t)layer * 16 * 6144;
    float* s_x = lds; float* s_w = lds + 1024; int* s_e = (int*)(lds + 1152);
    const int tid = id.tid, lane = tid & 63, wave = tid >> 6;
    for (int tok = id.bid; tok < NTOK; tok += gridDim.x) {
        const int b = tok >> 11;
        for (int i = tid; i < 1024; i += NTHR) s_x[i] = bf2f(N[(size_t)tok * 1024 + i]);
        if (tid < 128) s_e[tid] = PE[(size_t)tok * 128 + tid];
        __syncthreads();
        for (int i = 0; i < 16; ++i) { const int slot = wave * 16 + i; const int e = s_e[slot];
            const float4* ur = (const float4*)(U + (size_t)e * 1024); float dot = 0.f;
#pragma unroll
            for (int j = 0; j < 4; ++j) { const float4 uv = ur[lane + 64 * j]; const float* xx = s_x + (lane + 64 * j) * 4; dot += xx[0] * uv.x + xx[1] * uv.y + xx[2] * uv.z + xx[3] * uv.w; }
            dot = wave_sum(dot);
            const float act = 0.5f * dot * (1.f + erff(dot * 0.70710678118654752f));
            if (lane == 0) s_w[slot] = PG[(size_t)tok * 128 + slot] * act; }
        __syncthreads();
        { float a0 = 0.f, a1 = 0.f;
          for (int j = 0; j < 128; ++j) { const float2 vv = *(const float2*)(V + (size_t)s_e[j] * 1024 + tid * 2); const float w = s_w[j]; a0 += w * vv.x; a1 += w * vv.y; }
          const float2 g = *(const float2*)(mod + (size_t)b * 6144 + 5 * 1024 + tid * 2);
          float2* o = (float2*)(p.out + (size_t)tok * 1024 + tid * 2); float2 hv = *o; hv.x += g.x * a0; hv.y += g.y * a1; *o = hv; }
        __syncthreads();
    }
}


#define LAS __attribute__((address_space(3)))
#define LDS_WAIT() asm volatile("s_waitcnt lgkmcnt(0)" ::: "memory")
__device__ __forceinline__ unsigned pk2(float lo, float hi) { return (unsigned)f2bf(lo) | ((unsigned)f2bf(hi) << 16); }
template <bool MAP>
__device__ __forceinline__ void transpose_item(const float* W, int ldw, int K, int nblk, bf16* WT, float* scr, int item, int lane) {
    const int kb = item / nblk, nb = item % nblk, k0 = 64 * kb, n0 = 32 * nb;
    const int n = n0 + (lane & 31);
    const int sc = MAP ? (n < 4052 ? inproj_src_col(n) : -1) : n;
#pragma unroll 8
    for (int i = 0; i < 32; ++i) { const int kk = 2 * i + (lane >> 5); scr[kk * 33 + (lane & 31)] = sc >= 0 ? W[(size_t)(k0 + kk) * ldw + sc] : 0.f; }
    LDS_WAIT();
    const int c = lane & 7;
#pragma unroll
    for (int j = 0; j < 4; ++j) { const int nn = (lane >> 3) + 8 * j; const float* sp = scr + (8 * c) * 33 + nn;
        uint4 o; o.x = pk2(sp[0 * 33], sp[1 * 33]); o.y = pk2(sp[2 * 33], sp[3 * 33]); o.z = pk2(sp[4 * 33], sp[5 * 33]); o.w = pk2(sp[6 * 33], sp[7 * 33]);
        *(uint4*)(WT + (size_t)(n0 + nn) * K + k0 + 8 * c) = o; }
    LDS_WAIT();
}
__device__ __forceinline__ void ph_wprep(const Ids& id, const Params& p, int layer, float* lds) {
    const int lane = id.tid & 63, wave = __builtin_amdgcn_readfirstlane(id.tid >> 6);
    float* scr = lds + wave * (64 * 33);
    unsigned char* ws = p.ws;
    {
        const float4* SK = (const float4*)(p.peer_subkeys + (size_t)layer * 262144); uint2* SKB = (uint2*)(p.ws + WS_SKB);
        for (int i = id.bid * NTHR + id.tid; i < 65536; i += gridDim.x * NTHR) { const float4 a = SK[i]; uint2 o; o.x = pk2(a.x, a.y); o.y = pk2(a.z, a.w); SKB[i] = o; }
    }
    constexpr int I_IN = 16 * 128, I_G = 16 * 96, I_O = 8 * 32, I_OUT = 16 * 32, I_PQ = 16 * 64;
    constexpr int NITEMS = I_IN + I_G + 3 * I_O + I_OUT + I_PQ;
    const float* win = p.w_in + (size_t)layer * 1024 * INC;
    for (int it = id.bid * 8 + wave; it < NITEMS; it += gridDim.x * 8) {
        int r = it;
        if (r < I_IN) { transpose_item<true>(win, INC, 1024, 128, (bf16*)(ws + WS_WIN_T), scr, r, lane); continue; } r -= I_IN;
        if (r < I_G) { transpose_item<false>(win + 4052, INC, 1024, 96, (bf16*)(ws + WS_WG_T), scr, r, lane); continue; } r -= I_G;
        if (r < I_O) { transpose_item<false>(p.w_oa + (size_t)layer * 512 * 1024, 1024, 512, 32, (bf16*)(ws + WS_WOA_T), scr, r, lane); continue; } r -= I_O;
        if (r < I_O) { transpose_item<false>(p.w_ob + (size_t)layer * 512 * 1024, 1024, 512, 32, (bf16*)(ws + WS_WOB_T), scr, r, lane); continue; } r -= I_O;
        if (r < I_O) { transpose_item<false>(p.w_oc + (size_t)layer * 512 * 1024, 1024, 512, 32, (bf16*)(ws + WS_WOC_T), scr, r, lane); continue; } r -= I_O;
        if (r < I_OUT) { transpose_item<false>(p.w_out + (size_t)layer * 1024 * 1024, 1024, 1024, 32, (bf16*)(ws + WS_WOUT_T), scr, r, lane); continue; } r -= I_OUT;
        transpose_item<false>(p.peer_wq + (size_t)layer * 1024 * 2048, 2048, 1024, 64, (bf16*)(ws + WS_WPQ_T), scr, r, lane);
    }
}

#ifndef FUSE_QK
#define FUSE_QK 1
#endif
#ifndef FUSE_GATES
#define FUSE_GATES 1
#endif
constexpr int LDG = FUSE_GATES ? 8192 : 3072;
namespace pg8 {
#define PG8_LAS __attribute__((address_space(3)))
typedef unsigned short bf16_t;
typedef short bf16x8 __attribute__((ext_vector_type(8)));
typedef float f32x4 __attribute__((ext_vector_type(4)));
typedef unsigned u32x4 __attribute__((ext_vector_type(4)));
constexpr int BM = 256, BK = 64, HALF = 128, HTB = HALF * BK * 2  , STAGE_BYTES = 8 * HTB, NXCD = 8, WGM = 8;

__host__ __device__ __forceinline__ int lds_byte(int r, int c) { const int st = (r >> 4) * 2 + (c >> 5), rr = r & 15, cc = c & 31, ob = rr * 64 + cc * 2; return st * 1024 + (ob ^ (((ob >> 9) & 1) << 5)); }
__host__ __device__ __forceinline__ void stage_rc(int b, int& R, int& C) { const int st = b / 1024, sb = b % 1024, swz = sb ^ (((sb >> 9) & 1) << 5); R = (st >> 1) * 16 + swz / 64; C = (st & 1) * 32 + (swz % 64) / 2; }
__host__ __device__ __forceinline__ int perm32(int rho) { const int n = rho >> 4, i = rho & 15; return 8 * (i >> 2) + 4 * n + (i & 3); }

struct Unit { int pm, pn; int br; };
struct Gemm { const bf16_t* A; const bf16_t* Bt; int M, N, K; const bf16_t* A1; const bf16_t* Bt1; const bf16_t* A2; const bf16_t* Bt2; };

struct StaticOrder {
    int nM, nN, nwg, G, c;
    __host__ __device__ void init(int M, int N, int G_, int c_) { nM = M / BM; nN = N / BM; nwg = nM * nN; G = G_; c = c_; }
    __host__ __device__ bool next(int i, Unit& u) const {
        const long L = (long)i * G + c; if (L >= nwg) return false;
        int wgid = (int)L; { const int q = nwg / NXCD, r = nwg % NXCD, xcd = wgid % NXCD, off = wgid / NXCD; wgid = (xcd < r ? xcd * (q + 1) : r * (q + 1) + (xcd - r) * q) + off; }
        const int nig = WGM * nN, gid = wgid / nig, fm = gid * WGM, gsz = (nM - fm) < WGM ? (nM - fm) : WGM;
        u.pm = fm + ((wgid % nig) % gsz); u.pn = (wgid % nig) / gsz; return true;
    }
    __device__ __forceinline__ void a_ready(const Unit&) const {}
    __device__ __forceinline__ void done(const Unit&) const {}
};
typedef float f32x2_t __attribute__((ext_vector_type(2))); typedef __bf16 bf16x2_t __attribute__((ext_vector_type(2)));
__device__ __forceinline__ unsigned cvt_pk_bf16(float lo, float hi) { f32x2_t v = {lo, hi}; bf16x2_t b = __builtin_convertvector(v, bf16x2_t); return __builtin_bit_cast(unsigned, b); }

__device__ __forceinline__ float fast_sigmoid(float x) { return __builtin_amdgcn_rcpf(1.0f + __builtin_amdgcn_exp2f(-1.4426950408889634f * x)); }
template <int ACT  > struct EpiBfStore {
    static constexpr bool PERM = true, AFTER_DRAIN = false;
    bf16_t* O; int ldc; const float* bias;
    __device__ __forceinline__ void operator()(const f32x4 (&acc)[2][2][4][2], const Unit& u, int wr, int wc, int fr, int fq) const {
        const int row0 = u.pm * BM + wr * 64 + fr, col0 = u.pn * BM + wc * 32 + 8 * fq;
        f32x4 bv[2][2];
#pragma unroll
        for (int bj = 0; bj < 2; ++bj)
#pragma unroll
            for (int n = 0; n < 2; ++n) bv[bj][n] = ACT ? *(const f32x4*)(bias + col0 + bj * HALF + 4 * n) : (f32x4){0.f, 0.f, 0.f, 0.f};
#pragma unroll
        for (int ai = 0; ai < 2; ++ai)
#pragma unroll
            for (int m = 0; m < 4; ++m) { bf16_t* rowp = O + (size_t)(row0 + ai * HALF + m * 16) * ldc + col0;
#pragma unroll
                for (int bj = 0; bj < 2; ++bj) { f32x4 v0 = acc[ai][bj][m][0] + bv[bj][0], v1 = acc[ai][bj][m][1] + bv[bj][1];
                    if (ACT == 1) {
#pragma unroll
                        for (int j = 0; j < 4; ++j) { v0[j] = fast_sigmoid(v0[j]); v1[j] = fast_sigmoid(v1[j]); } }
                    u32x4 w; w.x = cvt_pk_bf16(v0[0], v0[1]); w.y = cvt_pk_bf16(v0[2], v0[3]); w.z = cvt_pk_bf16(v1[0], v1[1]); w.w = cvt_pk_bf16(v1[2], v1[3]);
                    *(u32x4*)(rowp + bj * HALF) = w; } }
    }
};
__device__ __forceinline__ int qk_head_type(int c0) { return c0 < 512 ? 1 : (c0 == 512 ? 2 : ((c0 >= 960 && c0 < 1472) ? 3 : ((c0 >= 1472 && c0 < 1984) ? 4 : 0))); }
struct EpiInQK {
    static constexpr bool PERM = true, AFTER_DRAIN = false;
    bf16_t* O; int ldc; const float* gtab; PG8_LAS float* P;
    __device__ __forceinline__ void operator()(const f32x4 (&acc)[2][2][4][2], const Unit& u, int wr, int wc, int fr, int fq) const {
        const int row0 = u.pm * BM + wr * 64 + fr, col0 = u.pn * BM + wc * 32 + 8 * fq;
        const int wave = wr * 4 + wc;
        const bool normed = u.pn < 8;
        if (normed) {
#pragma unroll
            for (int bj = 0; bj < 2; ++bj)
#pragma unroll
                for (int ai = 0; ai < 2; ++ai)
#pragma unroll
                    for (int m = 0; m < 4; ++m) { const f32x4 a = acc[ai][bj][m][0], b = acc[ai][bj][m][1];
                        float s = (a[0] * a[0] + a[1] * a[1]) + (a[2] * a[2] + a[3] * a[3]) + (b[0] * b[0] + b[1] * b[1]) + (b[2] * b[2] + b[3] * b[3]);
                        { const auto r16 = __builtin_amdgcn_permlane16_swap(__float_as_uint(s), __float_as_uint(s), false, false); s = __uint_as_float(r16[0]) + __uint_as_float(r16[1]);
                          const auto r32 = __builtin_amdgcn_permlane32_swap(__float_as_uint(s), __float_as_uint(s), false, false); s = __uint_as_float(r32[0]) + __uint_as_float(r32[1]); }
                        if (fq == 0) P[wave * 256 + bj * 128 + ai * 64 + m * 16 + fr] = s; __builtin_amdgcn_sched_barrier(0); }
            asm volatile("s_waitcnt lgkmcnt(0)\n\ts_barrier" ::: "memory");
        }
#pragma unroll
        for (int bj = 0; bj < 2; ++bj) {
            const int ty = normed ? qk_head_type(u.pn * BM + bj * HALF + (wc >> 1) * 64) : 0;
            const float* gp = gtab + (ty ? ty - 1 : 0) * 64;
            f32x4 g0 = {1.f, 1.f, 1.f, 1.f}, g1 = {1.f, 1.f, 1.f, 1.f};
            if (ty) { g0 = *(const f32x4*)(gp + (wc & 1) * 32 + 8 * fq); g1 = *(const f32x4*)(gp + (wc & 1) * 32 + 8 * fq + 4); }
#pragma unroll
            for (int ai = 0; ai < 2; ++ai)
#pragma unroll
                for (int m = 0; m < 4; ++m) { bf16_t* rowp = O + (size_t)(row0 + ai * HALF + m * 16) * ldc + col0 + bj * HALF;
                    float rsv = 1.f;
                    if (ty) { const int pi = bj * 128 + ai * 64 + m * 16 + fr; rsv = __builtin_amdgcn_rsqf((P[wave * 256 + pi] + P[(wave ^ 1) * 256 + pi]) * (1.f / 64.f) + 1e-6f); }
                    const f32x4 v0 = acc[ai][bj][m][0] * g0 * rsv, v1 = acc[ai][bj][m][1] * g1 * rsv;
                    u32x4 w; w.x = cvt_pk_bf16(v0[0], v0[1]); w.y = cvt_pk_bf16(v0[2], v0[3]); w.z = cvt_pk_bf16(v1[0], v1[1]); w.w = cvt_pk_bf16(v1[2], v1[3]);
                    *(u32x4*)rowp = w; __builtin_amdgcn_sched_barrier(0); } }
    }
};
struct EpiGate8 {
    static constexpr bool PERM = true, AFTER_DRAIN = false;
    unsigned char* O; int ldc; const float* bias;
    __device__ __forceinline__ void operator()(const f32x4 (&acc)[2][2][4][2], const Unit& u, int wr, int wc, int fr, int fq) const {
        const int row0 = u.pm * BM + wr * 64 + fr, col0 = u.pn * BM + wc * 32 + 8 * fq;
        f32x4 bv[2][2];
#pragma unroll
        for (int bj = 0; bj < 2; ++bj)
#pragma unroll
            for (int n = 0; n < 2; ++n) bv[bj][n] = *(const f32x4*)(bias + col0 + bj * HALF + 4 * n);
        const int odd = fq & 1;
#pragma unroll
        for (int ai = 0; ai < 2; ++ai)
#pragma unroll
            for (int m = 0; m < 4; ++m) { unsigned char* rowp = O + (size_t)(row0 + ai * HALF + m * 16) * ldc + col0;
                unsigned wlo[2], whi[2];
#pragma unroll
                for (int bj = 0; bj < 2; ++bj) { f32x4 v0 = acc[ai][bj][m][0] + bv[bj][0], v1 = acc[ai][bj][m][1] + bv[bj][1];
#pragma unroll
                    for (int j = 0; j < 4; ++j) { v0[j] = fmaxf(fast_sigmoid(v0[j]), 0.001953125f); v1[j] = fmaxf(fast_sigmoid(v1[j]), 0.001953125f); }
                    int w0 = 0, w1 = 0;
                    w0 = __builtin_amdgcn_cvt_pk_fp8_f32(v0[0], v0[1], w0, false); w0 = __builtin_amdgcn_cvt_pk_fp8_f32(v0[2], v0[3], w0, true);
                    w1 = __builtin_amdgcn_cvt_pk_fp8_f32(v1[0], v1[1], w1, false); w1 = __builtin_amdgcn_cvt_pk_fp8_f32(v1[2], v1[3], w1, true);
                    wlo[bj] = (unsigned)w0; whi[bj] = (unsigned)w1; }
                const auto s0 = __builtin_amdgcn_permlane16_swap(wlo[0], wlo[1], false, false);
                const auto s1 = __builtin_amdgcn_permlane16_swap(whi[0], whi[1], false, false);
                u32x4 w; w.x = s0[0]; w.y = s1[0]; w.z = s0[1]; w.w = s1[1];
                *(u32x4*)(rowp + (odd ? HALF - 8 : 0)) = w; }
    }
};
template <int MODE> struct EpiProj {
    static constexpr bool PERM = true, AFTER_DRAIN = false;
    const unsigned char* G; int ldg; bf16_t* Mb; bf16_t* MG;
    __device__ __forceinline__ void operator()(const f32x4 (&acc)[2][2][4][2], const Unit& u, int wr, int wc, int fr, int fq) const {
        const int row0 = u.pm * BM + wr * 64 + fr, col0 = u.pn * BM + wc * 32 + 8 * fq;
#pragma unroll
        for (int ai = 0; ai < 2; ++ai)
#pragma unroll
            for (int m = 0; m < 4; ++m) { const size_t r = (size_t)(row0 + ai * HALF + m * 16);
#pragma unroll
                for (int bj = 0; bj < 2; ++bj) { const int c = col0 + bj * HALF;
                    const uint2 gw = *(const uint2*)(G + r * ldg + c);
                    typedef float f2g __attribute__((ext_vector_type(2)));
                    const f2g ga = __builtin_amdgcn_cvt_pk_f32_fp8((int)gw.x, false), gb = __builtin_amdgcn_cvt_pk_f32_fp8((int)gw.x, true), gc = __builtin_amdgcn_cvt_pk_f32_fp8((int)gw.y, false), gd = __builtin_amdgcn_cvt_pk_f32_fp8((int)gw.y, true);
                    const f32x4 g0 = {ga[0], ga[1], gb[0], gb[1]}, g1 = {gc[0], gc[1], gd[0], gd[1]};
                    f32x4 v0 = acc[ai][bj][m][0] * g0, v1 = acc[ai][bj][m][1] * g1;
                    bf16_t* mp = Mb + r * 1024 + c;
                    if (MODE >= 1) { const u32x4 mw = *(const u32x4*)mp;
                        v0[0] += __uint_as_float(mw.x << 16); v0[1] += __uint_as_float(mw.x & 0xffff0000u); v0[2] += __uint_as_float(mw.y << 16); v0[3] += __uint_as_float(mw.y & 0xffff0000u);
                        v1[0] += __uint_as_float(mw.z << 16); v1[1] += __uint_as_float(mw.z & 0xffff0000u); v1[2] += __uint_as_float(mw.w << 16); v1[3] += __uint_as_float(mw.w & 0xffff0000u); }
                    u32x4 w; w.x = cvt_pk_bf16(v0[0], v0[1]); w.y = cvt_pk_bf16(v0[2], v0[3]); w.z = cvt_pk_bf16(v1[0], v1[1]); w.w = cvt_pk_bf16(v1[2], v1[3]);
                    if (MODE <= 1) *(u32x4*)mp = w; else *(u32x4*)(MG + r * 1024 + c) = w; } }
    }
};
struct ChainOrder { StaticOrder S;
    __device__ bool next(int i, Unit& u) const { const int t = i / 3; if (!S.next(t, u)) return false; u.br = i - 3 * t; return true; }
    __device__ __forceinline__ void a_ready(const Unit&) const {}
    __device__ __forceinline__ void done(const Unit&) const {}
};
struct EpiChain {
    static constexpr bool PERM = true, AFTER_DRAIN = false;
    const unsigned char* G; bf16_t* MG;
    __device__ __forceinline__ void operator()(const f32x4 (&)[2][2][4][2], const Unit&, int, int, int, int) const {}
    __device__ __forceinline__ void chain(f32x4 (&acc)[2][2][4][2], const Unit& u, int wr, int wc, int fr, int fq) const {
        typedef float f2g __attribute__((ext_vector_type(2)));
        const int row0 = u.pm * BM + wr * 64 + fr, col0 = u.pn * BM + wc * 32 + 8 * fq, br = u.br;
#pragma unroll
        for (int ai = 0; ai < 2; ++ai)
#pragma unroll
            for (int m = 0; m < 4; ++m) { const size_t r = (size_t)(row0 + ai * HALF + m * 16);
#pragma unroll
                for (int bj = 0; bj < 2; ++bj) { const int c = col0 + bj * HALF;
                    const uint2 ga = *(const uint2*)(G + r * LDG + br * 1024 + c);
                    const f2g a0 = __builtin_amdgcn_cvt_pk_f32_fp8((int)ga.x, false), a1 = __builtin_amdgcn_cvt_pk_f32_fp8((int)ga.x, true), a2 = __builtin_amdgcn_cvt_pk_f32_fp8((int)ga.y, false), a3 = __builtin_amdgcn_cvt_pk_f32_fp8((int)ga.y, true);
                    f32x4 s0 = {a0[0], a0[1], a1[0], a1[1]}, s1 = {a2[0], a2[1], a3[0], a3[1]};
                    if (br < 2) { const uint2 gb = *(const uint2*)(G + r * LDG + (br + 1) * 1024 + c);
                        const f2g b0 = __builtin_amdgcn_cvt_pk_f32_fp8((int)gb.x, false), b1 = __builtin_amdgcn_cvt_pk_f32_fp8((int)gb.x, true), b2 = __builtin_amdgcn_cvt_pk_f32_fp8((int)gb.y, false), b3 = __builtin_amdgcn_cvt_pk_f32_fp8((int)gb.y, true);
                        s0[0] *= __builtin_amdgcn_rcpf(b0[0]); s0[1] *= __builtin_amdgcn_rcpf(b0[1]); s0[2] *= __builtin_amdgcn_rcpf(b1[0]); s0[3] *= __builtin_amdgcn_rcpf(b1[1]);
                        s1[0] *= __builtin_amdgcn_rcpf(b2[0]); s1[1] *= __builtin_amdgcn_rcpf(b2[1]); s1[2] *= __builtin_amdgcn_rcpf(b3[0]); s1[3] *= __builtin_amdgcn_rcpf(b3[1]);
                        acc[ai][bj][m][0] *= s0; acc[ai][bj][m][1] *= s1; }
                    else { const f32x4 v0 = acc[ai][bj][m][0] * s0, v1 = acc[ai][bj][m][1] * s1;
                        u32x4 w; w.x = cvt_pk_bf16(v0[0], v0[1]); w.y = cvt_pk_bf16(v0[2], v0[3]); w.z = cvt_pk_bf16(v1[0], v1[1]); w.w = cvt_pk_bf16(v1[2], v1[3]);
                        *(u32x4*)(MG + r * 1024 + c) = w; } } }
    }
};
template <bool HIN_BF16> struct EpiResid {
    static constexpr bool PERM = true, AFTER_DRAIN = false;
    const void* hin; bf16_t* hm; const float* gate;
    __device__ __forceinline__ void operator()(const f32x4 (&acc)[2][2][4][2], const Unit& u, int wr, int wc, int fr, int fq) const {
        const int row0 = u.pm * BM + wr * 64 + fr, col0 = u.pn * BM + wc * 32 + 8 * fq;
        const float* gp = gate + (size_t)(u.pm >> 3) * 6144 + col0;
        f32x4 gv[2][2];
#pragma unroll
        for (int bj = 0; bj < 2; ++bj)
#pragma unroll
            for (int n = 0; n < 2; ++n) gv[bj][n] = *(const f32x4*)(gp + bj * HALF + 4 * n);
#pragma unroll
        for (int ai = 0; ai < 2; ++ai)
#pragma unroll
            for (int m = 0; m < 4; ++m) { const size_t r = (size_t)(row0 + ai * HALF + m * 16);
#pragma unroll
                for (int bj = 0; bj < 2; ++bj) { const size_t o = r * 1024 + col0 + bj * HALF;
                    f32x4 h0, h1;
                    if constexpr (HIN_BF16) { const u32x4 hb = *(const u32x4*)((const bf16_t*)hin + o);
                        h0 = (f32x4){__uint_as_float(hb.x << 16), __uint_as_float(hb.x & 0xffff0000u), __uint_as_float(hb.y << 16), __uint_as_float(hb.y & 0xffff0000u)};
                        h1 = (f32x4){__uint_as_float(hb.z << 16), __uint_as_float(hb.z & 0xffff0000u), __uint_as_float(hb.w << 16), __uint_as_float(hb.w & 0xffff0000u)}; }
                    else { h0 = *(const f32x4*)((const float*)hin + o); h1 = *(const f32x4*)((const float*)hin + o + 4); }
                    const f32x4 v0 = h0 + gv[bj][0] * acc[ai][bj][m][0], v1 = h1 + gv[bj][1] * acc[ai][bj][m][1];
                    u32x4 w; w.x = cvt_pk_bf16(v0[0], v0[1]); w.y = cvt_pk_bf16(v0[2], v0[3]); w.z = cvt_pk_bf16(v1[0], v1[1]); w.w = cvt_pk_bf16(v1[2], v1[3]);
                    *(u32x4*)(hm + o) = w; } }
    }
};


template <class Epi, class Sched, bool ALIGN_EPI = false, bool SP2 = false, bool CHAIN = false>
__device__ __forceinline__ void gemm_phase(PG8_LAS unsigned char* lds, const Gemm g, const Sched& S, const Epi& E, const int tid) {
    const int wid = __builtin_amdgcn_readfirstlane(tid >> 6), lane = tid & 63, wr = wid >> 2, wc = wid & 3, fr = lane & 15, fq = lane >> 4;
    const int K = g.K, nt = K / BK;
    unsigned voffA[2], voffB[2];
#pragma unroll
    for (int i = 0; i < 2; ++i) { int R, C; stage_rc(tid * 16 + i * 8192, R, C); const int Rb = Epi::PERM ? ((R & ~31) + perm32(R & 31)) : R;
        voffA[i] = (unsigned)(R * K + C) * 2u; voffB[i] = (unsigned)(Rb * K + C) * 2u; }
    const size_t kstep = (size_t)(BK * 2);
    const size_t hstep = (size_t)HALF * K * 2;
    const size_t tstep = 2 * hstep;
    const unsigned ldsw = (unsigned)wid * 1024u;
    const int aoff = lds_byte(wr * 64 + fr, fq * 8), boff = lds_byte(wc * 32 + fr, fq * 8);
#define PG8_SA(b, h) (((b) * 2 + (h)) * HTB)
#define PG8_SB(b, h) ((4 + (b) * 2 + (h)) * HTB)
#define PG8_STAGE(bufoff, gbase, voff) do { _Pragma("unroll") for (int _i = 0; _i < 2; ++_i) \
        __builtin_amdgcn_global_load_lds((const unsigned*)((const char*)(gbase) + (voff)[_i]), (PG8_LAS unsigned*)(lds + (bufoff) + ldsw + _i * 8192), 16, 0, 0); } while (0)
#define PG8_LDA(dst, b, h) do { _Pragma("unroll") for (int m = 0; m < 4; ++m) _Pragma("unroll") for (int k = 0; k < 2; ++k) dst[m][k] = *(const PG8_LAS bf16x8*)(lds + PG8_SA(b, h) + aoff + m * 2048 + k * 1024); } while (0)
#define PG8_LDB(dst, b, h) do { _Pragma("unroll") for (int n = 0; n < 2; ++n) _Pragma("unroll") for (int k = 0; k < 2; ++k) dst[n][k] = *(const PG8_LAS bf16x8*)(lds + PG8_SB(b, h) + boff + n * 2048 + k * 1024); } while (0)
#define PG8_MMA(ai, bj, At, Bt) do { __builtin_amdgcn_s_setprio(1); _Pragma("unroll") for (int m = 0; m < 4; ++m) _Pragma("unroll") for (int n = 0; n < 2; ++n) _Pragma("unroll") for (int k = 0; k < 2; ++k) \
        acc[ai][bj][m][n] = __builtin_amdgcn_mfma_f32_16x16x32_bf16(Bt[n][k], At[m][k], acc[ai][bj][m][n], 0, 0, 0); __builtin_amdgcn_s_setprio(0); } while (0)
#define PG8_WAIT_V(n) asm volatile("s_waitcnt vmcnt(" #n ")" ::: "memory")
#define PG8_WAIT_L(n) asm volatile("s_waitcnt lgkmcnt(" #n ")" ::: "memory")
#define PG8_BAR __builtin_amdgcn_s_barrier()
#define PG8_SCHED __builtin_amdgcn_sched_barrier(0)
    Unit cur, nxt; int ui = 0;
    if (!S.next(0, cur)) return;
    f32x4 acc[2][2][4][2];
#pragma unroll
    for (int a = 0; a < 2; ++a)
#pragma unroll
        for (int b = 0; b < 2; ++b)
#pragma unroll
            for (int m = 0; m < 4; ++m)
#pragma unroll
                for (int n = 0; n < 2; ++n) acc[a][b][m][n] = (f32x4){0.f, 0.f, 0.f, 0.f};
    bf16x8 At[4][2], B0[2][2], B1[2][2];
#define PG8_SELA(u_) (!CHAIN || (u_).br == 0 ? g.A : ((u_).br == 1 ? g.A1 : g.A2))
#define PG8_SELB(u_) (!CHAIN || (u_).br == 0 ? g.Bt : ((u_).br == 1 ? g.Bt1 : g.Bt2))
    const char* cA = (const char*)PG8_SELA(cur) + (size_t)cur.pm * tstep; const char* cB = (const char*)PG8_SELB(cur) + (size_t)cur.pn * tstep;
    S.a_ready(cur);
    if constexpr (SP2) {
        PG8_STAGE(PG8_SB(0, 0), cB, voffB); PG8_STAGE(PG8_SB(0, 1), cB + hstep, voffB); PG8_STAGE(PG8_SA(0, 0), cA, voffA); PG8_STAGE(PG8_SA(0, 1), cA + hstep, voffA);
        if (wr == 1) PG8_BAR;
        PG8_WAIT_V(2); PG8_BAR;
        PG8_STAGE(PG8_SB(1, 0), cB + kstep, voffB); PG8_STAGE(PG8_SA(1, 0), cA + kstep, voffA); PG8_STAGE(PG8_SB(1, 1), cB + hstep + kstep, voffB);
        PG8_WAIT_V(6); PG8_BAR;
    } else {
        PG8_STAGE(PG8_SB(0, 0), cB, voffB); PG8_STAGE(PG8_SA(0, 0), cA, voffA); PG8_STAGE(PG8_SB(0, 1), cB + hstep, voffB); PG8_STAGE(PG8_SA(0, 1), cA + hstep, voffA);
        if (wr == 1) PG8_BAR;
        PG8_WAIT_V(4); PG8_BAR;
        PG8_STAGE(PG8_SB(1, 0), cB + kstep, voffB); PG8_STAGE(PG8_SA(1, 0), cA + kstep, voffA); PG8_STAGE(PG8_SB(1, 1), cB + hstep + kstep, voffB);
        PG8_WAIT_V(6); PG8_BAR;
    }
    for (;;) {
        const bool has_next = S.next(ui + 1, nxt);
        const char* nA = has_next ? (const char*)PG8_SELA(nxt) + (size_t)nxt.pm * tstep : cA; const char* nB = has_next ? (const char*)PG8_SELB(nxt) + (size_t)nxt.pn * tstep : cB;
        for (int t = 0; t < nt; t += 2) {
            const bool last = (t == nt - 2);
            const char* a1 = cA + (size_t)(t + 1) * kstep;
            const char* a2 = last ? nA : cA + (size_t)(t + 2) * kstep; const char* b2 = last ? nB : cB + (size_t)(t + 2) * kstep;
            const char* a3 = a2 + kstep; const char* b3 = b2 + kstep;
            if (last && has_next) S.a_ready(nxt);
            if constexpr (SP2) {
            PG8_LDB(B0, 0, 0); PG8_LDB(B1, 0, 1); PG8_SCHED; PG8_LDA(At, 0, 0); PG8_STAGE(PG8_SA(1, 1), a1 + hstep, voffA);
            PG8_WAIT_V(8); PG8_WAIT_L(0); PG8_BAR; PG8_MMA(0, 0, At, B0); PG8_MMA(0, 1, At, B1); PG8_BAR; PG8_SCHED;
            PG8_LDA(At, 0, 1); PG8_STAGE(PG8_SB(0, 0), b2, voffB); PG8_STAGE(PG8_SB(0, 1), b2 + hstep, voffB); PG8_STAGE(PG8_SA(0, 0), a2, voffA);
            PG8_WAIT_V(8); PG8_WAIT_L(0); PG8_BAR; PG8_MMA(1, 0, At, B0); PG8_MMA(1, 1, At, B1); PG8_BAR; PG8_SCHED;
            PG8_LDB(B0, 1, 0); PG8_LDB(B1, 1, 1); PG8_SCHED; PG8_LDA(At, 1, 0); PG8_STAGE(PG8_SA(0, 1), a2 + hstep, voffA);
            PG8_WAIT_V(8); PG8_WAIT_L(0); PG8_BAR; PG8_MMA(0, 0, At, B0); PG8_MMA(0, 1, At, B1); PG8_BAR; PG8_SCHED;
            PG8_LDA(At, 1, 1); PG8_STAGE(PG8_SB(1, 0), b3, voffB); PG8_STAGE(PG8_SB(1, 1), b3 + hstep, voffB); PG8_STAGE(PG8_SA(1, 0), a3, voffA);
            PG8_WAIT_V(8); PG8_WAIT_L(0); PG8_BAR; PG8_MMA(1, 0, At, B0); PG8_MMA(1, 1, At, B1); PG8_BAR; PG8_SCHED;
            } else {
            PG8_LDB(B0, 0, 0); PG8_SCHED; PG8_LDA(At, 0, 0); PG8_STAGE(PG8_SA(1, 1), a1 + hstep, voffA);
            PG8_WAIT_L(8); PG8_BAR; PG8_WAIT_L(0); PG8_MMA(0, 0, At, B0); PG8_BAR; PG8_SCHED;
            PG8_LDB(B1, 0, 1); PG8_STAGE(PG8_SB(0, 0), b2, voffB);
            PG8_BAR; PG8_WAIT_L(0); PG8_MMA(0, 1, At, B1); PG8_BAR;
            PG8_LDA(At, 0, 1); PG8_STAGE(PG8_SA(0, 0), a2, voffA);
            PG8_BAR; PG8_WAIT_L(0); PG8_MMA(1, 0, At, B0); PG8_BAR; PG8_SCHED;
            PG8_STAGE(PG8_SB(0, 1), b2 + hstep, voffB);
            PG8_WAIT_V(6); PG8_BAR; PG8_MMA(1, 1, At, B1); PG8_BAR;
            PG8_LDB(B0, 1, 0); PG8_SCHED; PG8_LDA(At, 1, 0); PG8_STAGE(PG8_SA(0, 1), a2 + hstep, voffA);
            PG8_WAIT_L(8); PG8_BAR; PG8_WAIT_L(0); PG8_MMA(0, 0, At, B0); PG8_BAR; PG8_SCHED;
            PG8_LDB(B1, 1, 1); PG8_STAGE(PG8_SB(1, 0), b3, voffB);
            PG8_BAR; PG8_WAIT_L(0); PG8_MMA(0, 1, At, B1); PG8_BAR;
            PG8_LDA(At, 1, 1); PG8_STAGE(PG8_SA(1, 0), a3, voffA);
            PG8_BAR; PG8_WAIT_L(0); PG8_MMA(1, 0, At, B0); PG8_BAR; PG8_SCHED;
            PG8_STAGE(PG8_SB(1, 1), b3 + hstep, voffB);
            PG8_WAIT_V(6); PG8_BAR; PG8_MMA(1, 1, At, B1); PG8_BAR;
            }
        }
        if constexpr (ALIGN_EPI) { if (wr == 0) PG8_BAR; }
        if constexpr (CHAIN) { E.chain(acc, cur, wr, wc, fr, fq); } else
        if constexpr (!Epi::AFTER_DRAIN) { E(acc, cur, wr, wc, fr, fq); S.done(cur); }
        if (!has_next) break;
        if (!CHAIN || cur.br == 2)
#pragma unroll
        for (int a = 0; a < 2; ++a)
#pragma unroll
            for (int b = 0; b < 2; ++b)
#pragma unroll
                for (int m = 0; m < 4; ++m)
#pragma unroll
                    for (int n = 0; n < 2; ++n) acc[a][b][m][n] = (f32x4){0.f, 0.f, 0.f, 0.f};
        cur = nxt; cA = nA; cB = nB; ++ui;
        if constexpr (ALIGN_EPI) { if (wr == 1) PG8_BAR; }
    }
    PG8_WAIT_V(0);
    if constexpr (!ALIGN_EPI) { if (wr == 0) PG8_BAR; }
    PG8_BAR;
    if constexpr (Epi::AFTER_DRAIN) { E.fused(acc, cur, wr, wc, fr, fq, lds, wid, lane); S.done(cur); }
#undef PG8_SELA
#undef PG8_SELB
#undef PG8_SA
#undef PG8_SB
#undef PG8_STAGE
#undef PG8_LDA
#undef PG8_LDB
#undef PG8_MMA
#undef PG8_WAIT_V
#undef PG8_WAIT_L
#undef PG8_BAR
#undef PG8_SCHED
}
}


constexpr size_t WS_UB = WS_Z + 160 * MiB;
constexpr size_t WS_VB = WS_Z + 192 * MiB;
__device__ __forceinline__ void ph_uvprep(const Ids& id, const Params& p, int layer) {
    const float4* U = (const float4*)(p.peer_u + (size_t)layer * 16384 * 1024); const float4* V = (const float4*)(p.peer_v + (size_t)layer * 16384 * 1024);
    uint2* UB = (uint2*)(p.ws + WS_UB); uint2* VB = (uint2*)(p.ws + WS_VB);
    const size_t n4 = (size_t)16384 * 1024 / 4;
    for (size_t i = (size_t)id.bid * NTHR + id.tid; i < n4; i += (size_t)gridDim.x * NTHR) {
        const float4 a = U[i], b = V[i];
        uint2 oa, ob; oa.x = cvt_pk(a.x, a.y); oa.y = cvt_pk(a.z, a.w); ob.x = cvt_pk(b.x, b.y); ob.y = cvt_pk(b.z, b.w);
        UB[i] = oa; VB[i] = ob;
    }
}
__device__ __forceinline__ float wave_sum_dpp(float v) {
#pragma unroll
    for (int o = 32; o >= 1; o >>= 1) v += __shfl_xor(v, o);
    return v;
}
__device__ __forceinline__ void ph_peerexp2(const Ids& id, const Params& p, int layer) {
    const bf16* N = (const bf16*)(p.ws + WS_N); const int* PE = (const int*)(p.ws + WS_PE); const float* PG = (const float*)(p.ws + WS_PG);
    const bf16* UB = (const bf16*)(p.ws + WS_UB); const bf16* VB = (const bf16*)(p.ws + WS_VB);
    const float* mod = (const float*)(p.ws + WS_MOD) + (size_t)layer * 16 * 6144;
    const int lane = id.tid & 63, wave = __builtin_amdgcn_readfirstlane(id.tid >> 6);
    for (int tok = id.bid * 8 + wave; tok < NTOK; tok += gridDim.x * 8) {
        const int b = tok >> 11;
        float x[16];
        { const uint4 x0 = *(const uint4*)(N + (size_t)tok * 1024 + lane * 8), x1 = *(const uint4*)(N + (size_t)tok * 1024 + 512 + lane * 8); unpack8(x0, x); unpack8(x1, x + 8); }
        const int e0 = PE[(size_t)tok * 128 + lane], e1 = PE[(size_t)tok * 128 + 64 + lane];
        const float g0 = PG[(size_t)tok * 128 + lane], g1 = PG[(size_t)tok * 128 + 64 + lane];
        float d0 = 0.f, d1 = 0.f;
#pragma unroll 4
        for (int j = 0; j < 64; ++j) {
            const int ea = __shfl(e0, j), eb = __shfl(e1, j);
            const bf16* ua = UB + (size_t)ea * 1024 + lane * 8; const bf16* ub = UB + (size_t)eb * 1024 + lane * 8;
            const uint4 a0 = *(const uint4*)ua, a1 = *(const uint4*)(ua + 512), b0 = *(const uint4*)ub, b1 = *(const uint4*)(ub + 512);
            float f[8]; float sa = 0.f, sb = 0.f;
            unpack8(a0, f);
#pragma unroll
            for (int i = 0; i < 8; ++i) sa += x[i] * f[i];
            unpack8(a1, f);
#pragma unroll
            for (int i = 0; i < 8; ++i) sa += x[8 + i] * f[i];
            unpack8(b0, f);
#pragma unroll
            for (int i = 0; i < 8; ++i) sb += x[i] * f[i];
            unpack8(b1, f);
#pragma unroll
            for (int i = 0; i < 8; ++i) sb += x[8 + i] * f[i];
            sa = wave_sum_dpp(sa); sb = wave_sum_dpp(sb);
            if (lane == j) { d0 = sa; d1 = sb; }
        }
        const float w0 = g0 * (0.5f * d0 * (1.f + erff(d0 * 0.70710678118654752f))), w1 = g1 * (0.5f * d1 * (1.f + erff(d1 * 0.70710678118654752f)));
        float acc[16];
#pragma unroll
        for (int i = 0; i < 16; ++i) acc[i] = 0.f;
#pragma unroll 4
        for (int j = 0; j < 64; ++j) {
            const int ea = __shfl(e0, j), eb = __shfl(e1, j); const float wa = __shfl(w0, j), wb = __shfl(w1, j);
            const bf16* va = VB + (size_t)ea * 1024 + lane * 8; const bf16* vb = VB + (size_t)eb * 1024 + lane * 8;
            const uint4 a0 = *(const uint4*)va, a1 = *(const uint4*)(va + 512), b0 = *(const uint4*)vb, b1 = *(const uint4*)(vb + 512);
            float f[8];
            unpack8(a0, f);
#pragma unroll
            for (int i = 0; i < 8; ++i) acc[i] += wa * f[i];
            unpack8(a1, f);
#pragma unroll
            for (int i = 0; i < 8; ++i) acc[8 + i] += wa * f[i];
            unpack8(b0, f);
#pragma unroll
            for (int i = 0; i < 8; ++i) acc[i] += wb * f[i];
            unpack8(b1, f);
#pragma unroll
            for (int i = 0; i < 8; ++i) acc[8 + i] += wb * f[i];
        }
        const float* gp = mod + (size_t)b * 6144 + 5 * 1024;
        float* op = p.out + (size_t)tok * 1024;
#pragma unroll
        for (int hh = 0; hh < 2; ++hh)
#pragma unroll
            for (int q = 0; q < 2; ++q) { const int c = hh * 512 + lane * 8 + q * 4;
                const float4 g = *(const float4*)(gp + c); float4 o = *(const float4*)(op + c);
                o.x += g.x * acc[hh * 8 + q * 4 + 0]; o.y += g.y * acc[hh * 8 + q * 4 + 1]; o.z += g.z * acc[hh * 8 + q * 4 + 2]; o.w += g.w * acc[hh * 8 + q * 4 + 3];
                *(float4*)(op + c) = o; }
    }
}


__device__ __forceinline__ unsigned f2key(float x) { const unsigned b = __float_as_uint(x); return (b & 0x80000000u) ? ~b : (b | 0x80000000u); }
__device__ __forceinline__ float key2f(unsigned k) { return __uint_as_float((k & 0x80000000u) ? (k & 0x7fffffffu) : ~k); }
__device__ __forceinline__ void sort16_desc(unsigned (&v)[16]) {
#pragma unroll
    for (int k = 2; k <= 16; k <<= 1)
#pragma unroll
        for (int j = k >> 1; j > 0; j >>= 1)
#pragma unroll
            for (int i = 0; i < 16; ++i) { const int l = i ^ j;
                if (l > i) { const bool desc = (i & k) == 0; const unsigned mx = max(v[i], v[l]), mn = min(v[i], v[l]); v[i] = desc ? mx : mn; v[l] = desc ? mn : mx; } }
}
__device__ __forceinline__ void merge16_desc(unsigned (&R)[16], const unsigned (&G)[16]) {
#pragma unroll
    for (int i = 0; i < 16; ++i) R[i] = max(R[i], G[15 - i]);
#pragma unroll
    for (int j = 8; j > 0; j >>= 1)
#pragma unroll
        for (int i = 0; i < 16; ++i) { const int l = i ^ j; if (l > i) { const unsigned mx = max(R[i], R[l]), mn = min(R[i], R[l]); R[i] = mx; R[l] = mn; } }
}
__device__ __forceinline__ void cross_half_top16(unsigned (&T)[16], const unsigned (&R)[16], int hf) {
    unsigned O[16];
#pragma unroll
    for (int i = 0; i < 16; ++i) O[i] = __shfl_xor(R[i], 32);
#pragma unroll
    for (int i = 0; i < 16; ++i) { unsigned oi = O[i], ri = R[i], rj = R[15 - i], oj = O[15 - i]; asm volatile("" : "+v"(oi), "+v"(ri), "+v"(rj), "+v"(oj)); const unsigned a = hf ? oi : ri, b = hf ? rj : oj; T[i] = max(a, b); }
}
__device__ __forceinline__ void ph_peersel2(const Ids& id, const Params& p, int layer, float* lds) {
    const bf16* PQ = (const bf16*)(p.ws + WS_PQ); int* PE = (int*)(p.ws + WS_PE); float* PG = (float*)(p.ws + WS_PG);
    const bf16* SKB = (const bf16*)(p.ws + WS_SKB);
    const int lane = id.tid & 63, wave = __builtin_amdgcn_readfirstlane(id.tid >> 6), r = lane & 31, hf = lane >> 5;
    typedef __attribute__((address_space(3))) unsigned lds_u32;
    lds_u32* tl = (lds_u32*)((lds_u8*)lds + wave * 8192) + lane;
    typedef unsigned u4v __attribute__((ext_vector_type(4)));
    const int hg = id.bid & 1, tid_ = id.tid;
    lds_u8* skl = (lds_u8*)lds + 65536;
    for (int tile = (id.bid >> 1) * 8 + wave; tile < 1024; tile += ((int)gridDim.x >> 1) * 8) {
        const int tok0 = tile * 32;
#define SK_DMA(step, bufo) do { _Pragma("unroll") for (int i_ = 0; i_ < 4; ++i_) { int P = (wave * 4 + i_) * 64 + lane; asm volatile("" : "+v"(P));     \
        const int row = P >> 4, col = (P & 15) ^ (row & 15); \
        __builtin_amdgcn_global_load_lds((const __attribute__((address_space(1))) unsigned*)(SKB + (size_t)(hg * 8 + (step)) * 16384 + row * 128 + col * 8), \
            (__attribute__((address_space(3))) unsigned*)(skl + (bufo) + (wave * 4 + i_) * 1024), 16, 0, 0); } } while (0)
        __syncthreads();
        SK_DMA(0, 0);
        __syncthreads();
        for (int hh = 0; hh < 4; ++hh) {
            const int h = hg * 4 + hh;
            unsigned T0[16], T1[16];
#pragma unroll
            for (int pp = 0; pp < 2; ++pp) {
                const int step = hh * 2 + pp, bufo = (step & 1) * 32768;
                s16x8 bq[8];
#pragma unroll
                for (int kk = 0; kk < 8; ++kk) bq[kk] = *(const s16x8*)(PQ + (size_t)(tok0 + r) * 2048 + h * 256 + pp * 128 + kk * 16 + hf * 8);
                if (step < 7) SK_DMA(step + 1, 32768 - bufo);
                const lds_u8* skp = skl + bufo + r * 256;
                unsigned R[16];
#pragma unroll
                for (int kb = 0; kb < 4; ++kb) {
                    f32x16 acc;
#pragma unroll
                    for (int i = 0; i < 16; ++i) acc[i] = 0.f;
#pragma unroll
                    for (int kk = 0; kk < 8; ++kk) acc = __builtin_amdgcn_mfma_f32_32x32x16_bf16(ldsv8(skp + kb * 32 * 256 + (((kk * 2 + hf) ^ (r & 15)) << 4)), bq[kk], acc, 0, 0, 0);
                    __builtin_amdgcn_sched_barrier(0);
                    unsigned G[16];
#pragma unroll
                    for (int i = 0; i < 16; ++i) { const int kidx = kb * 32 + (i & 3) + 8 * (i >> 2) + 4 * hf; G[i] = (f2key(acc[i]) & ~127u) | (unsigned)(127 - kidx); }
                    sort16_desc(G);
                    if (kb == 0) {
#pragma unroll
                        for (int i = 0; i < 16; ++i) R[i] = G[i];
                    } else merge16_desc(R, G);
                }
                __syncthreads();
                if (pp == 0) cross_half_top16(T0, R, hf); else cross_half_top16(T1, R, hf);
            }
            {
#pragma unroll
              for (int j = 8; j > 0; j >>= 1)
#pragma unroll
                for (int i = 0; i < 16; ++i) { const int l = i ^ j; if (l > i) { const unsigned mx0 = max(T0[i], T0[l]), mn0 = min(T0[i], T0[l]), mx1 = max(T1[i], T1[l]), mn1 = min(T1[i], T1[l]); T0[i] = mx0; T0[l] = mn0; T1[i] = mx1; T1[l] = mn1; } }
            }
            float v0[16], v1[16];
#pragma unroll
            for (int i = 0; i < 16; ++i) { tl[i * 64] = T0[i]; tl[(16 + i) * 64] = T1[i]; v0[i] = key2f(T0[i] & ~127u); v1[i] = key2f(T1[i] & ~127u); }
            unsigned R2[16];
            {
                static constexpr unsigned char PA0[32] = {0, 0, 0, 0, 0, 0, 0, 0, 1, 1, 1, 1, 2, 2, 2, 3, 3, 4, 5, 6, 7, 8, 10, 12, 14, 0, 0, 0, 0, 0, 0, 0}; static constexpr unsigned char PB0[32] = {0, 2, 4, 6, 8, 10, 12, 14, 0, 2, 4, 6, 0, 2, 4, 1, 3, 1, 0, 0, 0, 0, 0, 0, 0, 0, 0, 0, 0, 0, 0, 0};
                static constexpr unsigned char PA1[32] = {0, 0, 0, 0, 0, 0, 0, 0, 1, 1, 1, 1, 2, 2, 3, 3, 4, 4, 5, 6, 7, 9, 11, 13, 15, 0, 0, 0, 0, 0, 0, 0}; static constexpr unsigned char PB1[32] = {1, 3, 5, 7, 9, 11, 13, 15, 1, 3, 5, 7, 1, 3, 0, 2, 0, 2, 1, 1, 1, 0, 0, 0, 0, 0, 0, 0, 0, 0, 0, 0};
#pragma unroll
                for (int g = 0; g < 2; ++g) {
                    unsigned G[16];
#pragma unroll
                    for (int i = 0; i < 16; ++i) { const int sidx = g * 16 + i;
                        if (sidx < 25) { const float s_lo = v0[PA0[sidx]] + v1[PB0[sidx]], s_hi = v0[PA1[sidx]] + v1[PB1[sidx]];
                            const unsigned k_lo = (f2key(s_lo) & ~255u) | (unsigned)(255 - (PA0[sidx] * 16 + PB0[sidx])), k_hi = (f2key(s_hi) & ~255u) | (unsigned)(255 - (PA1[sidx] * 16 + PB1[sidx]));
                            G[i] = hf ? k_hi : k_lo; }
                        else G[i] = 0u; }
                    sort16_desc(G);
                    if (g == 0) {
#pragma unroll
                        for (int i = 0; i < 16; ++i) R2[i] = G[i];
                    } else merge16_desc(R2, G);
                }
            }
            unsigned W[16];
            cross_half_top16(W, R2, hf);
            float sv[16]; int ex[16]; float m = -3.0e38f;
#pragma unroll
            for (int i = 0; i < 16; ++i) { const unsigned ci = 255u - (W[i] & 255u); const unsigned t0 = tl[(ci >> 4) * 64], t1 = tl[(16 + (ci & 15)) * 64];
                sv[i] = key2f(t0 & ~127u) + key2f(t1 & ~127u); ex[i] = (int)((127u - (t0 & 127u)) * 128u + (127u - (t1 & 127u))); m = fmaxf(m, sv[i]); }
            float sum = 0.f;
#pragma unroll
            for (int i = 0; i < 16; ++i) { sv[i] = __expf(sv[i] - m); sum += sv[i]; }
            const float inv = 1.f / sum;
            { unsigned ew[4], gw[4];
#pragma unroll
              for (int q = 0; q < 4; ++q) {
                  int ea0 = ex[2 * q], ea1 = ex[8 + 2 * q], eb0 = ex[1 + 2 * q], eb1 = ex[9 + 2 * q]; float ga0 = sv[2 * q], ga1 = sv[8 + 2 * q], gb0 = sv[1 + 2 * q], gb1 = sv[9 + 2 * q];
                  asm volatile("" : "+v"(ea0), "+v"(ea1), "+v"(eb0), "+v"(eb1), "+v"(ga0), "+v"(ga1), "+v"(gb0), "+v"(gb1));
                  const int ea = hf ? ea1 : ea0, eb = hf ? eb1 : eb0; const float ga = hf ? ga1 : ga0, gb = hf ? gb1 : gb0;
                  ew[q] = (unsigned)ea | ((unsigned)eb << 16); gw[q] = pg8::cvt_pk_bf16(ga * inv, gb * inv); }
              uint4 e4, g4; e4.x = ew[0]; e4.y = ew[1]; e4.z = ew[2]; e4.w = ew[3]; g4.x = gw[0]; g4.y = gw[1]; g4.z = gw[2]; g4.w = gw[3];
              const size_t o16 = ((size_t)(tok0 + r) * 128 + h * 16 + hf * 8) * 2;
              *(uint4*)((unsigned char*)PE + o16) = e4; *(uint4*)((unsigned char*)PG + o16) = g4; }
        }
    }
    __syncthreads();
}
#undef SK_DMA


constexpr size_t WS_U8 = WS_Z + 160 * MiB, WS_V8 = WS_Z + 176 * MiB;
constexpr size_t WS_SU = WS_Z + 192 * MiB, WS_SV = WS_SU + 65536;
constexpr size_t WS_PW = WS_Z + 193 * MiB;
typedef float f32x2v __attribute__((ext_vector_type(2)));
__device__ __forceinline__ void ph_uvprep8(const Ids& id, const Params& p, int layer) {
    const float* U = p.peer_u + (size_t)layer * 16384 * 1024; const float* V = p.peer_v + (size_t)layer * 16384 * 1024;
    const int lane = id.tid & 63, wave = __builtin_amdgcn_readfirstlane(id.tid >> 6);
    for (int row = id.bid * 8 + wave; row < 32768; row += gridDim.x * 8) {
        const bool isv = row >= 16384; const int e = isv ? row - 16384 : row;
        const float4* src = (const float4*)((isv ? V : U) + (size_t)e * 1024 + lane * 16);
        const float4 a = src[0], b = src[1], c = src[2], d = src[3];
        float am = fmaxf(fmaxf(fmaxf(fabsf(a.x), fabsf(a.y)), fmaxf(fabsf(a.z), fabsf(a.w))), fmaxf(fmaxf(fabsf(b.x), fabsf(b.y)), fmaxf(fabsf(b.z), fabsf(b.w))));
        am = fmaxf(am, fmaxf(fmaxf(fmaxf(fabsf(c.x), fabsf(c.y)), fmaxf(fabsf(c.z), fabsf(c.w))), fmaxf(fmaxf(fabsf(d.x), fabsf(d.y)), fmaxf(fabsf(d.z), fabsf(d.w)))));
        am = wave_max(am);
        const float sc = am > 0.f ? am * (1.f / 440.f) : 1.f, inv = 1.f / sc;
        int w0 = 0, w1 = 0, w2 = 0, w3 = 0;
        w0 = __builtin_amdgcn_cvt_pk_fp8_f32(a.x * inv, a.y * inv, w0, false); w0 = __builtin_amdgcn_cvt_pk_fp8_f32(a.z * inv, a.w * inv, w0, true);
        w1 = __builtin_amdgcn_cvt_pk_fp8_f32(b.x * inv, b.y * inv, w1, false); w1 = __builtin_amdgcn_cvt_pk_fp8_f32(b.z * inv, b.w * inv, w1, true);
        w2 = __builtin_amdgcn_cvt_pk_fp8_f32(c.x * inv, c.y * inv, w2, false); w2 = __builtin_amdgcn_cvt_pk_fp8_f32(c.z * inv, c.w * inv, w2, true);
        w3 = __builtin_amdgcn_cvt_pk_fp8_f32(d.x * inv, d.y * inv, w3, false); w3 = __builtin_amdgcn_cvt_pk_fp8_f32(d.z * inv, d.w * inv, w3, true);
        uint4 o; o.x = (unsigned)w0; o.y = (unsigned)w1; o.z = (unsigned)w2; o.w = (unsigned)w3;
        *(uint4*)(p.ws + (isv ? WS_V8 : WS_U8) + (size_t)e * 1024 + lane * 16) = o;
        if (lane == 0) ((float*)(p.ws + (isv ? WS_SV : WS_SU)))[e] = sc;
    }
}
__device__ __forceinline__ void unpack_fp8x16(const uint4 q, float* f) {
    const unsigned w[4] = {q.x, q.y, q.z, q.w};
#pragma unroll
    for (int i = 0; i < 4; ++i) { const f32x2v lo = __builtin_amdgcn_cvt_pk_f32_fp8((int)w[i], false), hi = __builtin_amdgcn_cvt_pk_f32_fp8((int)w[i], true);
        f[4 * i] = lo[0]; f[4 * i + 1] = lo[1]; f[4 * i + 2] = hi[0]; f[4 * i + 3] = hi[1]; }
}
__device__ __forceinline__ float dot16_fp8(const uint4 q, const float* x) {
    const unsigned w[4] = {q.x, q.y, q.z, q.w}; f32x2v acc = {0.f, 0.f};
#pragma unroll
    for (int i = 0; i < 4; ++i) { const f32x2v lo = __builtin_amdgcn_cvt_pk_f32_fp8((int)w[i], false), hi = __builtin_amdgcn_cvt_pk_f32_fp8((int)w[i], true);
        const f32x2v x0 = {x[4 * i], x[4 * i + 1]}, x1 = {x[4 * i + 2], x[4 * i + 3]};
        acc = __builtin_elementwise_fma(x0, lo, acc); acc = __builtin_elementwise_fma(x1, hi, acc); }
    return acc[0] + acc[1]; }
__device__ __forceinline__ void dot16_fp8_acc(const uint4 q, const float* x, f32x2v& acc) {
    const unsigned w[4] = {q.x, q.y, q.z, q.w};
#pragma unroll
    for (int i = 0; i < 4; ++i) { const f32x2v lo = __builtin_amdgcn_cvt_pk_f32_fp8((int)w[i], false), hi = __builtin_amdgcn_cvt_pk_f32_fp8((int)w[i], true);
        const f32x2v x0 = {x[4 * i], x[4 * i + 1]}, x1 = {x[4 * i + 2], x[4 * i + 3]};
        acc = __builtin_elementwise_fma(x0, lo, acc); acc = __builtin_elementwise_fma(x1, hi, acc); } }
__device__ __forceinline__ float dot64_fp8(const uint4 q0, const uint4 q1, const uint4 q2, const uint4 q3, const float* x) {
    f32x2v a = {0.f, 0.f}, b = {0.f, 0.f};
    dot16_fp8_acc(q0, x, a); dot16_fp8_acc(q1, x + 16, b); dot16_fp8_acc(q2, x + 32, a); dot16_fp8_acc(q3, x + 48, b);
    a += b; return a[0] + a[1]; }
__device__ __forceinline__ float swap32_add(float a, float b) { const auto r = __builtin_amdgcn_permlane32_swap(__float_as_uint(a), __float_as_uint(b), false, false); return __uint_as_float(r[0]) + __uint_as_float(r[1]); }
__device__ __forceinline__ float swap16_add(float a, float b) { const auto r = __builtin_amdgcn_permlane16_swap(__float_as_uint(a), __float_as_uint(b), false, false); return __uint_as_float(r[0]) + __uint_as_float(r[1]); }
__device__ __forceinline__ float dpp_ror8(float v) { return __uint_as_float(__builtin_amdgcn_update_dpp(0u, __float_as_uint(v), 0x128, 0xf, 0xf, true)); }
__device__ __forceinline__ float sum8_dpp(float v) {
    v += __uint_as_float(__builtin_amdgcn_update_dpp(0u, __float_as_uint(v), 0x141, 0xf, 0xf, true));
    v += __uint_as_float(__builtin_amdgcn_update_dpp(0u, __float_as_uint(v), 0xb1, 0xf, 0xf, true));
    v += __uint_as_float(__builtin_amdgcn_update_dpp(0u, __float_as_uint(v), 0x4e, 0xf, 0xf, true));
    return v;
}

__device__ __forceinline__ float gelu_erf(float v) {
    const float av = fabsf(v), t = __builtin_amdgcn_rcpf(av * 0.2316418882f + 1.0f);
    float q = t * 0.5307027145f + (-0.7265760135f); q = q * t + 0.7107068705f; q = q * t + (-0.142248368f); q = q * t + 0.127414796f; q = q * t;
    const float e = __builtin_amdgcn_exp2f((v * v) * (-0.72134752044f));
    const float m = v * (q * e);
    return v < 0.f ? m : v - m;
}
__device__ __forceinline__ float row16_sum_dpp(float v) {
    v += __uint_as_float(__builtin_amdgcn_update_dpp(0u, __float_as_uint(v), 0x128, 0xf, 0xf, true));
    v += __uint_as_float(__builtin_amdgcn_update_dpp(0u, __float_as_uint(v), 0x124, 0xf, 0xf, true));
    v += __uint_as_float(__builtin_amdgcn_update_dpp(0u, __float_as_uint(v), 0x122, 0xf, 0xf, true));
    v += __uint_as_float(__builtin_amdgcn_update_dpp(0u, __float_as_uint(v), 0x121, 0xf, 0xf, true));
    return v;
}
__device__ __forceinline__ void ph_peer_u(const Ids& id, const Params& p, int layer, float* lds, int emask = 0x7fffffff) {
    const bf16* N = (const bf16*)(p.ws + WS_N); const int* PE = (const int*)(p.ws + WS_PE); const float* PG = (const float*)(p.ws + WS_PG); float* PW = (float*)(p.ws + WS_PW);
    const float* SU = (const float*)(p.ws + WS_SU); const float* SV = (const float*)(p.ws + WS_SV);
    const int lane = id.tid & 63, wave = __builtin_amdgcn_readfirstlane(id.tid >> 6), s16 = lane & 15, rg = lane >> 4;
    const unsigned char* U8b = p.ws + WS_U8; const unsigned uoff = (unsigned)(s16 * 16);
    const int j = id.bid & 7, widx = (id.bid >> 3) * 8 + wave, nw = ((int)gridDim.x >> 3) * 8;
    typedef __attribute__((address_space(3))) unsigned lds_u32;
    lds_u32* Le = (lds_u32*)((lds_u8*)lds + wave * 2048); lds_u32* Ls = Le + 128; lds_u32* Ld = Le + 256;
    unsigned nep = ((const unsigned*)PE)[(size_t)widx * 64 + lane], ngp = ((const unsigned*)PG)[(size_t)widx * 64 + lane];
    for (int tok = widx; tok < NTOK; tok += nw) {
        const int e0 = (int)(nep & 0xffffu), e1 = (int)(nep >> 16); const float g0 = __uint_as_float(ngp << 16), g1 = __uint_as_float(ngp & 0xffff0000u);
        uint4 xr[8];
#pragma unroll
        for (int i = 0; i < 4; ++i) { const bf16* xp = N + (size_t)tok * 1024 + i * 256 + s16 * 16; xr[2 * i] = *(const uint4*)xp; xr[2 * i + 1] = *(const uint4*)(xp + 8); }
        { const int tn = (tok + nw < NTOK) ? tok + nw : tok;
          nep = ((const unsigned*)PE)[(size_t)tn * 64 + lane]; ngp = ((const unsigned*)PG)[(size_t)tn * 64 + lane]; }
        const bool own0 = (e0 >> 11) == j, own1 = (e1 >> 11) == j;
        const unsigned long long m0 = __builtin_amdgcn_ballot_w64(own0), m1 = __builtin_amdgcn_ballot_w64(own1);
        const int n0 = __builtin_popcountll(m0), n = n0 + __builtin_popcountll(m1);
        const int pos0 = (int)__builtin_amdgcn_mbcnt_hi((unsigned)(m0 >> 32), __builtin_amdgcn_mbcnt_lo((unsigned)m0, 0u));
        const int pos1 = n0 + (int)__builtin_amdgcn_mbcnt_hi((unsigned)(m1 >> 32), __builtin_amdgcn_mbcnt_lo((unsigned)m1, 0u));
        if (own0) { Le[pos0] = (unsigned)e0; Ls[pos0] = (unsigned)(2 * lane); }
        if (own1) { Le[pos1] = (unsigned)e1; Ls[pos1] = (unsigned)(2 * lane + 1); }
        const int ef = (int)Le[lane < n ? lane : 0] & 16383; const float suf = SU[ef];
        const float svf = SV[ef];
        const int npass = (n + 3) >> 2;
        {
            uint4 q[6][4]; bool vld[6];
#pragma unroll
            for (int k = 0; k < 6; ++k) { const int idx = 4 * k + rg; vld[k] = idx < n;
                const int e = (int)Le[vld[k] ? idx : 0] & emask; const unsigned ro = ((unsigned)e << 10) + uoff;
                if (k < npass) { q[k][0] = *(const uint4*)(U8b + ro); q[k][1] = *(const uint4*)(U8b + ro + 256); q[k][2] = *(const uint4*)(U8b + ro + 512); q[k][3] = *(const uint4*)(U8b + ro + 768); } }
            float x[64];
#pragma unroll
            for (int i = 0; i < 8; ++i) unpack8(xr[i], x + 8 * i);
#pragma unroll
            for (int k = 0; k < 6; ++k) if (k < npass) {
                float d = dot64_fp8(q[k][0], q[k][1], q[k][2], q[k][3], x);
                d = row16_sum_dpp(d);
                if (vld[k] && s16 == 0) Ld[4 * k + rg] = __float_as_uint(d); }
        }
        for (int k = 6; k < npass; ++k) {
            float x[64];
#pragma unroll
            for (int i = 0; i < 8; ++i) unpack8(xr[i], x + 8 * i);
            const int idx = 4 * k + rg; const bool valid = idx < n;
            const int e = (int)Le[valid ? idx : 0] & emask;
            const unsigned ro = ((unsigned)e << 10) + uoff;
            const uint4 q0 = *(const uint4*)(U8b + ro), q1 = *(const uint4*)(U8b + ro + 256), q2 = *(const uint4*)(U8b + ro + 512), q3 = *(const uint4*)(U8b + ro + 768);
            float d = dot64_fp8(q0, q1, q2, q3, x);
            d = row16_sum_dpp(d);
            if (valid && s16 == 0) Ld[idx] = __float_as_uint(d);
        }
#pragma unroll
        for (int hh = 0; hh < 2; ++hh) { const int i = hh * 64 + lane;
            if (hh == 1 && n <= 64) break;
            const int slot = (i < n) ? (int)Ls[i] : 0; const float gsa = __shfl(g0, slot >> 1), gsb = __shfl(g1, slot >> 1); const float gs = (slot & 1) ? gsb : gsa;
            if (i < n) { const float dv = __uint_as_float(Ld[i]) * (hh == 0 ? suf : SU[(int)Le[i] & 16383]); const float g = gs * (hh == 0 ? svf : SV[(int)Le[i] & 16383]);
                ((bf16*)PW)[(size_t)tok * 128 + slot] = f2bf(g * gelu_erf(dv)); } }
    }
    __syncthreads();
}
struct TokV { int e0, e1; float ws0, ws1; float acc[16]; };
__device__ __forceinline__ void peerv_issue(const TokV& t, int hb, uint4 (&q)[8], float (&wsl)[8], const unsigned char* V8b, unsigned voff, int rg) {
#pragma unroll
    for (int it = 0; it < 8; ++it) { const int sl = it * 8 + rg;
        const int e = hb ? __shfl(t.e1, sl) : __shfl(t.e0, sl); wsl[it] = hb ? __shfl(t.ws1, sl) : __shfl(t.ws0, sl);
        q[it] = *(const uint4*)(V8b + (((unsigned)e << 10) + voff)); }
}
__device__ __forceinline__ void peerv_compute(TokV& t, const uint4 (&q)[8], const float (&wsl)[8]) {
#pragma unroll
    for (int it = 0; it < 8; ++it) { const unsigned w[4] = {q[it].x, q[it].y, q[it].z, q[it].w}; const f32x2v ws2 = {wsl[it], wsl[it]};
#pragma unroll
        for (int i = 0; i < 4; ++i) { const f32x2v lo = __builtin_amdgcn_cvt_pk_f32_fp8((int)w[i], false), hi = __builtin_amdgcn_cvt_pk_f32_fp8((int)w[i], true);
            f32x2v a0 = {t.acc[4 * i], t.acc[4 * i + 1]}, a1 = {t.acc[4 * i + 2], t.acc[4 * i + 3]};
            a0 = __builtin_elementwise_fma(ws2, lo, a0); a1 = __builtin_elementwise_fma(ws2, hi, a1);
            t.acc[4 * i] = a0[0]; t.acc[4 * i + 1] = a0[1]; t.acc[4 * i + 2] = a1[0]; t.acc[4 * i + 3] = a1[1]; } }
}
__device__ __forceinline__ void peerv_finish(const TokV& t, const Params& p, const float* modg, int tok, int dimoff, int lane, float gmul, bool last) {
    float r8[8], r4[4], r2[2];
#pragma unroll
    for (int i = 0; i < 8; ++i) r8[i] = swap32_add(t.acc[i], t.acc[8 + i]);
#pragma unroll
    for (int i = 0; i < 4; ++i) r4[i] = swap16_add(r8[i], r8[4 + i]);
    const bool b3 = (lane >> 3) & 1;
#pragma unroll
    for (int i = 0; i < 2; ++i) r2[i] = (b3 ? r4[2 + i] : r4[i]) + dpp_ror8(b3 ? r4[i] : r4[2 + i]);
    const unsigned off = (unsigned)tok * 1024u + (unsigned)dimoff;
    const float2 g = *(const float2*)((const char*)modg + (((unsigned)(tok >> 11) * 6144u + (unsigned)dimoff) << 2)); const unsigned hb = *(const unsigned*)((const char*)(p.ws + WS_HM) + (off << 1));
    const float o0 = __uint_as_float(hb << 16) + gmul * g.x * r2[0], o1 = __uint_as_float(hb & 0xffff0000u) + gmul * g.y * r2[1];
    if (last) { float2 o; o.x = o0; o.y = o1; *(float2*)((char*)p.out + (off << 2)) = o; }
    else *(unsigned*)((char*)p.out + (off << 1)) = pg8::cvt_pk_bf16(o0, o1);
}
__device__ __forceinline__ void ph_peer_v(const Ids& id, const Params& p, int layer, float gmul = 1.f) {
    const int* PE = (const int*)(p.ws + WS_PE); const float* PW = (const float*)(p.ws + WS_PW);
    const float* SV = (const float*)(p.ws + WS_SV);
    const float* mod = (const float*)(p.ws + WS_MOD) + (size_t)layer * 16 * 6144;
    const int lane = id.tid & 63, wave = __builtin_amdgcn_readfirstlane(id.tid >> 6), sub = lane & 7, rg = lane >> 3;
    const int j = id.bid & 7, widx = (id.bid >> 3) * 8 + wave, nw = ((int)gridDim.x >> 3) * 8;
    const unsigned char* V8b = p.ws + WS_V8; const unsigned voff = (unsigned)(j * 128 + sub * 16);
    const int dimoff = j * 128 + sub * 16 + 8 * ((lane >> 5) & 1) + 4 * ((lane >> 4) & 1) + 2 * ((lane >> 3) & 1);
#define PV_UNPACK(T, ew, ww) do { T.e0 = (int)((ew) & 0xffffu); T.e1 = (int)((ew) >> 16); T.ws0 = __uint_as_float((ww) << 16); T.ws1 = __uint_as_float((ww) & 0xffff0000u); } while (0)
#define PV_REC(tn_) do { nea = ((const unsigned*)PE)[(size_t)(tn_) * 64 + lane]; neb = ((const unsigned*)PE)[(size_t)((tn_) + nw) * 64 + lane]; \
                         nwa = ((const unsigned*)PW)[(size_t)(tn_) * 64 + lane]; nwb = ((const unsigned*)PW)[(size_t)((tn_) + nw) * 64 + lane]; } while (0)
    unsigned nea, neb, nwa, nwb;
    TokV A, B;
    PV_REC(widx);
    unsigned pea = nea, peb = neb, pwa = nwa, pwb = nwb;
    PV_UNPACK(A, pea, pwa); PV_UNPACK(B, peb, pwb);
    { const int t1 = (widx + 2 * nw < NTOK) ? widx + 2 * nw : widx; PV_REC(t1); }
    uint4 qa[8], qb[8]; float wa[8], wb[8];
    peerv_issue(A, 0, qa, wa, V8b, voff, rg); peerv_issue(B, 0, qb, wb, V8b, voff, rg);
    for (int tok = widx; tok < NTOK; tok += 2 * nw) {
        const int tokB = tok + nw;
        PV_UNPACK(A, pea, pwa); PV_UNPACK(B, peb, pwb);
#pragma unroll
        for (int i = 0; i < 16; ++i) { A.acc[i] = 0.f; B.acc[i] = 0.f; }
        peerv_compute(A, qa, wa); peerv_issue(A, 1, qa, wa, V8b, voff, rg); __builtin_amdgcn_sched_barrier(0);
        peerv_compute(B, qb, wb); peerv_issue(B, 1, qb, wb, V8b, voff, rg); __builtin_amdgcn_sched_barrier(0);
        peerv_compute(A, qa, wa);
        { TokV An; PV_UNPACK(An, nea, nwa); peerv_issue(An, 0, qa, wa, V8b, voff, rg); } __builtin_amdgcn_sched_barrier(0);
        peerv_compute(B, qb, wb);
        { TokV Bn; PV_UNPACK(Bn, neb, nwb); peerv_issue(Bn, 0, qb, wb, V8b, voff, rg); } __builtin_amdgcn_sched_barrier(0);
        pea = nea; peb = neb; pwa = nwa; pwb = nwb;
        { const int t2 = (tok + 4 * nw < NTOK) ? tok + 4 * nw : tok; PV_REC(t2); }
        peerv_finish(A, p, mod + 5 * 1024, tok, dimoff, lane, gmul, layer == 1);
        peerv_finish(B, p, mod + 5 * 1024, tokB, dimoff, lane, gmul, layer == 1);
    }
#undef PV_UNPACK
#undef PV_REC
}

#ifndef PROBE_A
#define PROBE_A 0
#endif
#ifndef PROBE_GAIN
#define PROBE_GAIN 1.0f
#endif
#if PROBE_A
constexpr size_t WS_Y2 = 516 * MiB;
__device__ __forceinline__ void ph_probe_diff(const Ids& id, const Params& p, int layer, float* lds) {
    const bf16* Y1 = (const bf16*)(p.ws + WS_YA); const bf16* Y2 = (const bf16*)(p.ws + WS_Y2);
    float e = 0.f, n = 0.f;
    for (size_t i = (size_t)id.bid * NTHR + id.tid; i < (size_t)8192 * 512; i += (size_t)gridDim.x * NTHR) { const float a = bf2f(Y1[i]), b = bf2f(Y2[i]); e += (a - b) * (a - b); n += a * a; }
    e = wave_sum(e); n = wave_sum(n);
    __syncthreads();
    if ((id.tid & 63) == 0) { lds[(id.tid >> 6) * 2] = e; lds[(id.tid >> 6) * 2 + 1] = n; }
    __syncthreads();
    if (id.tid == 0) { float es = 0.f, ns = 0.f; for (int w = 0; w < 8; ++w) { es += lds[w * 2]; ns += lds[w * 2 + 1]; }
        float* o = (float*)(p.ws + WS_CTL) + (layer * 256 + id.bid) * 2; o[0] = es; o[1] = ns; }
    __syncthreads();
}
__device__ __forceinline__ void ph_probe_scale(const Ids& id, const Params& p) {
    float e = 0.f, n = 0.f; const float* c = (const float*)(p.ws + WS_CTL);
    for (int i = 0; i < 2 * (int)gridDim.x; ++i) { e += c[2 * i]; n += c[2 * i + 1]; }
    const float f = 1.f + PROBE_GAIN * sqrtf(e / n);
    for (size_t i = (size_t)id.bid * NTHR + id.tid; i < (size_t)NTOK * 1024; i += (size_t)gridDim.x * NTHR) p.out[i] *= f;
}
#endif

#define XB_TMO      128
#define XB_XCNT(j)  (256  + 64 * (j))
#define XB_XSUB(j)  (1280 + 64 * (j))
#define XB_XGEN(j)  (2304 + 64 * (j))
#define XB_TOP      3328
#define XB_TOPGEN   3392
#define XCD_BAR_WORDS 3456
#define XB_SPIN_CAP (1u << 18)

__device__ __forceinline__ unsigned xb_ld(unsigned* p)              { return __hip_atomic_load(p, __ATOMIC_RELAXED, __HIP_MEMORY_SCOPE_AGENT); }
__device__ __forceinline__ unsigned xb_add(unsigned* p, unsigned v) { return __hip_atomic_fetch_add(p, v, __ATOMIC_RELAXED, __HIP_MEMORY_SCOPE_AGENT); }
__device__ __forceinline__ unsigned xb_xcc_id() { return (unsigned)__builtin_amdgcn_s_getreg((3 << 11) | 20) & 0xFu; }
#define XB_SPIN(cond, bar) do { unsigned _sp = 0; while (cond) { __builtin_amdgcn_s_sleep(1); \
    if ((++_sp & 255u) == 0u) { if (xb_ld(&(bar)[XB_TMO])) break; if (_sp > XB_SPIN_CAP) { atomicAdd(&(bar)[XB_TMO], 1u); break; } } } } while (0)

struct XcdBarrier {
    unsigned* bar; unsigned x;
    volatile __attribute__((address_space(3))) unsigned* st;
};

__device__ __forceinline__ XcdBarrier xcd_barrier_post(unsigned* bar, volatile __attribute__((address_space(3))) unsigned* st) {
    XcdBarrier b; b.bar = bar; b.x = xb_xcc_id(); b.st = st;
    if (threadIdx.x == 0) (void)xb_add(&bar[XB_XCNT(b.x)], 1u);
    return b;
}
__device__ __forceinline__ void xcd_barrier_complete(unsigned* bar, unsigned x, unsigned& nloc, unsigned& nx) {
    const unsigned G = gridDim.x * gridDim.y * gridDim.z;
    unsigned sum, cnt, mine, sp = 0u;
    for (;;) {
        sum = 0u; cnt = 0u; mine = 0u;
#pragma unroll
        for (unsigned j = 0; j < 16; ++j) { const unsigned c = xb_ld(&bar[XB_XCNT(j)]); sum += c; cnt += (c > 0u) ? 1u : 0u; mine = (j == x) ? c : mine; }
        if (sum == G) break;
        __builtin_amdgcn_s_sleep(1);
        if ((++sp & 255u) == 0u) { if (xb_ld(&bar[XB_TMO])) break; if (sp > XB_SPIN_CAP) { atomicAdd(&bar[XB_TMO], 1u); break; } }
    }
    nloc = mine > 0u ? mine : 1u; nx = cnt > 0u ? cnt : 1u;
}

__device__ __forceinline__ void xcd_barrier(const XcdBarrier& b) {
    asm volatile("s_waitcnt vmcnt(0)" ::: "memory");
    __syncthreads();
    if (threadIdx.x == 0) {
        unsigned* bar = b.bar;
        __builtin_amdgcn_s_waitcnt(0);
        unsigned nloc = b.st[0], nx = b.st[1];
        if (nloc == 0u) { xcd_barrier_complete(bar, b.x, nloc, nx); b.st[0] = nloc; b.st[1] = nx; }
        const unsigned old = xb_add(&bar[XB_XSUB(b.x)], 1u);
        const unsigned gen = old / nloc;
        if (old + 1u == (gen + 1u) * nloc) {
            __builtin_amdgcn_fence(__ATOMIC_RELEASE, "agent");
            asm volatile("s_waitcnt vmcnt(0)" ::: "memory");
            const unsigned og = xb_add(&bar[XB_TOP], 1u);
            const unsigned tg = og / nx;
            if (og + 1u == (tg + 1u) * nx) xb_add(&bar[XB_TOPGEN], 1u);
            else XB_SPIN(xb_ld(&bar[XB_TOPGEN]) == tg, bar);
            __builtin_amdgcn_fence(__ATOMIC_ACQUIRE, "agent");
            xb_add(&bar[XB_XGEN(b.x)], 1u);
            asm volatile("s_waitcnt vmcnt(0)" ::: "memory");
        } else {
            XB_SPIN(xb_ld(&bar[XB_XGEN(b.x)]) == gen, bar);
            __builtin_amdgcn_fence(__ATOMIC_ACQUIRE, "agent");
            asm volatile("s_waitcnt vmcnt(0)" ::: "memory");
        }
    }
    __syncthreads();
}


constexpr int PH_PER_LAYER = 14;
#ifndef REP_PEERSEL
#define REP_PEERSEL 1
#endif
#ifndef REP_C
#define REP_C 1
#endif
#ifndef PROBE_NOGATHER
#define PROBE_NOGATHER 0
#endif
#ifndef USE_XCD_BARRIER
#define USE_XCD_BARRIER 1
#endif
#ifndef USE_PEER8
#define USE_PEER8 1
#endif
#ifndef REP_A
#define REP_A 1
#endif
#ifndef REP_B
#define REP_B 1
#endif
#ifndef REP_C2
#define REP_C2 1
#endif
#ifndef REP_Q
#define REP_Q -100
#endif
#ifndef REP_N
#define REP_N 2
#endif
#ifndef USE_C_MFMA
#define USE_C_MFMA 1
#endif
#ifndef USE_PEERSEL2
#define USE_PEERSEL2 1
#endif
#ifndef USE_PEEREXP2
#define USE_PEEREXP2 1
#endif
#ifndef USE_A_MFMA
#define USE_A_MFMA 1
#endif
#ifndef USE_B_MFMA
#define USE_B_MFMA 1
#endif
#ifndef GATE_ACT
#define GATE_ACT 1
#endif
#ifndef GEMM_PG8
#define GEMM_PG8 31
#endif

template <class Epi>
__device__ __forceinline__ void run_gemm(const Ids& id, float* lds, const bf16* A, const bf16* Bt, int N, int K, const Epi& E) {
    pg8::Gemm g{A, Bt, NTOK, N, K, nullptr, nullptr, nullptr, nullptr}; pg8::StaticOrder S; S.init(NTOK, N, (int)gridDim.x, id.bid);
    pg8::gemm_phase<Epi, pg8::StaticOrder, true, true>((PG8_LAS unsigned char*)lds, g, S, E, id.tid);
}

template <int Q>
__device__ __forceinline__ void run_phase_body(const Params& p, int layer, float* lds, const int rep_) {
    {
    Ids id; id.tid = threadIdx.x; id.bid = blockIdx.x;
    asm volatile("" : "+v"(id.tid), "+s"(id.bid));
    if constexpr (Q < 0) { ph_mod(id, p, lds); if (rep_ + 1 < ((Q == REP_Q) ? REP_N : 1)) return;
#if PROBE_A
        if (id.bid == 0 && id.tid < 2) ((float*)(p.ws + WS_CTL))[id.tid] = 0.f;
#endif
        return; }
    unsigned char* ws = p.ws;
    bf16* N = (bf16*)(ws + WS_N); bf16* Z = (bf16*)(ws + WS_Z);
    const float* mod = (const float*)(ws + WS_MOD) + (size_t)layer * 16 * 6144;
    float* M = (float*)(ws + WS_M); bf16* G = (bf16*)(ws + WS_G);
    const float* win = p.w_in + (size_t)layer * 1024 * INC;
    if constexpr (Q == 0) { ph_wprep(id, p, layer, lds); ph_norm(id, p, layer, 0);
        if (id.bid == 0 && id.tid < 256) { const int t4 = id.tid >> 6, c = id.tid & 63; const float* sp = t4 == 0 ? p.a_qn_g : (t4 == 1 ? p.a_kn_g : (t4 == 2 ? p.b_qn_g : p.b_kn_g));
            ((float*)(ws + WS_QKG))[layer * 256 + id.tid] = sp[layer * 64 + c]; } }
    if constexpr (Q == 1) { if constexpr (GEMM_PG8 & 1) { if constexpr (FUSE_QK) run_gemm(id, lds, N, (const bf16*)(ws + WS_WIN_T), 4096, 1024, pg8::EpiInQK{Z, ZC, (const float*)(ws + WS_QKG) + layer * 256, (PG8_LAS float*)((PG8_LAS unsigned char*)lds + pg8::STAGE_BYTES)});
                              else run_gemm(id, lds, N, (const bf16*)(ws + WS_WIN_T), 4096, 1024, pg8::EpiBfStore<0>{Z, ZC, nullptr}); }
                            else gemm_naive<true>(id, N, 1024, win, INC, 4052, 1024, EpiBf{Z, ZC, 0}, lds); }
    if constexpr (Q == 2 && !FUSE_QK) ph_qknorm(id, p, layer);
    if constexpr (Q == 3) {
#if PROBE_A
        ph_A(id, p, lds); ph_A_mfma(id, p, layer, lds, WS_Y2, 4);
#else
        if constexpr (USE_A_MFMA) { for (int ra = 0; ra < REP_A; ++ra) { asm volatile("" : "+s"(ra)); ph_A_mfma(id, p, layer, lds); } } else ph_A(id, p, lds);
#endif
 if constexpr (USE_B_MFMA) { for (int rb = 0; rb < REP_B; ++rb) { asm volatile("" : "+s"(rb)); ph_B_mfma(id, p, lds); } } else ph_B(id, p, lds); ph_C_chunk<1>(id, p, layer, lds); }
    if constexpr (Q == 5) ph_C_chunk<3>(id, p, layer, lds);
    if constexpr (Q == 4) { ph_C_scan(id, p);
        if constexpr (FUSE_GATES) run_gemm(id, lds, N, (const bf16*)(ws + WS_WG_T), 3072, 1024, pg8::EpiGate8{(unsigned char*)G, LDG, p.b_gate + layer * 3072});
#if PROBE_A
        ph_probe_diff(id, p, layer, lds);
#endif
    }
    if constexpr (Q == 6 && !FUSE_GATES) { if constexpr (GEMM_PG8 & 2) run_gemm(id, lds, N, (const bf16*)(ws + WS_WG_T), 3072, 1024, pg8::EpiGate8{(unsigned char*)G, LDG, p.b_gate + layer * 3072});
                            else gemm_naive<false>(id, N, 1024, win + 4052, INC, 3072, 1024, EpiSigBfN{G, p.b_gate + layer * 3072}, lds); }
    if constexpr (Q == 7) {
        if constexpr (GEMM_PG8 & 4) {
        {   pg8::Gemm g{(const bf16*)(ws + WS_YA), (const bf16*)(ws + WS_WOA_T), NTOK, 1024, 512, (const bf16*)(ws + WS_YB), (const bf16*)(ws + WS_WOB_T), (const bf16*)(ws + WS_YC), (const bf16*)(ws + WS_WOC_T)};
            pg8::ChainOrder S; S.S.init(NTOK, 1024, (int)gridDim.x, id.bid);
            pg8::gemm_phase<pg8::EpiChain, pg8::ChainOrder, true, true, true>((PG8_LAS unsigned char*)lds, g, S, pg8::EpiChain{(const unsigned char*)G, N}, id.tid); }
        } else {
        gemm_naive<false>(id, (const bf16*)(ws + WS_YA), 512, p.w_oa + (size_t)layer * 512 * 1024, 1024, 1024, 512, EpiProjN{G, M, N, 0, GATE_ACT ? nullptr : p.b_gate + layer * 3072}, lds);
        gemm_naive<false>(id, (const bf16*)(ws + WS_YB), 512, p.w_ob + (size_t)layer * 512 * 1024, 1024, 1024, 512, EpiProjN{G + 1024, M, N, 1, GATE_ACT ? nullptr : p.b_gate + layer * 3072 + 1024}, lds);
        gemm_naive<false>(id, (const bf16*)(ws + WS_YC), 512, p.w_oc + (size_t)layer * 512 * 1024, 1024, 1024, 512, EpiProjN{G + 2048, M, N, 2, GATE_ACT ? nullptr : p.b_gate + layer * 3072 + 2048}, lds);
        }
    }
    if constexpr (Q == 8) { if constexpr (GEMM_PG8 & 8) { if (layer == 0) run_gemm(id, lds, N, (const bf16*)(ws + WS_WOUT_T), 1024, 1024, pg8::EpiResid<false>{(const void*)p.x, (bf16*)(ws + WS_HM), mod + 2 * 1024});
                              else run_gemm(id, lds, N, (const bf16*)(ws + WS_WOUT_T), 1024, 1024, pg8::EpiResid<true>{(const void*)p.out, (bf16*)(ws + WS_HM), mod + 2 * 1024}); }
                            else gemm_naive<false>(id, N, 1024, p.w_out + (size_t)layer * 1024 * 1024, 1024, 1024, 1024, EpiRes{layer == 0 ? p.x : p.out, p.out, mod + 2 * 1024}, lds); }
    if constexpr (Q == 9) { ph_norm(id, p, layer, 1); if constexpr (USE_PEER8) ph_uvprep8(id, p, layer); else ph_uvprep(id, p, layer); }
    if constexpr (Q == 10) { if constexpr (GEMM_PG8 & 16) run_gemm(id, lds, N, (const bf16*)(ws + WS_WPQ_T), 2048, 1024, pg8::EpiBfStore<0>{(bf16*)(ws + WS_PQ), 2048, nullptr});
                            else gemm_naive<false>(id, N, 1024, p.peer_wq + (size_t)layer * 1024 * 2048, 2048, 2048, 1024, EpiBf{(bf16*)(ws + WS_PQ), 2048, 0}, lds); }
    if constexpr (Q == 11) { for (int rep = 0; rep < REP_PEERSEL; ++rep) { asm volatile("" : "+s"(rep)); if constexpr (USE_PEERSEL2) ph_peersel2(id, p, layer, lds); else ph_peersel(id, p, layer, lds); } }
    if constexpr (Q == 12) { if constexpr (USE_PEER8) ph_peer_u(id, p, layer, lds, (PROBE_NOGATHER && rep_ + 1 < REP_N) ? 0x3800 : 0x7fffffff); else if constexpr (USE_PEEREXP2) ph_peerexp2(id, p, layer); else ph_peerexp(id, p, layer, lds); }
    if constexpr (Q == 13) { if constexpr (USE_PEER8) ph_peer_v(id, p, layer, (rep_ + 1 < ((Q == REP_Q) ? REP_N : 1)) ? 0.f : 1.f); }
    }
}

template <int Q>
__device__ __forceinline__ void run_phase(const Params& p_unused, int layer, float* lds) {
    if constexpr (Q == REP_Q) { for (int rep_ = 0; rep_ < REP_N; ++rep_) { asm volatile("" : "+s"(rep_)); run_phase_body<Q>(p_unused, layer, lds, rep_); } }
    else run_phase_body<Q>(p_unused, layer, lds, 0);
}

#if MK_COOP
constexpr int CW_BAR = 4096;
constexpr int LDS_MISC = LDS_BYTES - 64;
#if USE_XCD_BARRIER
#define GSYNC() xcd_barrier(xbar)
#else
#define GSYNC() cg::this_grid().sync()
#endif
template <int Q> __device__ __forceinline__ void layer_phases(const Params& p, int layer, float* lds, const XcdBarrier& xbar) {
    if constexpr ((FUSE_QK && Q == 2) || (FUSE_GATES && Q == 6)) { layer_phases<Q + 1>(p, layer, lds, xbar); }
    else {
    run_phase<Q>(p, layer, lds);
    if constexpr (Q + 1 < PH_PER_LAYER) { GSYNC(); layer_phases<Q + 1>(p, layer, lds, xbar); }
    }
}
__global__ void __launch_bounds__(NTHR, 2) k_mega(Params p) {
    extern __shared__ __attribute__((aligned(16))) unsigned char lds_raw[];
    float* lds = (float*)lds_raw;
    volatile __attribute__((address_space(3))) unsigned* misc = (volatile __attribute__((address_space(3))) unsigned*)((__attribute__((address_space(3))) unsigned char*)lds_raw + LDS_MISC);
    if (threadIdx.x < 16) misc[threadIdx.x] = 0u;
    __syncthreads();
    XcdBarrier xbar; xbar.bar = (unsigned*)p.ws + CW_BAR; xbar.x = xb_xcc_id(); xbar.st = misc;
    if (blockIdx.x == 0) { uint4* cw = (uint4*)p.ws; const uint4 z4 = {0u, 0u, 0u, 0u};
#pragma unroll 1
        for (int i = threadIdx.x; i < 4096; i += NTHR) cw[i] = z4; }
    run_phase<-1>(p, 0, lds);
    cg::this_grid().sync();
    if (threadIdx.x == 0) (void)xb_add(&xbar.bar[XB_XCNT(xbar.x)], 1u);
    layer_phases<0>(p, 0, lds, xbar); GSYNC();
    layer_phases<0>(p, 1, lds, xbar);
#if PROBE_A
    GSYNC(); { Ids id; id.tid = threadIdx.x; id.bid = blockIdx.x; ph_probe_scale(id, p); }
#endif
}
#else
template <int Q> __global__ void __launch_bounds__(NTHR, 2) k_phase(Params p) {
    extern __shared__ __attribute__((aligned(16))) unsigned char lds_raw[];
    run_phase<Q>(p, p.ph_lo, (float*)lds_raw);
}
template <int Q> static void launch_phase(Params p, int layer, int grid, hipStream_t stream) {
    static bool attr = false;
    if (!attr) { (void)hipFuncSetAttribute((const void*)k_phase<Q>, hipFuncAttributeMaxDynamicSharedMemorySize, LDS_BYTES); attr = true; }
    p.ph_lo = layer; p.ph_hi = 0;
    hipLaunchKernelGGL(k_phase<Q>, dim3(grid), dim3(NTHR), LDS_BYTES, stream, p);
}
template <int Q> static void launch_layer(const Params& p, int layer, int grid, hipStream_t stream) {
    launch_phase<Q>(p, layer, grid, stream);
    if constexpr (Q + 1 < PH_PER_LAYER) launch_layer<Q + 1>(p, layer, grid, stream);
}
#endif

extern "C" void kernel_launch(void* const* d_in, const int* in_sizes, int n_in, void* d_out, int out_size, void* d_ws, size_t ws_size, hipStream_t stream) {
    static int grid = 0;
    if (grid == 0) {
        if (n_in != 23 || out_size != NTOK * D || ws_size < WS_END) { fprintf(stderr, "kernel_launch: unexpected problem: n_in %d out %d ws %zu (need %zu)\n", n_in, out_size, ws_size, (size_t)WS_END); grid = -1; return; }
        int dev = 0, cus = 0;
        (void)hipGetDevice(&dev); (void)hipDeviceGetAttribute(&cus, hipDeviceAttributeMultiprocessorCount, dev);
#if MK_COOP
        int per_cu = 0;
        if (hipFuncSetAttribute((const void*)k_mega, hipFuncAttributeMaxDynamicSharedMemorySize, LDS_BYTES) != hipSuccess) { fprintf(stderr, "hipFuncSetAttribute failed\n"); grid = -1; return; }
        if (hipOccupancyMaxActiveBlocksPerMultiprocessor(&per_cu, (const void*)k_mega, NTHR, LDS_BYTES) != hipSuccess || per_cu < 1) { fprintf(stderr, "occupancy query: %d\n", per_cu); per_cu = 1; }
        (void)hipGetLastError();
        grid = cus * per_cu;
#else
        grid = cus;
#endif
        fprintf(stderr, "kernel_launch: grid %d (cus %d), ws %zu\n", grid, cus, ws_size);
    }
    if (grid < 0) return;
    Params p{};
    const float** pp = (const float**)&p;
    for (int i = 0; i < 23; ++i) pp[i] = (const float*)d_in[i];
    p.out = (float*)d_out; p.ws = (unsigned char*)d_ws;
#if MK_COOP
    void* args[] = {&p};
    hipError_t e = hipLaunchCooperativeKernel((const void*)k_mega, dim3(grid), dim3(NTHR), args, LDS_BYTES, stream);
    if (e != hipSuccess) fprintf(stderr, "cooperative launch failed: %s (grid %d)\n", hipGetErrorString(e), grid);
#else
    launch_phase<-1>(p, 0, grid, stream);
    launch_layer<0>(p, 0, grid, stream);
    launch_layer<0>(p, 1, grid, stream);
#endif
}
```

```cpp
#include <hip/hip_runtime.h>
#include <hip/hip_cooperative_groups.h>
#include <cstdio>
#include <cstdint>
namespace cg = cooperative_groups;

#ifndef MK_COOP
#define MK_COOP 1
#endif

typedef unsigned short bf16;

constexpr int D = 1024, BATCH = 16, SEQ = 2048, DEPTH = 2, NTOK = BATCH * SEQ;
constexpr int INC = 7124;
constexpr int ZC = 4096;
constexpr int Z_AQ = 0, Z_AK = 512, Z_AV = 576, Z_IQ = 640, Z_IK = 896, Z_BQ = 960, Z_BK = 1472, Z_BV = 1984,
              Z_CQ = 2496, Z_CK = 2752, Z_CV = 3008, Z_CR = 3520, Z_IW = 4032, Z_CA = 4036;
constexpr int NTHR = 512;
constexpr int LDS_BYTES = 147456;

constexpr size_t MiB = 1u << 20;
constexpr size_t WS_CTL = 0;
constexpr size_t WS_MOD = 1 * MiB;
constexpr size_t WS_WIN_T = 2 * MiB;
constexpr size_t WS_WG_T = 10 * MiB;
constexpr size_t WS_WOA_T = 16 * MiB, WS_WOB_T = 17 * MiB, WS_WOC_T = 18 * MiB;
constexpr size_t WS_WOUT_T = 19 * MiB;
constexpr size_t WS_WPQ_T = 21 * MiB;
constexpr size_t WS_SKB = 25 * MiB;
constexpr size_t WS_N = 28 * MiB;
constexpr size_t WS_YA = 92 * MiB, WS_YB = 124 * MiB, WS_YC = 156 * MiB;
constexpr size_t WS_Z = 188 * MiB;
constexpr size_t WS_G = WS_Z;
constexpr size_t WS_M = 380 * MiB;
constexpr size_t WS_PQ = WS_Z;
constexpr size_t WS_PE = WS_Z + 128 * MiB;
constexpr size_t WS_PG = WS_Z + 144 * MiB;
constexpr size_t WS_CRAW = 452 * MiB;
constexpr size_t WS_END = 516 * MiB;
constexpr size_t WS_QKG = WS_CTL + 131072;
constexpr size_t WS_HM = WS_YA;

struct Ids { int tid, bid; };
struct Params {
    const float *x, *c, *norm1_g, *norm2_g, *w_mod, *b_mod, *w_in, *b_gate, *a_qn_g, *a_kn_g, *b_qn_g, *b_kn_g,
                *c_w_alpha, *c_b_alpha, *c_on_g, *w_oa, *w_ob, *w_oc, *w_out, *peer_wq, *peer_subkeys, *peer_u, *peer_v;
    float* out; unsigned char* ws;
    int ph_lo, ph_hi;
};

__device__ __forceinline__ float bf2f(bf16 v) { return __uint_as_float(((unsigned)v) << 16); }
__device__ __forceinline__ bf16 f2bf(float f) { unsigned u = __float_as_uint(f); return (bf16)((u + 0x7fffu + ((u >> 16) & 1u)) >> 16); }
__device__ __forceinline__ unsigned cvt_pk(float lo, float hi) { typedef float f2 __attribute__((ext_vector_type(2))); typedef __bf16 b2 __attribute__((ext_vector_type(2))); f2 v = {lo, hi}; b2 b = __builtin_convertvector(v, b2); return __builtin_bit_cast(unsigned, b); }
__device__ __forceinline__ float wave_sum(float v) {
#pragma unroll
    for (int o = 1; o < 64; o <<= 1) v += __shfl_xor(v, o);
    return v;
}
__device__ __forceinline__ float wave_max(float v) {
#pragma unroll
    for (int o = 1; o < 64; o <<= 1) v = fmaxf(v, __shfl_xor(v, o));
    return v;
}
__device__ __forceinline__ float logsig(float x) { return fminf(x, 0.f) - log1pf(expf(-fabsf(x))); }
__device__ __forceinline__ void unpack8(uint4 u, float* f) {
    f[0] = __uint_as_float(u.x << 16); f[1] = __uint_as_float(u.x & 0xffff0000u);
    f[2] = __uint_as_float(u.y << 16); f[3] = __uint_as_float(u.y & 0xffff0000u);
    f[4] = __uint_as_float(u.z << 16); f[5] = __uint_as_float(u.z & 0xffff0000u);
    f[6] = __uint_as_float(u.w << 16); f[7] = __uint_as_float(u.w & 0xffff0000u);
}

__device__ __forceinline__ void ph_mod(const Ids& id, const Params& p, float* lds) {
    float* s_c = lds; float* s_red = lds + 16384;
    const int tid = id.tid;
    for (int i = tid; i < 16384; i += NTHR) { float v = p.c[i]; s_c[i] = v / (1.f + expf(-v)); }
    __syncthreads();
    float* mod = (float*)(p.ws + WS_MOD);
    const int j = tid & 63, ks = tid >> 6;
    for (int item = id.bid; item < 2 * 96; item += gridDim.x) {
        const int l = item / 96, jt = item % 96, col = jt * 64 + j;
        const float* w = p.w_mod + (size_t)l * 1024 * 6144 + col;
        float acc[16];
#pragma unroll
        for (int b = 0; b < 16; ++b) acc[b] = 0.f;
        for (int k0 = ks * 128; k0 < ks * 128 + 128; k0 += 32) {
            float wv[32];
#pragma unroll
            for (int u = 0; u < 32; ++u) wv[u] = w[(size_t)(k0 + u) * 6144];
#pragma unroll
            for (int u = 0; u < 32; ++u)
#pragma unroll
                for (int b = 0; b < 16; ++b) acc[b] += s_c[b * 1024 + k0 + u] * wv[u];
        }
#pragma unroll
        for (int b = 0; b < 16; ++b) s_red[(ks * 64 + j) * 16 + b] = acc[b];
        __syncthreads();
        for (int o = tid; o < 1024; o += NTHR) {
            const int jj = o & 63, b = o >> 6; float s = 0.f;
            for (int q = 0; q < 8; ++q) s += s_red[(q * 64 + jj) * 16 + b];
            const int c2 = jt * 64 + jj;
            mod[((size_t)l * 16 + b) * 6144 + c2] = s + p.b_mod[l * 6144 + c2];
        }
        __syncthreads();
    }
}

__device__ __forceinline__ void ph_norm(const Ids& id, const Params& p, int layer, int which) {
    const float* g = (which == 0 ? p.norm1_g : p.norm2_g) + layer * 1024;
    const float* mod = (const float*)(p.ws + WS_MOD) + (size_t)layer * 16 * 6144;
    bf16* N = (bf16*)(p.ws + WS_N);
    const int lane = id.tid & 63, wave = __builtin_amdgcn_readfirstlane(id.tid >> 6);
    if (which == 0 && layer == 0) {
    const float* hin = p.x;
    for (int tok = id.bid * 8 + wave; tok < NTOK; tok += gridDim.x * 8) {
        const int b = tok >> 11;
        const float* shift = mod + b * 6144 + (which ? 3 : 0) * 1024; const float* scale = shift + 1024;
        const float4* hr = (const float4*)(hin + (size_t)tok * 1024);
        float4 v[4]; float ss = 0.f;
#pragma unroll
        for (int j = 0; j < 4; ++j) { v[j] = hr[lane + 64 * j]; ss += v[j].x * v[j].x + v[j].y * v[j].y + v[j].z * v[j].z + v[j].w * v[j].w; }
        ss = wave_sum(ss);
        const float r = rsqrtf(ss * (1.f / 1024.f) + 1e-6f);
#pragma unroll
        for (int j = 0; j < 4; ++j) {
            const int c = (lane + 64 * j) * 4;
            const float4 gg = *(const float4*)(g + c), sc = *(const float4*)(scale + c), sh = *(const float4*)(shift + c);
            const float o0 = v[j].x * r * gg.x * (1.f + sc.x) + sh.x, o1 = v[j].y * r * gg.y * (1.f + sc.y) + sh.y;
            const float o2 = v[j].z * r * gg.z * (1.f + sc.z) + sh.z, o3 = v[j].w * r * gg.w * (1.f + sc.w) + sh.w;
            uint2 pk; pk.x = (unsigned)f2bf(o0) | ((unsigned)f2bf(o1) << 16); pk.y = (unsigned)f2bf(o2) | ((unsigned)f2bf(o3) << 16);
            *(uint2*)(N + (size_t)tok * 1024 + c) = pk;
        }
    }
    } else {
    const bf16* hin = which ? (const bf16*)(p.ws + WS_HM) : (const bf16*)p.out;
    for (int tok = id.bid * 8 + wave; tok < NTOK; tok += gridDim.x * 8) {
        const int b = tok >> 11;
        const float* shift = mod + b * 6144 + (which ? 3 : 0) * 1024; const float* scale = shift + 1024;
        const uint4* hr = (const uint4*)(hin + (size_t)tok * 1024);
        float v[2][8]; float ss = 0.f;
#pragma unroll
        for (int j = 0; j < 2; ++j) { unpack8(hr[lane + 64 * j], v[j]);
#pragma unroll
            for (int i = 0; i < 8; ++i) ss += v[j][i] * v[j][i]; }
        ss = wave_sum(ss);
        const float r = rsqrtf(ss * (1.f / 1024.f) + 1e-6f);
#pragma unroll
        for (int j = 0; j < 2; ++j) {
            const int c = (lane + 64 * j) * 8; float o[8];
#pragma unroll
            for (int q = 0; q < 2; ++q) { const float4 gg = *(const float4*)(g + c + 4 * q), sc = *(const float4*)(scale + c + 4 * q), sh = *(const float4*)(shift + c + 4 * q);
                o[4 * q] = v[j][4 * q] * r * gg.x * (1.f + sc.x) + sh.x; o[4 * q + 1] = v[j][4 * q + 1] * r * gg.y * (1.f + sc.y) + sh.y;
                o[4 * q + 2] = v[j][4 * q + 2] * r * gg.z * (1.f + sc.z) + sh.z; o[4 * q + 3] = v[j][4 * q + 3] * r * gg.w * (1.f + sc.w) + sh.w; }
            uint4 pk; pk.x = (unsigned)f2bf(o[0]) | ((unsigned)f2bf(o[1]) << 16); pk.y = (unsigned)f2bf(o[2]) | ((unsigned)f2bf(o[3]) << 16);
            pk.z = (unsigned)f2bf(o[4]) | ((unsigned)f2bf(o[5]) << 16); pk.w = (unsigned)f2bf(o[6]) | ((unsigned)f2bf(o[7]) << 16);
            *(uint4*)(N + (size_t)tok * 1024 + c) = pk;
        }
    }
    }
}

__device__ __forceinline__ int inproj_src_col(int n) { return n < 960 ? n : (n < 4032 ? n + 4 : (n < 4036 ? n - 4032 + 960 : n)); }
template <bool MAP, class Epi>
__device__ void gemm_naive(const Ids& id, const bf16* A, int lda, const float* W, int ldb, int N, int K, const Epi& epi, float* lds) {
    float* As = lds;
    float* Bs = lds + 16 * 132;
    const int tid = id.tid, tx = tid & 31, ty = tid >> 5;
    const int ntn = (N + 127) / 128, ntm = NTOK / 128;
    for (int tile = id.bid; tile < ntm * ntn; tile += gridDim.x) {
        const int tm = tile / ntn, tn = tile % ntn, m0 = tm * 128, n0 = tn * 128;
        float acc[8][4];
#pragma unroll
        for (int i = 0; i < 8; ++i)
#pragma unroll
            for (int j = 0; j < 4; ++j) acc[i][j] = 0.f;
        for (int k0 = 0; k0 < K; k0 += 16) {
            {
                const int row = tid >> 2, kq = (tid & 3) * 4;
                const uint2 raw = *(const uint2*)(A + (size_t)(m0 + row) * lda + k0 + kq);
                As[(kq + 0) * 132 + row] = __uint_as_float(raw.x << 16);
                As[(kq + 1) * 132 + row] = __uint_as_float(raw.x & 0xffff0000u);
                As[(kq + 2) * 132 + row] = __uint_as_float(raw.y << 16);
                As[(kq + 3) * 132 + row] = __uint_as_float(raw.y & 0xffff0000u);
            }
            {
                const int k = tid >> 5, nq = (tid & 31) * 4;
                float4 v = make_float4(0.f, 0.f, 0.f, 0.f);
                if (n0 + nq < N) v = *(const float4*)(W + (size_t)(k0 + k) * ldb + (MAP ? inproj_src_col(n0 + nq) : n0 + nq));
                *(float4*)(Bs + k * 128 + nq) = v;
            }
            __syncthreads();
#pragma unroll
            for (int kk = 0; kk < 16; ++kk) {
                const float4 a0 = *(const float4*)(As + kk * 132 + ty * 8), a1 = *(const float4*)(As + kk * 132 + ty * 8 + 4);
                const float4 bb = *(const float4*)(Bs + kk * 128 + tx * 4);
                const float a[8] = {a0.x, a0.y, a0.z, a0.w, a1.x, a1.y, a1.z, a1.w};
                const float b[4] = {bb.x, bb.y, bb.z, bb.w};
#pragma unroll
                for (int i = 0; i < 8; ++i)
#pragma unroll
                    for (int j = 0; j < 4; ++j) acc[i][j] += a[i] * b[j];
            }
            __syncthreads();
        }
        const int n = n0 + tx * 4;
        if (n < N) {
#pragma unroll
            for (int i = 0; i < 8; ++i) epi(m0 + ty * 8 + i, n, acc[i][0], acc[i][1], acc[i][2], acc[i][3]);
        }
    }
}

struct EpiBf { bf16* O; int ldo; int dcol0;
    __device__ __forceinline__ void operator()(int m, int n, float v0, float v1, float v2, float v3) const {
        uint2 pk; pk.x = (unsigned)f2bf(v0) | ((unsigned)f2bf(v1) << 16); pk.y = (unsigned)f2bf(v2) | ((unsigned)f2bf(v3) << 16);
        *(uint2*)(O + (size_t)m * ldo + dcol0 + n) = pk; } };
struct EpiF32 { float* T;
    __device__ __forceinline__ void operator()(int m, int n, float v0, float v1, float v2, float v3) const {
        *(float4*)(T + (size_t)m * 1024 + n) = make_float4(v0, v1, v2, v3); } };
__device__ __forceinline__ float sigm(float x) { return 1.f / (1.f + expf(-x)); }
struct EpiGate { const float* T; float* M; const float* bias; bf16* merged; int mode;
    __device__ __forceinline__ void operator()(int m, int n, float v0, float v1, float v2, float v3) const {
        const float4 t = *(const float4*)(T + (size_t)m * 1024 + n); const float4 bb = *(const float4*)(bias + n);
        float4 r = make_float4(sigm(v0 + bb.x) * t.x, sigm(v1 + bb.y) * t.y, sigm(v2 + bb.z) * t.z, sigm(v3 + bb.w) * t.w);
        if (mode >= 1) { const float4 o = *(const float4*)(M + (size_t)m * 1024 + n); r.x += o.x; r.y += o.y; r.z += o.z; r.w += o.w; }
        if (mode <= 1) *(float4*)(M + (size_t)m * 1024 + n) = r;
        else { uint2 pk; pk.x = (unsigned)f2bf(r.x) | ((unsigned)f2bf(r.y) << 16); pk.y = (unsigned)f2bf(r.z) | ((unsigned)f2bf(r.w) << 16);
               *(uint2*)(merged + (size_t)m * 1024 + n) = pk; } } };
struct EpiRes { const float* hin; float* out; const float* gate;
    __device__ __forceinline__ void operator()(int m, int n, float v0, float v1, float v2, float v3) const {
        const int b = m >> 11; const float4 g = *(const float4*)(gate + (size_t)b * 6144 + n); const float4 h = *(const float4*)(hin + (size_t)m * 1024 + n);
        *(float4*)(out + (size_t)m * 1024 + n) = make_float4(h.x + g.x * v0, h.y + g.y * v1, h.z + g.z * v2, h.w + g.w * v3); } };


struct EpiSigBfN { bf16* G; const float* bias;
    __device__ __forceinline__ void operator()(int m, int n, float v0, float v1, float v2, float v3) const {
        const float4 bb = *(const float4*)(bias + n);
        uint2 pk; pk.x = (unsigned)f2bf(sigm(v0 + bb.x)) | ((unsigned)f2bf(sigm(v1 + bb.y)) << 16); pk.y = (unsigned)f2bf(sigm(v2 + bb.z)) | ((unsigned)f2bf(sigm(v3 + bb.w)) << 16);
        *(uint2*)(G + (size_t)m * 3072 + n) = pk; } };
struct EpiProjN { const bf16* G; float* M; bf16* MG; int mode; const float* rawbias;
    __device__ __forceinline__ void operator()(int m, int n, float v0, float v1, float v2, float v3) const {
        const uint2 gw = *(const uint2*)(G + (size_t)m * 3072 + n);
        float g0 = __uint_as_float(gw.x << 16), g1 = __uint_as_float(gw.x & 0xffff0000u), g2 = __uint_as_float(gw.y << 16), g3 = __uint_as_float(gw.y & 0xffff0000u);
        if (rawbias) { g0 = sigm(g0 + rawbias[n]); g1 = sigm(g1 + rawbias[n + 1]); g2 = sigm(g2 + rawbias[n + 2]); g3 = sigm(g3 + rawbias[n + 3]); }
        float4 r = make_float4(v0 * g0, v1 * g1, v2 * g2, v3 * g3);
        if (mode >= 1) { const float4 o = *(const float4*)(M + (size_t)m * 1024 + n); r.x += o.x; r.y += o.y; r.z += o.z; r.w += o.w; }
        if (mode <= 1) *(float4*)(M + (size_t)m * 1024 + n) = r;
        else { uint2 pk; pk.x = (unsigned)f2bf(r.x) | ((unsigned)f2bf(r.y) << 16); pk.y = (unsigned)f2bf(r.z) | ((unsigned)f2bf(r.w) << 16);
               *(uint2*)(MG + (size_t)m * 1024 + n) = pk; } } };

__device__ __forceinline__ void ph_qknorm(const Ids& id, const Params& p, int layer) {
    bf16* Z = (bf16*)(p.ws + WS_Z);
    const int lane = id.tid & 63, wave = __builtin_amdgcn_readfirstlane(id.tid >> 6), sub = lane & 7;
    float gaq[8], gak[8], gbq[8], gbk[8];
#pragma unroll
    for (int i = 0; i < 8; ++i) { gaq[i] = p.a_qn_g[layer * 64 + sub * 8 + i]; gak[i] = p.a_kn_g[layer * 64 + sub * 8 + i]; gbq[i] = p.b_qn_g[layer * 64 + sub * 8 + i]; gbk[i] = p.b_kn_g[layer * 64 + sub * 8 + i]; }
    for (int tok = id.bid * 8 + wave; tok < NTOK; tok += gridDim.x * 8) {
        bf16* zr = Z + (size_t)tok * ZC;
        uint4* p0 = (uint4*)(zr + Z_AQ + lane * 8); uint4* p1 = (uint4*)(zr + Z_AK + sub * 8); uint4* p2 = (uint4*)(zr + Z_BQ + lane * 8); uint4* p3 = (uint4*)(zr + Z_BK + lane * 8);
        const uint4 r0 = *p0, r1 = *p1, r2 = *p2, r3 = *p3;
        float v0[8], v1[8], v2[8], v3[8]; unpack8(r0, v0); unpack8(r1, v1); unpack8(r2, v2); unpack8(r3, v3);
        float s0 = 0.f, s1 = 0.f, s2 = 0.f, s3 = 0.f;
#pragma unroll
        for (int i = 0; i < 8; ++i) { s0 += v0[i] * v0[i]; s1 += v1[i] * v1[i]; s2 += v2[i] * v2[i]; s3 += v3[i] * v3[i]; }
#pragma unroll
        for (int o = 1; o < 8; o <<= 1) { s0 += __shfl_xor(s0, o); s1 += __shfl_xor(s1, o); s2 += __shfl_xor(s2, o); s3 += __shfl_xor(s3, o); }
        const float n0 = rsqrtf(s0 * (1.f / 64.f) + 1e-6f), n1 = rsqrtf(s1 * (1.f / 64.f) + 1e-6f), n2 = rsqrtf(s2 * (1.f / 64.f) + 1e-6f), n3 = rsqrtf(s3 * (1.f / 64.f) + 1e-6f);
        uint4 o0, o1, o2, o3;
        o0.x = cvt_pk(v0[0] * n0 * gaq[0], v0[1] * n0 * gaq[1]); o0.y = cvt_pk(v0[2] * n0 * gaq[2], v0[3] * n0 * gaq[3]); o0.z = cvt_pk(v0[4] * n0 * gaq[4], v0[5] * n0 * gaq[5]); o0.w = cvt_pk(v0[6] * n0 * gaq[6], v0[7] * n0 * gaq[7]);
        o1.x = cvt_pk(v1[0] * n1 * gak[0], v1[1] * n1 * gak[1]); o1.y = cvt_pk(v1[2] * n1 * gak[2], v1[3] * n1 * gak[3]); o1.z = cvt_pk(v1[4] * n1 * gak[4], v1[5] * n1 * gak[5]); o1.w = cvt_pk(v1[6] * n1 * gak[6], v1[7] * n1 * gak[7]);
        o2.x = cvt_pk(v2[0] * n2 * gbq[0], v2[1] * n2 * gbq[1]); o2.y = cvt_pk(v2[2] * n2 * gbq[2], v2[3] * n2 * gbq[3]); o2.z = cvt_pk(v2[4] * n2 * gbq[4], v2[5] * n2 * gbq[5]); o2.w = cvt_pk(v2[6] * n2 * gbq[6], v2[7] * n2 * gbq[7]);
        o3.x = cvt_pk(v3[0] * n3 * gbk[0], v3[1] * n3 * gbk[1]); o3.y = cvt_pk(v3[2] * n3 * gbk[2], v3[3] * n3 * gbk[3]); o3.z = cvt_pk(v3[4] * n3 * gbk[4], v3[5] * n3 * gbk[5]); o3.w = cvt_pk(v3[6] * n3 * gbk[6], v3[7] * n3 * gbk[7]);
        *p0 = o0; if (lane < 8) *p1 = o1; *p2 = o2; *p3 = o3;
    }
}

__device__ __forceinline__ void ph_A(const Ids& id, const Params& p, float* lds) {
    const bf16* Z = (const bf16*)(p.ws + WS_Z); bf16* YA = (bf16*)(p.ws + WS_YA);
    float* s_iq = lds; float* s_iw = lds + 256; float* s_q = lds + 264; float* s_sc = lds + 776; int* s_sel = (int*)(lds + 2824); float* s_lg = lds + 3080;
    const int tid = id.tid, lane = tid & 63, wave = tid >> 6;
    for (int tok = id.bid; tok < NTOK; tok += gridDim.x) {
        const int b = tok >> 11, t = tok & 2047, limit = ((t >> 6) + 1) << 6;
        const bf16* zr = Z + (size_t)tok * ZC; const bf16* zb = Z + (size_t)b * SEQ * ZC;
        if (tid < 256) s_iq[tid] = bf2f(zr[Z_IQ + tid]);
        if (tid < 4) s_iw[tid] = bf2f(zr[Z_IW + tid]);
        s_q[tid] = bf2f(zr[Z_AQ + tid]);
        __syncthreads();
        for (int s = tid; s < limit; s += NTHR) {
            const uint4* kr = (const uint4*)(zb + (size_t)s * ZC + Z_IK);
            float d0 = 0.f, d1 = 0.f, d2 = 0.f, d3 = 0.f;
#pragma unroll 1
            for (int c = 0; c < 8; ++c) { float kv[8]; unpack8(kr[c], kv);
#pragma unroll
                for (int e = 0; e < 8; ++e) { const int d = c * 8 + e; d0 += s_iq[d] * kv[e]; d1 += s_iq[64 + d] * kv[e]; d2 += s_iq[128 + d] * kv[e]; d3 += s_iq[192 + d] * kv[e]; } }
            s_sc[s] = s_iw[0] * fmaxf(d0, 0.f) + s_iw[1] * fmaxf(d1, 0.f) + s_iw[2] * fmaxf(d2, 0.f) + s_iw[3] * fmaxf(d3, 0.f);
        }
        __syncthreads();
        int nk;
        if (limit <= 256) { nk = limit; if (tid < limit) s_sel[tid] = tid; }
        else { nk = 256;
            for (int s = tid; s < limit; s += NTHR) { const float v = s_sc[s]; int rank = 0;
                for (int j = 0; j < limit; ++j) { const float u = s_sc[j]; rank += (u > v || (u == v && j < s)) ? 1 : 0; }
                if (rank < 256) s_sel[rank] = s; } }
        __syncthreads();
        for (int idx = tid; idx < 2048; idx += NTHR) { const int h = idx >> 8, j = idx & 255;
            if (j < nk) { const uint4* kr = (const uint4*)(zb + (size_t)s_sel[j] * ZC + Z_AK); float dot = 0.f;
#pragma unroll 1
                for (int c = 0; c < 8; ++c) { float kv[8]; unpack8(kr[c], kv);
#pragma unroll
                    for (int e = 0; e < 8; ++e) dot += s_q[h * 64 + c * 8 + e] * kv[e]; }
                s_lg[idx] = dot * 0.125f; } }
        __syncthreads();
        { float* lg = s_lg + wave * 256; float m = -INFINITY;
          for (int j = lane; j < nk; j += 64) m = fmaxf(m, lg[j]);
          m = wave_max(m); float sum = 0.f;
          for (int j = lane; j < nk; j += 64) { const float e = expf(lg[j] - m); lg[j] = e; sum += e; }
          sum = wave_sum(sum); const float inv = 1.f / sum;
          for (int j = lane; j < nk; j += 64) lg[j] *= inv; }
        __syncthreads();
        { const int h = tid >> 6, d = tid & 63; float acc = 0.f;
          for (int j = 0; j < nk; ++j) acc += s_lg[h * 256 + j] * bf2f(zb[(size_t)s_sel[j] * ZC + Z_AV + d]);
          YA[(size_t)tok * 512 + tid] = f2bf(acc); }
        __syncthreads();
    }
}

__device__ __forceinline__ void ph_B(const Ids& id, const Params& p, float* lds) {
    const bf16* Z = (const bf16*)(p.ws + WS_Z); bf16* YB = (bf16*)(p.ws + WS_YB);
    const int tid = id.tid, lane = tid & 63, wave = tid >> 6;
    float* s_q = lds + wave * 64;
    for (int tok = id.bid; tok < NTOK; tok += gridDim.x) {
        const int b = tok >> 11, t = tok & 2047;
        const bf16* zr = Z + (size_t)tok * ZC; const bf16* zb = Z + (size_t)b * SEQ * ZC;
        s_q[lane] = bf2f(zr[Z_BQ + wave * 64 + lane]);
        __syncthreads();
        float acc = 0.f, carry = 0.f;
        for (int shi = t - 1; shi >= 0; shi -= 64) {
            const int s = shi - lane; const bool valid = s >= 0; const int sc = valid ? s : 0;
            const uint4* kr = (const uint4*)(zb + (size_t)sc * ZC + Z_BK + wave * 64);
            float dot = 0.f;
#pragma unroll
            for (int c = 0; c < 8; ++c) { float kv[8]; unpack8(kr[c], kv);
#pragma unroll
                for (int e = 0; e < 8; ++e) dot += s_q[c * 8 + e] * kv[e]; }
            const float zz = dot * 0.125f;
            const float lk = valid ? logsig(-zz) : 0.f, lb = logsig(zz);
            float incl = lk;
#pragma unroll
            for (int off = 1; off < 64; off <<= 1) { const float y = __shfl_up(incl, off); if (lane >= off) incl += y; }
            const float later = carry + incl - lk;
            const float a = valid ? expf(lb + later) : 0.f;
            carry += __shfl(incl, 63);
            const int cnt = (shi + 1 < 64) ? shi + 1 : 64;
            for (int l2 = 0; l2 < cnt; ++l2) { const float al = __shfl(a, l2); acc += al * bf2f(zb[(size_t)(shi - l2) * ZC + Z_BV + wave * 64 + lane]); }
        }
        YB[(size_t)tok * 512 + wave * 64 + lane] = f2bf(acc);
        __syncthreads();
    }
}


typedef short s16x8 __attribute__((ext_vector_type(8)));
typedef short s16x4 __attribute__((ext_vector_type(4)));
typedef float f32x16 __attribute__((ext_vector_type(16)));
typedef __attribute__((address_space(3))) unsigned char lds_u8;
constexpr float SB_EXIT = 30.0f;
__device__ __forceinline__ s16x8 ldsv8(const lds_u8* p) { return *(const __attribute__((address_space(3))) s16x8*)p; }
__device__ __forceinline__ s16x4 lds_tr_read(const lds_u8* p) { return __builtin_bit_cast(s16x4, __builtin_amdgcn_ds_read_tr16_b64_v4i16((__attribute__((address_space(3))) s16x4*)p)); }
__device__ __forceinline__ void ph_B_mfma(const Ids& id, const Params& p, float* lds) {
    const bf16* Z = (const bf16*)(p.ws + WS_Z); bf16* YB = (bf16*)(p.ws + WS_YB);
    const int lane = id.tid & 63, wave = __builtin_amdgcn_readfirstlane(id.tid >> 6), r = lane & 31, hf = lane >> 5;
    lds_u8* vl = (lds_u8*)lds + wave * 4096;
    const int i16 = lane & 15;
    const lds_u8* vrd = vl + (4 * hf + (i16 >> 2)) * 128 + ((lane >> 4) & 1) * 32 + (i16 & 3) * 8;
    for (int item = id.bid; item < 1024; item += gridDim.x) {
        const int b = item >> 6, h = (item >> 3) & 7, qt = (item & 7) * 8 + wave, t0 = qt * 32;
        const bf16* zb = Z + (size_t)b * SEQ * ZC;
        s16x8 qf[4];
#pragma unroll
        for (int kk = 0; kk < 4; ++kk) qf[kk] = *(const s16x8*)(zb + (size_t)(t0 + r) * ZC + Z_BQ + h * 64 + kk * 16 + hf * 8);
        f32x16 o0, o1;
#pragma unroll
        for (int i = 0; i < 16; ++i) { o0[i] = 0.f; o1[i] = 0.f; }
        float carry = 0.f;
        for (int s0 = t0; s0 >= 0; s0 -= 32) {
            s16x8 kf[4];
#pragma unroll
            for (int kk = 0; kk < 4; ++kk) kf[kk] = *(const s16x8*)(zb + (size_t)(s0 + r) * ZC + Z_BK + h * 64 + kk * 16 + hf * 8);
#pragma unroll
            for (int i = 0; i < 4; ++i) { const int row = (lane >> 3) + 8 * i;
                typedef unsigned u4v __attribute__((ext_vector_type(4)));
                const u4v v = *(const u4v*)(zb + (size_t)(s0 + row) * ZC + Z_BV + h * 64 + (lane & 7) * 8);
                *(__attribute__((address_space(3))) u4v*)(vl + row * 128 + (lane & 7) * 16) = v; }
            f32x16 sacc;
#pragma unroll
            for (int i = 0; i < 16; ++i) sacc[i] = 0.f;
#pragma unroll
            for (int kk = 0; kk < 4; ++kk) sacc = __builtin_amdgcn_mfma_f32_32x32x16_bf16(kf[kk], qf[kk], sacc, 0, 0, 0);
            float lk[16], lb[16];
            const int tq = t0 + r;
#pragma unroll
            for (int i = 0; i < 16; ++i) { const float zz = sacc[i] * 0.125f; const int key = s0 + (i & 3) + 8 * (i >> 2) + 4 * hf;
                const float l = fminf(zz, 0.f) - __logf(1.f + __expf(-fabsf(zz)));
                lb[i] = l; lk[i] = (key < tq) ? l - zz : 0.f; }
            float gs[4], go[4], base[4];
#pragma unroll
            for (int g = 0; g < 4; ++g) { gs[g] = (lk[4 * g] + lk[4 * g + 1]) + (lk[4 * g + 2] + lk[4 * g + 3]); go[g] = __shfl_xor(gs[g], 32); }
            float run = carry;
#pragma unroll
            for (int g = 3; g >= 0; --g) { base[g] = hf ? run : run + go[g]; run += gs[g] + go[g]; }
            carry = run;
            float a[16];
#pragma unroll
            for (int g = 0; g < 4; ++g) {
                const float l3 = base[g], l2 = l3 + lk[4 * g + 3], l1 = l2 + lk[4 * g + 2], l0 = l1 + lk[4 * g + 1];
                const int key0 = s0 + 8 * g + 4 * hf;
                a[4 * g + 0] = (key0 + 0 < tq) ? __expf(lb[4 * g + 0] + l0) : 0.f;
                a[4 * g + 1] = (key0 + 1 < tq) ? __expf(lb[4 * g + 1] + l1) : 0.f;
                a[4 * g + 2] = (key0 + 2 < tq) ? __expf(lb[4 * g + 2] + l2) : 0.f;
                a[4 * g + 3] = (key0 + 3 < tq) ? __expf(lb[4 * g + 3] + l3) : 0.f;
            }
            uint4 pw0, pw1;
            pw0.x = cvt_pk(a[0], a[1]); pw0.y = cvt_pk(a[2], a[3]); pw0.z = cvt_pk(a[4], a[5]); pw0.w = cvt_pk(a[6], a[7]);
            pw1.x = cvt_pk(a[8], a[9]); pw1.y = cvt_pk(a[10], a[11]); pw1.z = cvt_pk(a[12], a[13]); pw1.w = cvt_pk(a[14], a[15]);
            const s16x8 pf0 = __builtin_bit_cast(s16x8, pw0), pf1 = __builtin_bit_cast(s16x8, pw1);
            {
                const s16x4 a00l = lds_tr_read(vrd), a00h = lds_tr_read(vrd + 1024), a01l = lds_tr_read(vrd + 2048), a01h = lds_tr_read(vrd + 2048 + 1024);
                const s16x4 a10l = lds_tr_read(vrd + 64), a10h = lds_tr_read(vrd + 64 + 1024), a11l = lds_tr_read(vrd + 64 + 2048), a11h = lds_tr_read(vrd + 64 + 2048 + 1024);
                o0 = __builtin_amdgcn_mfma_f32_32x32x16_bf16(__builtin_shufflevector(a00l, a00h, 0, 1, 2, 3, 4, 5, 6, 7), pf0, o0, 0, 0, 0);
                o0 = __builtin_amdgcn_mfma_f32_32x32x16_bf16(__builtin_shufflevector(a01l, a01h, 0, 1, 2, 3, 4, 5, 6, 7), pf1, o0, 0, 0, 0);
                o1 = __builtin_amdgcn_mfma_f32_32x32x16_bf16(__builtin_shufflevector(a10l, a10h, 0, 1, 2, 3, 4, 5, 6, 7), pf0, o1, 0, 0, 0);
                o1 = __builtin_amdgcn_mfma_f32_32x32x16_bf16(__builtin_shufflevector(a11l, a11h, 0, 1, 2, 3, 4, 5, 6, 7), pf1, o1, 0, 0, 0);
            }
            if (__all(carry < -SB_EXIT)) break;
        }
        bf16* orow = YB + (size_t)(b * SEQ + t0 + r) * 512 + h * 64 + 4 * hf;
#pragma unroll
        for (int g = 0; g < 4; ++g) {
            uint2 w0, w1; w0.x = cvt_pk(o0[4 * g], o0[4 * g + 1]); w0.y = cvt_pk(o0[4 * g + 2], o0[4 * g + 3]);
            w1.x = cvt_pk(o1[4 * g], o1[4 * g + 1]); w1.y = cvt_pk(o1[4 * g + 2], o1[4 * g + 3]);
            *(uint2*)(orow + 8 * g) = w0; *(uint2*)(orow + 32 + 8 * g) = w1;
        }
    }
    __syncthreads();
}


__device__ __forceinline__ int wave_sum_i32(int v) {
    v += __builtin_amdgcn_update_dpp(0, v, 0x128, 0xf, 0xf, true);
    v += __builtin_amdgcn_update_dpp(0, v, 0x124, 0xf, 0xf, true);
    v += __builtin_amdgcn_update_dpp(0, v, 0x122, 0xf, 0xf, true);
    v += __builtin_amdgcn_update_dpp(0, v, 0x121, 0xf, 0xf, true);
    return __builtin_amdgcn_readlane(v, 0) + __builtin_amdgcn_readlane(v, 16) + __builtin_amdgcn_readlane(v, 32) + __builtin_amdgcn_readlane(v, 48);
}
#ifndef REP_SEL
#define REP_SEL 1
#endif
#ifndef REP_ATT
#define REP_ATT 1
#endif
constexpr int SC_STRIDE = 2052;

template <int NJ>
__device__ __forceinline__ void select_emit(const unsigned (&u)[NJ], unsigned T, int lane, unsigned* mrow) {
    int cg = 0, ce = 0;
#pragma unroll
    for (int j = 0; j < NJ; ++j) { cg += (u[j] > T) ? 1 : 0; ce += (u[j] == T) ? 1 : 0; }
    const int cpk = wave_sum_i32(cg | (ce << 16)); const int cgt = cpk & 0xffff, ceq = cpk >> 16, need = 256 - cgt;
    if (ceq == need) {
#pragma unroll 4
        for (int j = 0; j < NJ; ++j) { const unsigned long long bal = __builtin_amdgcn_ballot_w64(u[j] >= T); if (lane == 0) { mrow[2 * j] = (unsigned)bal; mrow[2 * j + 1] = (unsigned)(bal >> 32); } }
    } else {
        int running = 0;
#pragma unroll 4
        for (int j = 0; j < NJ; ++j) { const unsigned long long eqm = __builtin_amdgcn_ballot_w64(u[j] == T);
            const int pre = running + (int)__builtin_amdgcn_mbcnt_hi((unsigned)(eqm >> 32), __builtin_amdgcn_mbcnt_lo((unsigned)eqm, 0u));
            const unsigned long long bal = __builtin_amdgcn_ballot_w64(u[j] > T || (u[j] == T && pre < need));
            if (lane == 0) { mrow[2 * j] = (unsigned)bal; mrow[2 * j + 1] = (unsigned)(bal >> 32); }
            running += __builtin_popcountll(eqm); }
    }
    if (lane < 32 - NJ) { mrow[2 * (NJ + lane)] = 0u; mrow[2 * (NJ + lane) + 1] = 0u; }
}
template <int NJ>
__device__ __forceinline__ void select2(const float* scq, int nj, int lane, unsigned* mrow0) {
    unsigned u0[NJ], u1[NJ];
#pragma unroll
    for (int j = 0; j < NJ; ++j) { unsigned k0 = 0u, k1 = 0u;
        if (j < nj) { const float x0 = scq[j * 64 + lane] + 0.0f, x1 = scq[SC_STRIDE + j * 64 + lane] + 0.0f; const unsigned b0 = __float_as_uint(x0), b1 = __float_as_uint(x1);
            k0 = (b0 & 0x80000000u) ? ~b0 : (b0 | 0x80000000u); k1 = (b1 & 0x80000000u) ? ~b1 : (b1 | 0x80000000u); }
        u0[j] = k0; u1[j] = k1; }
    unsigned T0 = 0u, T1 = 0u;
    for (int bit = 31; bit >= 0; --bit) {
        const unsigned Tc0 = T0 | (1u << bit), Tc1 = T1 | (1u << bit); int c0 = 0, c1 = 0;
#pragma unroll
        for (int j = 0; j < NJ; ++j) { c0 += (u0[j] >= Tc0) ? 1 : 0; c1 += (u1[j] >= Tc1) ? 1 : 0; }
        const int sp = wave_sum_i32(c0 | (c1 << 16));
        const int s0 = sp & 0xffff, s1 = sp >> 16;
        if (s0 >= 256) T0 = Tc0;
        if (s1 >= 256) T1 = Tc1;
    }
    select_emit<NJ>(u0, T0, lane, mrow0); select_emit<NJ>(u1, T1, lane, mrow0 + 64);
}
typedef float f32x4v __attribute__((ext_vector_type(4)));

__device__ __forceinline__ void ph_A_mfma(const Ids& id, const Params& p, int layer, float* lds, size_t ya_off = WS_YA, int bmax = 16) {
    const bf16* Z = (const bf16*)(p.ws + WS_Z); bf16* YA = (bf16*)(p.ws + ya_off);
    const int lane = id.tid & 63, wave = __builtin_amdgcn_readfirstlane(id.tid >> 6), r = lane & 31, hf = lane >> 5;
    float* sc = lds;
    unsigned* msk = (unsigned*)(lds + 16 * SC_STRIDE);
    lds_u8* vl = (lds_u8*)lds + wave * 4096;
    const int i16 = lane & 15;
    const lds_u8* vrd = vl + (4 * hf + (i16 >> 2)) * 128 + ((lane >> 4) & 1) * 32 + (i16 & 3) * 8;
    float Mref2; bool fixref;
    { const float gq = wave_max(fabsf(p.a_qn_g[layer * 64 + lane])), gk = wave_max(fabsf(p.a_kn_g[layer * 64 + lane]));
      Mref2 = 8.f * gq * gk * 1.001f * 1.4426950408889634f + 0.01f; fixref = Mref2 < 40.f; }
    for (int it = id.bid; it < 1024; it += gridDim.x) {
        const int c = it & 255, k4 = it >> 8, qp = c & 63, qt = (k4 & 1) ? 63 - qp : qp, b = (c >> 6) + 4 * k4;
        const int t0 = qt * 32, limit = ((t0 >> 6) + 1) << 6, nj = limit >> 6;
        const bf16* zb = Z + (size_t)b * SEQ * ZC;
        for (int half = 0; half < 2; ++half) {
            const int tq0 = t0 + 16 * half, qc = lane & 15, kg = lane >> 4;
            {
                s16x8 bq[4][2]; float w[4];
#pragma unroll
                for (int h = 0; h < 4; ++h) {
#pragma unroll
                    for (int kk = 0; kk < 2; ++kk) bq[h][kk] = *(const s16x8*)(zb + (size_t)(tq0 + qc) * ZC + Z_IQ + h * 64 + kk * 32 + kg * 8);
                    w[h] = bf2f(zb[(size_t)(tq0 + qc) * ZC + Z_IW + h]); }
                for (int kt0 = wave; kt0 * 16 < limit; kt0 += 32) {
                    s16x8 ak[4][2]; int key0[4]; bool ok[4];
#pragma unroll
                    for (int jt = 0; jt < 4; ++jt) { const int kt = kt0 + 8 * jt; ok[jt] = kt * 16 < limit; key0[jt] = (ok[jt] ? kt : kt0) * 16;
                        ak[jt][0] = *(const s16x8*)(zb + (size_t)(key0[jt] + qc) * ZC + Z_IK + kg * 8); ak[jt][1] = *(const s16x8*)(zb + (size_t)(key0[jt] + qc) * ZC + Z_IK + 32 + kg * 8); }
#pragma unroll
                    for (int jt = 0; jt < 4; ++jt) {
                        f32x4v score = {0.f, 0.f, 0.f, 0.f};
#pragma unroll
                        for (int h = 0; h < 4; ++h) { f32x4v d = {0.f, 0.f, 0.f, 0.f};
                            d = __builtin_amdgcn_mfma_f32_16x16x32_bf16(ak[jt][0], bq[h][0], d, 0, 0, 0); d = __builtin_amdgcn_mfma_f32_16x16x32_bf16(ak[jt][1], bq[h][1], d, 0, 0, 0);
#pragma unroll
                            for (int e = 0; e < 4; ++e) score[e] += w[h] * fmaxf(d[e], 0.f); }
                        if (ok[jt]) *(f32x4v*)(sc + qc * SC_STRIDE + key0[jt] + 4 * kg) = score;
                    }
                }
            }
            __syncthreads();
            for (int rsel = 0; rsel < REP_SEL; ++rsel) {
                asm volatile("" : "+s"(rsel));
                unsigned* mrow0 = msk + (16 * half + wave * 2) * 64;
                if (nj <= 4) {
                    if (lane < 32) { const unsigned v = (lane < nj) ? 0xffffffffu : 0u; mrow0[2 * lane] = v; mrow0[2 * lane + 1] = v; mrow0[64 + 2 * lane] = v; mrow0[64 + 2 * lane + 1] = v; }
                } else if (nj <= 8) select2<8>(sc + (wave * 2) * SC_STRIDE, nj, lane, mrow0);
                else if (nj <= 16) select2<16>(sc + (wave * 2) * SC_STRIDE, nj, lane, mrow0);
                else if (nj <= 24) select2<24>(sc + (wave * 2) * SC_STRIDE, nj, lane, mrow0);
                else select2<32>(sc + (wave * 2) * SC_STRIDE, nj, lane, mrow0);
            }
            __syncthreads();
        }
        for (int ratt = 0; ratt < REP_ATT; ++ratt) {
            asm volatile("" : "+s"(ratt));
            const int h = wave;
            s16x8 qf[4];
#pragma unroll
            for (int kk = 0; kk < 4; ++kk) qf[kk] = *(const s16x8*)(zb + (size_t)(t0 + r) * ZC + Z_AQ + h * 64 + kk * 16 + hf * 8);
            f32x16 o0, o1;
#pragma unroll
            for (int i = 0; i < 16; ++i) { o0[i] = 0.f; o1[i] = 0.f; }
            float m = -1e30f, l = 0.f;
            typedef unsigned u4v __attribute__((ext_vector_type(4)));
            const int tid_ = id.tid;
            u4v stg[8];
#define ATT_LOAD(c0) do { _Pragma("unroll") for (int i_ = 0; i_ < 4; ++i_) { const int pc = tid_ + 512 * i_, row = pc >> 3, col = pc & 7; const int key = (c0) + row; \
        const size_t go = (size_t)(key < limit ? key : 0) * ZC + col * 8; stg[i_] = *(const u4v*)(zb + go + Z_AK); stg[4 + i_] = *(const u4v*)(zb + go + Z_AV); } } while (0)
#define ATT_STORE(bufo) do { _Pragma("unroll") for (int i_ = 0; i_ < 4; ++i_) { const int pc = tid_ + 512 * i_, row = pc >> 3, col = pc & 7; \
        *(__attribute__((address_space(3))) u4v*)((lds_u8*)lds + (bufo) + row * 128 + ((col ^ (row & 7)) << 4)) = stg[i_]; \
        *(__attribute__((address_space(3))) u4v*)((lds_u8*)lds + (bufo) + 32768 + row * 128 + (col << 4)) = stg[4 + i_]; } } while (0)
            ATT_LOAD(0); ATT_STORE(0);
            __syncthreads();
            for (int c0 = 0; c0 < limit; c0 += 256) {
                const int bufo = ((c0 >> 8) & 1) * 65536;
                if (c0 + 256 < limit) ATT_LOAD(c0 + 256);
                const int ntile = (limit - c0 < 256) ? ((limit - c0) >> 5) : 8;
                for (int tl = 0; tl < ntile; ++tl) {
                    const int s0 = c0 + tl * 32;
                    const unsigned mw = msk[r * 64 + (s0 >> 5)];
                    if (!__any(mw != 0u)) continue;
                    const lds_u8* kb = (const lds_u8*)lds + bufo + (tl * 32 + r) * 128;
                    f32x16 sacc;
#pragma unroll
                    for (int i = 0; i < 16; ++i) sacc[i] = 0.f;
#pragma unroll
                    for (int kk = 0; kk < 4; ++kk) sacc = __builtin_amdgcn_mfma_f32_32x32x16_bf16(ldsv8(kb + (((kk * 2 + hf) ^ (r & 7)) << 4)), qf[kk], sacc, 0, 0, 0);
                    float a[16]; const unsigned mwh = mw >> (4 * hf);
                    if (fixref) {
                        float ps = 0.f;
#pragma unroll
                        for (int i = 0; i < 16; ++i) { const bool on = (mwh >> ((i & 3) + 8 * (i >> 2))) & 1u;
                            a[i] = on ? __builtin_amdgcn_exp2f(sacc[i] * (0.125f * 1.4426950408889634f) - Mref2) : 0.f; ps += a[i]; }
                        l += ps;
                    } else {
                        float sv[16]; float mx = -1e30f;
#pragma unroll
                        for (int i = 0; i < 16; ++i) { const bool on = (mwh >> ((i & 3) + 8 * (i >> 2))) & 1u;
                            sv[i] = on ? sacc[i] * (0.125f * 1.4426950408889634f) : -1e30f; mx = fmaxf(mx, sv[i]); }
                        mx = fmaxf(mx, __shfl_xor(mx, 32));
                        const float mn = fmaxf(m, mx), alpha = __builtin_amdgcn_exp2f(m - mn);
                        m = mn;
                        float ps = 0.f;
#pragma unroll
                        for (int i = 0; i < 16; ++i) { a[i] = __builtin_amdgcn_exp2f(sv[i] - mn); ps += a[i]; }
                        l = l * alpha + ps;
#pragma unroll
                        for (int i = 0; i < 16; ++i) { o0[i] *= alpha; o1[i] *= alpha; }
                    }
                    uint4 pw0, pw1;
                    pw0.x = cvt_pk(a[0], a[1]); pw0.y = cvt_pk(a[2], a[3]); pw0.z = cvt_pk(a[4], a[5]); pw0.w = cvt_pk(a[6], a[7]);
                    pw1.x = cvt_pk(a[8], a[9]); pw1.y = cvt_pk(a[10], a[11]); pw1.z = cvt_pk(a[12], a[13]); pw1.w = cvt_pk(a[14], a[15]);
                    const s16x8 pf0 = __builtin_bit_cast(s16x8, pw0), pf1 = __builtin_bit_cast(s16x8, pw1);
                    const lds_u8* vr2 = (const lds_u8*)lds + bufo + 32768 + tl * 4096 + (4 * hf + (i16 >> 2)) * 128 + ((lane >> 4) & 1) * 32 + (i16 & 3) * 8;
                    const s16x4 a00l = lds_tr_read(vr2), a00h = lds_tr_read(vr2 + 1024), a01l = lds_tr_read(vr2 + 2048), a01h = lds_tr_read(vr2 + 2048 + 1024);
                    const s16x4 a10l = lds_tr_read(vr2 + 64), a10h = lds_tr_read(vr2 + 64 + 1024), a11l = lds_tr_read(vr2 + 64 + 2048), a11h = lds_tr_read(vr2 + 64 + 2048 + 1024);
                    o0 = __builtin_amdgcn_mfma_f32_32x32x16_bf16(__builtin_shufflevector(a00l, a00h, 0, 1, 2, 3, 4, 5, 6, 7), pf0, o0, 0, 0, 0);
                    o0 = __builtin_amdgcn_mfma_f32_32x32x16_bf16(__builtin_shufflevector(a01l, a01h, 0, 1, 2, 3, 4, 5, 6, 7), pf1, o0, 0, 0, 0);
                    o1 = __builtin_amdgcn_mfma_f32_32x32x16_bf16(__builtin_shufflevector(a10l, a10h, 0, 1, 2, 3, 4, 5, 6, 7), pf0, o1, 0, 0, 0);
                    o1 = __builtin_amdgcn_mfma_f32_32x32x16_bf16(__builtin_shufflevector(a11l, a11h, 0, 1, 2, 3, 4, 5, 6, 7), pf1, o1, 0, 0, 0);
                }
                if (c0 + 256 < limit) ATT_STORE(65536 - bufo);
                __syncthreads();
            }
#undef ATT_LOAD
#undef ATT_STORE
            l += __shfl_xor(l, 32);
            const float inv = 1.f / l;
            bf16* orow = YA + (size_t)(b * SEQ + t0 + r) * 512 + h * 64 + 4 * hf;
            if (b < bmax)
#pragma unroll
            for (int g = 0; g < 4; ++g) {
                uint2 w0, w1; w0.x = cvt_pk(o0[4 * g] * inv, o0[4 * g + 1] * inv); w0.y = cvt_pk(o0[4 * g + 2] * inv, o0[4 * g + 3] * inv);
                w1.x = cvt_pk(o1[4 * g] * inv, o1[4 * g + 1] * inv); w1.y = cvt_pk(o1[4 * g + 2] * inv, o1[4 * g + 3] * inv);
                *(uint2*)(orow + 8 * g) = w0; *(uint2*)(orow + 32 + 8 * g) = w1;
            }
        }
        __syncthreads();
    }
}


constexpr int C_QT = 0, C_KT = 9216, C_QH = 18432, C_KH = 27648, C_VV = 36864, C_SS = 54272, C_F32 = 71680;
__device__ __forceinline__ void ph_C_mfma(const Ids& id, const Params& p, int layer, float* lds) {
    const bf16* Z = (const bf16*)(p.ws + WS_Z); bf16* YC = (bf16*)(p.ws + WS_YC);
    const int tid = id.tid, lane = tid & 63, wave = tid >> 6, r = lane & 31, hf = lane >> 5, i16 = lane & 15;
    lds_u8* L = (lds_u8*)lds;
    typedef __attribute__((address_space(3))) unsigned short lds_u16; typedef __attribute__((address_space(3))) float lds_f32;
    lds_f32* F = (lds_f32*)(L + C_F32);
    const float* walp = p.c_w_alpha + layer * 16 * 256; const float* balp = p.c_b_alpha + layer * 256; const float* gainp = p.c_on_g + layer * 512;
    const int kt = wave & 1, vt2 = wave >> 1;
    const int tt = wave & 1, vt = wave >> 1;
    const int trrow = 8 * hf + (i16 >> 2), trcol = ((lane >> 4) & 1) * 16 + (i16 & 3) * 4;
    const int prow = 4 * hf + (i16 >> 2);
    for (int item = id.bid; item < 64; item += gridDim.x) {
        const int b = item >> 2, h = item & 3; const bf16* zb = Z + (size_t)b * SEQ * ZC;
        __syncthreads();
        for (int i = tid; i < 1024; i += NTHR) F[960 + i] = walp[(i >> 6) * 256 + h * 64 + (i & 63)];
        if (tid < 64) F[1984 + tid] = balp[h * 64 + tid];
        if (tid < 128) F[2048 + tid] = gainp[h * 128 + tid];
        for (int i = tid; i < 64 * 136 / 2; i += NTHR) ((__attribute__((address_space(3))) unsigned*)(L + C_SS))[i] = 0u;
        f32x16 S;
#pragma unroll
        for (int i = 0; i < 16; ++i) S[i] = 0.f;
        __syncthreads();
        for (int c = 0; c < 32; ++c) {
            const int t0c = c * 64; const int k = lane;
            float bb[8], qv[8], kv[8];
            {
                float run = 0.f;
#pragma unroll
                for (int i = 0; i < 8; ++i) { const bf16* zr = zb + (size_t)(t0c + 8 * wave + i) * ZC;
                    float a[16];
                    { const uint2 a0 = *(const uint2*)(zr + Z_CA), a1 = *(const uint2*)(zr + Z_CA + 4), a2 = *(const uint2*)(zr + Z_CA + 8), a3 = *(const uint2*)(zr + Z_CA + 12);
                      uint4 lo4, hi4; lo4.x = a0.x; lo4.y = a0.y; lo4.z = a1.x; lo4.w = a1.y; hi4.x = a2.x; hi4.y = a2.y; hi4.z = a3.x; hi4.w = a3.y; unpack8(lo4, a); unpack8(hi4, a + 8); }
                    float x = F[1984 + k];
#pragma unroll
                    for (int rr = 0; rr < 16; ++rr) x += a[rr] * F[960 + rr * 64 + k];
                    const float la = (fminf(x, 0.f) - __logf(1.f + __expf(-fabsf(x)))) * (1.f / 16.f);
                    run += la; bb[i] = run;
                    qv[i] = bf2f(zr[Z_CQ + h * 64 + k]) * 0.125f; kv[i] = bf2f(zr[Z_CK + h * 64 + k]); }
                F[wave * 64 + k] = run;
                typedef unsigned u4v __attribute__((ext_vector_type(4)));
#pragma unroll
                for (int i = 0; i < 2; ++i) { const int idx = tid + i * 512, row = idx >> 4, ch = idx & 15;
                    const u4v v = *(const u4v*)(zb + (size_t)(t0c + row) * ZC + Z_CV + h * 128 + ch * 8);
                    *(__attribute__((address_space(3))) u4v*)(L + C_VV + row * 272 + ch * 16) = v; }
            }
            __syncthreads();
            {   float pre = 0.f;
                for (int g = 0; g < wave; ++g) pre += F[g * 64 + k];
#pragma unroll
                for (int i = 0; i < 8; ++i) bb[i] += pre;
                if (wave == 3) F[512 + k] = bb[7];
                if (wave == 7) { F[576 + k] = bb[7]; F[640 + k] = __expf(bb[7]); }
            }
            __syncthreads();
            {   const float bmid = F[512 + k], blast = F[576 + k];
#pragma unroll
                for (int i = 0; i < 8; ++i) { const int t = 8 * wave + i;
                    const float e1 = __expf(fminf(fmaxf(bb[i] - bmid, -80.f), 80.f)), e2 = __expf(fminf(fmaxf(bmid - bb[i], -80.f), 80.f));
                    ((lds_u16*)(L + C_QT))[t * 72 + k] = f2bf(qv[i] * e1); ((lds_u16*)(L + C_KT))[t * 72 + k] = f2bf(kv[i] * e2);
                    ((lds_u16*)(L + C_QH))[t * 72 + k] = f2bf(qv[i] * __expf(bb[i])); ((lds_u16*)(L + C_KH))[t * 72 + k] = f2bf(kv[i] * __expf(blast - bb[i])); }
            }
            __syncthreads();
            f32x16 o;
#pragma unroll
            for (int i = 0; i < 16; ++i) o[i] = 0.f;
            {
#pragma unroll
                for (int ks = 0; ks < 4; ++ks) {
                    const lds_u8* ap = L + C_SS + (16 * ks + trrow) * 272 + (vt * 32 + trcol) * 2;
                    const s16x4 lo = lds_tr_read(ap), hi = lds_tr_read(ap + 4 * 272);
                    const s16x8 bq = ldsv8(L + C_QH + (tt * 32 + r) * 144 + (16 * ks + 8 * hf) * 2);
                    o = __builtin_amdgcn_mfma_f32_32x32x16_bf16(__builtin_shufflevector(lo, hi, 0, 1, 2, 3, 4, 5, 6, 7), bq, o, 0, 0, 0);
                }
            }
#pragma unroll
            for (int st = 0; st < 2; ++st) {
                if (st > tt) continue;
                f32x16 at;
#pragma unroll
                for (int i = 0; i < 16; ++i) at[i] = 0.f;
#pragma unroll
                for (int kk = 0; kk < 4; ++kk) at = __builtin_amdgcn_mfma_f32_32x32x16_bf16(ldsv8(L + C_KT + (st * 32 + r) * 144 + (kk * 16 + hf * 8) * 2), ldsv8(L + C_QT + (tt * 32 + r) * 144 + (kk * 16 + hf * 8) * 2), at, 0, 0, 0);
                if (st == tt) {
#pragma unroll
                    for (int i = 0; i < 16; ++i) { const int srow = (i & 3) + 8 * (i >> 2) + 4 * hf; if (srow > r) at[i] = 0.f; }
                }
                uint4 pw0, pw1;
                pw0.x = cvt_pk(at[0], at[1]); pw0.y = cvt_pk(at[2], at[3]); pw0.z = cvt_pk(at[4], at[5]); pw0.w = cvt_pk(at[6], at[7]);
                pw1.x = cvt_pk(at[8], at[9]); pw1.y = cvt_pk(at[10], at[11]); pw1.z = cvt_pk(at[12], at[13]); pw1.w = cvt_pk(at[14], at[15]);
                const s16x8 pf0 = __builtin_bit_cast(s16x8, pw0), pf1 = __builtin_bit_cast(s16x8, pw1);
                const lds_u8* vp = L + C_VV + (st * 32 + prow) * 272 + (vt * 32 + trcol) * 2;
                const s16x4 v0l = lds_tr_read(vp), v0h = lds_tr_read(vp + 8 * 272), v1l = lds_tr_read(vp + 16 * 272), v1h = lds_tr_read(vp + 24 * 272);
                o = __builtin_amdgcn_mfma_f32_32x32x16_bf16(__builtin_shufflevector(v0l, v0h, 0, 1, 2, 3, 4, 5, 6, 7), pf0, o, 0, 0, 0);
                o = __builtin_amdgcn_mfma_f32_32x32x16_bf16(__builtin_shufflevector(v1l, v1h, 0, 1, 2, 3, 4, 5, 6, 7), pf1, o, 0, 0, 0);
            }
            {
#pragma unroll
                for (int i = 0; i < 16; ++i) S[i] *= F[640 + kt * 32 + (i & 3) + 8 * (i >> 2) + 4 * hf];
#pragma unroll
                for (int ks = 0; ks < 4; ++ks) {
                    const lds_u8* ap = L + C_KH + (16 * ks + trrow) * 144 + (kt * 32 + trcol) * 2;
                    const lds_u8* bp = L + C_VV + (16 * ks + trrow) * 272 + (vt2 * 32 + trcol) * 2;
                    const s16x4 al = lds_tr_read(ap), ah = lds_tr_read(ap + 4 * 144), bl = lds_tr_read(bp), bh = lds_tr_read(bp + 4 * 272);
                    S = __builtin_amdgcn_mfma_f32_32x32x16_bf16(__builtin_shufflevector(al, ah, 0, 1, 2, 3, 4, 5, 6, 7), __builtin_shufflevector(bl, bh, 0, 1, 2, 3, 4, 5, 6, 7), S, 0, 0, 0);
                }
            }
            {   float ss = 0.f;
#pragma unroll
                for (int i = 0; i < 16; ++i) ss += o[i] * o[i];
                ss += __shfl_xor(ss, 32);
                __syncthreads();
                if (hf == 0) F[704 + vt * 64 + tt * 32 + r] = ss;
#pragma unroll
                for (int i = 0; i < 16; ++i) ((lds_u16*)(L + C_SS))[(kt * 32 + (i & 3) + 8 * (i >> 2) + 4 * hf) * 136 + vt2 * 32 + r] = f2bf(S[i]);
            }
            __syncthreads();
            {   const int t = tt * 32 + r;
                const float tot = F[704 + t] + F[704 + 64 + t] + F[704 + 128 + t] + F[704 + 192 + t];
                const float rn = rsqrtf(tot * (1.f / 128.f) + 1e-6f);
                const bf16* rrow = zb + (size_t)(t0c + t) * ZC + Z_CR + h * 128 + vt * 32 + 4 * hf;
                bf16* orow = YC + (size_t)(b * SEQ + t0c + t) * 512 + h * 128 + vt * 32 + 4 * hf;
#pragma unroll
                for (int g = 0; g < 4; ++g) {
                    const uint2 rw = *(const uint2*)(rrow + 8 * g);
                    const float r0 = __uint_as_float(rw.x << 16), r1 = __uint_as_float(rw.x & 0xffff0000u), r2 = __uint_as_float(rw.y << 16), r3 = __uint_as_float(rw.y & 0xffff0000u);
                    const int vb = 2048 + vt * 32 + 8 * g + 4 * hf;
                    const float y0 = o[4 * g] * rn * F[vb] * (r0 / (1.f + __expf(-r0))), y1 = o[4 * g + 1] * rn * F[vb + 1] * (r1 / (1.f + __expf(-r1)));
                    const float y2 = o[4 * g + 2] * rn * F[vb + 2] * (r2 / (1.f + __expf(-r2))), y3 = o[4 * g + 3] * rn * F[vb + 3] * (r3 / (1.f + __expf(-r3)));
                    uint2 w; w.x = cvt_pk(y0, y1); w.y = cvt_pk(y2, y3); *(uint2*)(orow + 8 * g) = w;
                }
            }
        }
    }
    __syncthreads();
}


constexpr size_t WS_CD = 452 * MiB;
constexpr size_t WS_CS = 484 * MiB;
constexpr size_t WS_CL = 444 * MiB;
template <int PASS>
__device__ __forceinline__ void ph_C_chunk(const Ids& id, const Params& p, int layer, float* lds) {
    const bf16* Z = (const bf16*)(p.ws + WS_Z); bf16* YC = (bf16*)(p.ws + WS_YC);
    bf16* CD = (bf16*)(p.ws + WS_CD); const bf16* CS = (const bf16*)(p.ws + WS_CS); float* CL = (float*)(p.ws + WS_CL);
    const int tid = id.tid, lane = tid & 63, wave = tid >> 6, r = lane & 31, hf = lane >> 5, i16 = lane & 15;
    lds_u8* L = (lds_u8*)lds;
    typedef __attribute__((address_space(3))) unsigned short lds_u16; typedef __attribute__((address_space(3))) float lds_f32;
    lds_f32* F = (lds_f32*)(L + C_F32);
    const float* walp = p.c_w_alpha + layer * 16 * 256; const float* balp = p.c_b_alpha + layer * 256; const float* gainp = p.c_on_g + layer * 512;
    const int kt = wave & 1, vt2 = wave >> 1, tt = wave & 1, vt = wave >> 1;
    const int trrow = 8 * hf + (i16 >> 2), trcol = ((lane >> 4) & 1) * 16 + (i16 & 3) * 4, prow = 4 * hf + (i16 >> 2);
    typedef unsigned u4v __attribute__((ext_vector_type(4)));
    int h_loaded = -1;
    u4v cspre[2];
    if (PASS == 3 && id.bid < 2048) {
#pragma unroll
        for (int i = 0; i < 2; ++i) { const int idx = tid + i * 512, row = idx >> 4, ch = idx & 15; cspre[i] = *(const u4v*)(CS + (size_t)id.bid * 8192 + row * 128 + ch * 8); } }
    for (int item = id.bid; item < 2048; item += gridDim.x) {
        const int c = item & 31, bh = item >> 5, b = bh >> 2, h = bh & 3; const bf16* zb = Z + (size_t)b * SEQ * ZC;
        const int t0c = c * 64, k = lane;
        u4v vpre[2];
#pragma unroll
        for (int i = 0; i < 2; ++i) { const int idx = tid + i * 512, row = idx >> 4, ch = idx & 15; vpre[i] = *(const u4v*)(zb + (size_t)(t0c + row) * ZC + Z_CV + h * 128 + ch * 8); }
        const unsigned apre = *(const unsigned*)(zb + (size_t)(t0c + 8 * wave + (lane >> 3)) * ZC + Z_CA + (lane & 7) * 2);
        bf16 qpre[8], kpre[8];
#pragma unroll
        for (int i = 0; i < 8; ++i) { const bf16* zr = zb + (size_t)(t0c + 8 * wave + i) * ZC; if (PASS == 3) qpre[i] = zr[Z_CQ + h * 64 + k]; kpre[i] = zr[Z_CK + h * 64 + k]; }
        uint2 rpre[4];
        if (PASS == 3) { const bf16* rrow0 = zb + (size_t)(t0c + tt * 32 + r) * ZC + Z_CR + h * 128 + vt * 32 + 4 * hf;
#pragma unroll
            for (int g = 0; g < 4; ++g) rpre[g] = *(const uint2*)(rrow0 + 8 * g); }
        __syncthreads();
        if (h != h_loaded) {
            for (int i = tid; i < 1024; i += NTHR) F[960 + i] = walp[(i >> 6) * 256 + h * 64 + (i & 63)];
            if (tid < 64) F[1984 + tid] = balp[h * 64 + tid];
            if (PASS == 3 && tid < 128) F[2048 + tid] = gainp[h * 128 + tid];
            h_loaded = h;
        }
        if (PASS == 3) {
#pragma unroll
            for (int i = 0; i < 2; ++i) { const int idx = tid + i * 512, row = idx >> 4, ch = idx & 15;
                *(__attribute__((address_space(3))) u4v*)(L + C_SS + row * 272 + ch * 16) = cspre[i]; }
            const int nitem = item + (int)gridDim.x;
            if (nitem < 2048) {
#pragma unroll
                for (int i = 0; i < 2; ++i) { const int idx = tid + i * 512, row = idx >> 4, ch = idx & 15; cspre[i] = *(const u4v*)(CS + (size_t)nitem * 8192 + row * 128 + ch * 8); } }
        }
        __syncthreads();
        float bb[8], qv[8], kv[8];
        {
            float run = 0.f;
#pragma unroll
            for (int i = 0; i < 8; ++i) {
                float a[16];
#pragma unroll
                for (int pp = 0; pp < 8; ++pp) { const unsigned ap = (unsigned)__builtin_amdgcn_readlane((int)apre, 8 * i + pp); a[2 * pp] = __uint_as_float(ap << 16); a[2 * pp + 1] = __uint_as_float(ap & 0xffff0000u); }
                float x = F[1984 + k];
#pragma unroll
                for (int rr = 0; rr < 16; ++rr) x += a[rr] * F[960 + rr * 64 + k];
                const float la = (fminf(x, 0.f) - __logf(1.f + __expf(-fabsf(x)))) * (1.f / 16.f);
                run += la; bb[i] = run;
                if (PASS == 3) qv[i] = bf2f(qpre[i]) * 0.125f;
                kv[i] = bf2f(kpre[i]); }
            F[wave * 64 + k] = run;
#pragma unroll
            for (int i = 0; i < 2; ++i) { const int idx = tid + i * 512, row = idx >> 4, ch = idx & 15;
                *(__attribute__((address_space(3))) u4v*)(L + C_VV + row * 272 + ch * 16) = vpre[i]; }
        }
        __syncthreads();
        {   float pre = 0.f;
            for (int g = 0; g < wave; ++g) pre += F[g * 64 + k];
#pragma unroll
            for (int i = 0; i < 8; ++i) bb[i] += pre;
            if (wave == 3) F[512 + k] = bb[7];
            if (wave == 7) { F[576 + k] = bb[7]; if (PASS == 1) CL[(size_t)item * 64 + k] = __expf(bb[7]); }
        }
        __syncthreads();
        {   const float bmid = F[512 + k], blast = F[576 + k];
#pragma unroll
            for (int i = 0; i < 8; ++i) { const int t = 8 * wave + i;
                if (PASS == 3) { const float e1 = __expf(fminf(fmaxf(bb[i] - bmid, -80.f), 80.f)), e2 = __expf(fminf(fmaxf(bmid - bb[i], -80.f), 80.f));
                    ((lds_u16*)(L + C_QT))[t * 72 + k] = f2bf(qv[i] * e1); ((lds_u16*)(L + C_KT))[t * 72 + k] = f2bf(kv[i] * e2);
                    ((lds_u16*)(L + C_QH))[t * 72 + k] = f2bf(qv[i] * __expf(bb[i])); }
                else ((lds_u16*)(L + C_KH))[t * 72 + k] = f2bf(kv[i] * __expf(blast - bb[i])); }
        }
        __syncthreads();
        if (PASS == 1) {
            f32x16 S;
#pragma unroll
            for (int i = 0; i < 16; ++i) S[i] = 0.f;
#pragma unroll
            for (int ks = 0; ks < 4; ++ks) {
                const lds_u8* ap = L + C_KH + (16 * ks + trrow) * 144 + (kt * 32 + trcol) * 2;
                const lds_u8* bp = L + C_VV + (16 * ks + trrow) * 272 + (vt2 * 32 + trcol) * 2;
                const s16x4 al = lds_tr_read(ap), ah = lds_tr_read(ap + 4 * 144), bl = lds_tr_read(bp), bh2 = lds_tr_read(bp + 4 * 272);
                S = __builtin_amdgcn_mfma_f32_32x32x16_bf16(__builtin_shufflevector(al, ah, 0, 1, 2, 3, 4, 5, 6, 7), __builtin_shufflevector(bl, bh2, 0, 1, 2, 3, 4, 5, 6, 7), S, 0, 0, 0);
            }
            bf16* dp = CD + (size_t)item * 8192 + vt2 * 32 + r;
#pragma unroll
            for (int i = 0; i < 16; ++i) dp[(kt * 32 + (i & 3) + 8 * (i >> 2) + 4 * hf) * 128] = f2bf(S[i]);
        } else {
            f32x16 o;
#pragma unroll
            for (int i = 0; i < 16; ++i) o[i] = 0.f;
#pragma unroll
            for (int ks = 0; ks < 4; ++ks) {
                const lds_u8* ap = L + C_SS + (16 * ks + trrow) * 272 + (vt * 32 + trcol) * 2;
                const s16x4 lo = lds_tr_read(ap), hi = lds_tr_read(ap + 4 * 272);
                const s16x8 bq = ldsv8(L + C_QH + (tt * 32 + r) * 144 + (16 * ks + 8 * hf) * 2);
                o = __builtin_amdgcn_mfma_f32_32x32x16_bf16(__builtin_shufflevector(lo, hi, 0, 1, 2, 3, 4, 5, 6, 7), bq, o, 0, 0, 0);
            }
#pragma unroll
            for (int st = 0; st < 2; ++st) {
                if (st > tt) continue;
                f32x16 at;
#pragma unroll
                for (int i = 0; i < 16; ++i) at[i] = 0.f;
#pragma unroll
                for (int kk = 0; kk < 4; ++kk) at = __builtin_amdgcn_mfma_f32_32x32x16_bf16(ldsv8(L + C_KT + (st * 32 + r) * 144 + (kk * 16 + hf * 8) * 2), ldsv8(L + C_QT + (tt * 32 + r) * 144 + (kk * 16 + hf * 8) * 2), at, 0, 0, 0);
                if (st == tt) {
#pragma unroll
                    for (int i = 0; i < 16; ++i) { const int srow = (i & 3) + 8 * (i >> 2) + 4 * hf; if (srow > r) at[i] = 0.f; }
                }
                uint4 pw0, pw1;
                pw0.x = cvt_pk(at[0], at[1]); pw0.y = cvt_pk(at[2], at[3]); pw0.z = cvt_pk(at[4], at[5]); pw0.w = cvt_pk(at[6], at[7]);
                pw1.x = cvt_pk(at[8], at[9]); pw1.y = cvt_pk(at[10], at[11]); pw1.z = cvt_pk(at[12], at[13]); pw1.w = cvt_pk(at[14], at[15]);
                const s16x8 pf0 = __builtin_bit_cast(s16x8, pw0), pf1 = __builtin_bit_cast(s16x8, pw1);
                const lds_u8* vp = L + C_VV + (st * 32 + prow) * 272 + (vt * 32 + trcol) * 2;
                const s16x4 v0l = lds_tr_read(vp), v0h = lds_tr_read(vp + 8 * 272), v1l = lds_tr_read(vp + 16 * 272), v1h = lds_tr_read(vp + 24 * 272);
                o = __builtin_amdgcn_mfma_f32_32x32x16_bf16(__builtin_shufflevector(v0l, v0h, 0, 1, 2, 3, 4, 5, 6, 7), pf0, o, 0, 0, 0);
                o = __builtin_amdgcn_mfma_f32_32x32x16_bf16(__builtin_shufflevector(v1l, v1h, 0, 1, 2, 3, 4, 5, 6, 7), pf1, o, 0, 0, 0);
            }
            float ss = 0.f;
#pragma unroll
            for (int i = 0; i < 16; ++i) ss += o[i] * o[i];
            ss += __shfl_xor(ss, 32);
            if (hf == 0) F[704 + vt * 64 + tt * 32 + r] = ss;
            __syncthreads();
            const int t = tt * 32 + r;
            const float tot = F[704 + t] + F[704 + 64 + t] + F[704 + 128 + t] + F[704 + 192 + t];
            const float rn = rsqrtf(tot * (1.f / 128.f) + 1e-6f);
            const bf16* rrow = zb + (size_t)(t0c + t) * ZC + Z_CR + h * 128 + vt * 32 + 4 * hf;
            bf16* orow = YC + (size_t)(b * SEQ + t0c + t) * 512 + h * 128 + vt * 32 + 4 * hf;
#pragma unroll
            for (int g = 0; g < 4; ++g) {
                const uint2 rw = rpre[g];
                const float r0 = __uint_as_float(rw.x << 16), r1 = __uint_as_float(rw.x & 0xffff0000u), r2 = __uint_as_float(rw.y << 16), r3 = __uint_as_float(rw.y & 0xffff0000u);
                const int vb = 2048 + vt * 32 + 8 * g + 4 * hf;
                const float y0 = o[4 * g] * rn * F[vb] * (r0 / (1.f + __expf(-r0))), y1 = o[4 * g + 1] * rn * F[vb + 1] * (r1 / (1.f + __expf(-r1)));
                const float y2 = o[4 * g + 2] * rn * F[vb + 2] * (r2 / (1.f + __expf(-r2))), y3 = o[4 * g + 3] * rn * F[vb + 3] * (r3 / (1.f + __expf(-r3)));
                uint2 w; w.x = cvt_pk(y0, y1); w.y = cvt_pk(y2, y3); *(uint2*)(orow + 8 * g) = w;
            }
        }
    }
    __syncthreads();
}
__device__ __forceinline__ void ph_C_scan(const Ids& id, const Params& p) {
    const bf16* CD = (const bf16*)(p.ws + WS_CD); bf16* CS = (bf16*)(p.ws + WS_CS); const float* CL = (const float*)(p.ws + WS_CL);
    for (int e = id.bid * NTHR + id.tid; e < 64 * 64 * 32; e += gridDim.x * NTHR) {
        const int v4 = e & 31, k = (e >> 5) & 63, bh = e >> 11;
        float s0 = 0.f, s1 = 0.f, s2 = 0.f, s3 = 0.f;
#pragma unroll 8
        for (int c = 0; c < 32; ++c) {
            const size_t off = (size_t)(bh * 32 + c) * 8192 + k * 128 + v4 * 4;
            const uint2 d = *(const uint2*)(CD + off); const float dl = CL[(size_t)(bh * 32 + c) * 64 + k];
            uint2 o; o.x = cvt_pk(s0, s1); o.y = cvt_pk(s2, s3); *(uint2*)(CS + off) = o;
            s0 = dl * s0 + __uint_as_float(d.x << 16); s1 = dl * s1 + __uint_as_float(d.x & 0xffff0000u); s2 = dl * s2 + __uint_as_float(d.y << 16); s3 = dl * s3 + __uint_as_float(d.y & 0xffff0000u);
        }
    }
}

__device__ __forceinline__ void ph_C(const Ids& id, const Params& p, int layer, float* lds) {
    const bf16* Z = (const bf16*)(p.ws + WS_Z); float* OR = (float*)(p.ws + WS_CRAW);
    float* s_al = lds; float* s_k = lds + 1024; float* s_q = lds + 2048; float* s_wa = lds + 3072; float* s_ba = lds + 4096;
    const float* wal = p.c_w_alpha + layer * 16 * 256; const float* bal = p.c_b_alpha + layer * 256;
    const int tid = id.tid;
    for (int item = id.bid; item < 64; item += gridDim.x) {
        const int b = item >> 2, h = item & 3; const bf16* zb = Z + (size_t)b * SEQ * ZC;
        for (int i = tid; i < 1024; i += NTHR) { const int r = i >> 6, k = i & 63; s_wa[i] = wal[r * 256 + h * 64 + k]; }
        if (tid < 64) s_ba[tid] = bal[h * 64 + tid];
        float S[64];
#pragma unroll
        for (int k = 0; k < 64; ++k) S[k] = 0.f;
        __syncthreads();
        for (int t0 = 0; t0 < SEQ; t0 += 16) {
            for (int i = tid; i < 1024; i += NTHR) { const int st = i >> 6, k = i & 63; const bf16* zr = zb + (size_t)(t0 + st) * ZC;
                float x = s_ba[k];
#pragma unroll
                for (int r = 0; r < 16; ++r) x += bf2f(zr[Z_CA + r]) * s_wa[r * 64 + k];
                s_al[i] = expf(logsig(x) * (1.f / 16.f));
                s_k[i] = bf2f(zr[Z_CK + h * 64 + k]); s_q[i] = bf2f(zr[Z_CQ + h * 64 + k]) * 0.125f; }
            __syncthreads();
            if (tid < 128) {
                for (int st = 0; st < 16; ++st) {
                    const float vv = bf2f(zb[(size_t)(t0 + st) * ZC + Z_CV + h * 128 + tid]);
                    float o = 0.f;
#pragma unroll
                    for (int k = 0; k < 64; ++k) { S[k] = s_al[st * 64 + k] * S[k] + s_k[st * 64 + k] * vv; o += s_q[st * 64 + k] * S[k]; }
                    OR[(size_t)(b * SEQ + t0 + st) * 512 + h * 128 + tid] = o;
                }
            }
            __syncthreads();
        }
    }
}
__device__ __forceinline__ void ph_Cpost(const Ids& id, const Params& p, int layer) {
    const bf16* Z = (const bf16*)(p.ws + WS_Z); const float* OR = (const float*)(p.ws + WS_CRAW); bf16* YC = (bf16*)(p.ws + WS_YC);
    const int lane = id.tid & 63, wave = __builtin_amdgcn_readfirstlane(id.tid >> 6);
    for (int idx = id.bid * 8 + wave; idx < NTOK * 4; idx += gridDim.x * 8) {
        const int tok = idx >> 2, h = idx & 3;
        const float o0 = OR[(size_t)tok * 512 + h * 128 + lane], o1 = OR[(size_t)tok * 512 + h * 128 + 64 + lane];
        const float ss = wave_sum(o0 * o0 + o1 * o1); const float r = rsqrtf(ss * (1.f / 128.f) + 1e-6f);
        const float g0 = p.c_on_g[layer * 512 + h * 128 + lane], g1 = p.c_on_g[layer * 512 + h * 128 + 64 + lane];
        const float r0 = bf2f(Z[(size_t)tok * ZC + Z_CR + h * 128 + lane]), r1 = bf2f(Z[(size_t)tok * ZC + Z_CR + h * 128 + 64 + lane]);
        YC[(size_t)tok * 512 + h * 128 + lane] = f2bf(o0 * r * g0 * (r0 / (1.f + expf(-r0))));
        YC[(size_t)tok * 512 + h * 128 + 64 + lane] = f2bf(o1 * r * g1 * (r1 / (1.f + expf(-r1))));
    }
}

__device__ __forceinline__ void ph_peersel(const Ids& id, const Params& p, int layer, float* lds) {
    const bf16* PQ = (const bf16*)(p.ws + WS_PQ); int* PE = (int*)(p.ws + WS_PE); float* PG = (float*)(p.ws + WS_PG);
    const float* SK = p.peer_subkeys + (size_t)layer * 8 * 2 * 128 * 128;
    float* s_q = lds; float* s_sc = lds + 2048; float* s_ts = lds + 4096; int* s_ti = (int*)(lds + 4352); float* s_bs = lds + 4608; int* s_be = (int*)(lds + 4736);
    const int tid = id.tid;
    for (int tok = id.bid; tok < NTOK; tok += gridDim.x) {
        for (int i = tid; i < 2048; i += NTHR) s_q[i] = bf2f(PQ[(size_t)tok * 2048 + i]);
        __syncthreads();
        for (int idx = tid; idx < 2048; idx += NTHR) { const int list = idx >> 7;
            const float4* kr = (const float4*)(SK + (size_t)idx * 128); const float* q = s_q + list * 128; float dot = 0.f;
            for (int c = 0; c < 32; ++c) { const float4 kv = kr[c]; dot += q[c * 4] * kv.x + q[c * 4 + 1] * kv.y + q[c * 4 + 2] * kv.z + q[c * 4 + 3] * kv.w; }
            s_sc[idx] = dot; }
        __syncthreads();
        for (int idx = tid; idx < 2048; idx += NTHR) { const int list = idx >> 7, i = idx & 127; const float v = s_sc[idx]; int rank = 0;
            for (int j = 0; j < 128; ++j) { const float u = s_sc[list * 128 + j]; rank += (u > v || (u == v && j < i)) ? 1 : 0; }
            if (rank < 16) { s_ts[list * 16 + rank] = v; s_ti[list * 16 + rank] = i; } }
        __syncthreads();
        for (int idx = tid; idx < 2048; idx += NTHR) { const int h = idx >> 8, a = (idx >> 4) & 15, b = idx & 15;
            s_sc[idx] = s_ts[(2 * h) * 16 + a] + s_ts[(2 * h + 1) * 16 + b]; }
        __syncthreads();
        for (int idx = tid; idx < 2048; idx += NTHR) { const int h = idx >> 8, i = idx & 255; const float v = s_sc[idx]; int rank = 0;
            for (int j = 0; j < 256; ++j) { const float u = s_sc[h * 256 + j]; rank += (u > v || (u == v && j < i)) ? 1 : 0; }
            if (rank < 16) { s_bs[h * 16 + rank] = v; s_be[h * 16 + rank] = s_ti[(2 * h) * 16 + (i >> 4)] * 128 + s_ti[(2 * h + 1) * 16 + (i & 15)]; } }
        __syncthreads();
        if (tid < 128) { const int h = tid >> 4; const float m = s_bs[h * 16]; float sum = 0.f;
            for (int k = 0; k < 16; ++k) sum += expf(s_bs[h * 16 + k] - m);
            PG[(size_t)tok * 128 + tid] = expf(s_bs[tid] - m) / sum; PE[(size_t)tok * 128 + tid] = s_be[tid]; }
        __syncthreads();
    }
}
__device__ __forceinline__ void ph_peerexp(const Ids& id, const Params& p, int layer, float* lds) {
    const bf16* N = (const bf16*)(p.ws + WS_N); const int* PE = (const int*)(p.ws + WS_PE); const float* PG = (const float*)(p.ws + WS_PG);
    const float* U = p.peer_u + (size_t)layer * 16384 * 1024; const float* V = p.peer_v + (size_t)layer * 16384 * 1024;
    const float* mod = (const float*)(p.ws + WS_MOD) + (size_t)layer * 16 * 6144;
    float* s_x = lds; float* s_w = lds + 1024; int* s_e = (int*)(lds + 1152);
    const int tid = id.tid, lane = tid & 63, wave = tid >> 6;
    for (int tok = id.bid; tok < NTOK; tok += gridDim.x) {
        const int b = tok >> 11;
        for (int i = tid; i < 1024; i += NTHR) s_x[i] = bf2f(N[(size_t)tok * 1024 + i]);
        if (tid < 128) s_e[tid] = PE[(size_t)tok * 128 + tid];
        __syncthreads();
        for (int i = 0; i < 16; ++i) { const int slot = wave * 16 + i; const int e = s_e[slot];
            const float4* ur = (const float4*)(U + (size_t)e * 1024); float dot = 0.f;
#pragma unroll
            for (int j = 0; j < 4; ++j) { const float4 uv = ur[lane + 64 * j]; const float* xx = s_x + (lane + 64 * j) * 4; dot += xx[0] * uv.x + xx[1] * uv.y + xx[2] * uv.z + xx[3] * uv.w; }
            dot = wave_sum(dot);
            const float act = 0.5f * dot * (1.f + erff(dot * 0.70710678118654752f));
            if (lane == 0) s_w[slot] = PG[(size_t)tok * 128 + slot] * act; }
        __syncthreads();
        { float a0 = 0.f, a1 = 0.f;
          for (int j = 0; j < 128; ++j) { const float2 vv = *(const float2*)(V + (size_t)s_e[j] * 1024 + tid * 2); const float w = s_w[j]; a0 += w * vv.x; a1 += w * vv.y; }
          const float2 g = *(const float2*)(mod + (size_t)b * 6144 + 5 * 1024 + tid * 2);
          float2* o = (float2*)(p.out + (size_t)tok * 1024 + tid * 2); float2 hv = *o; hv.x += g.x * a0; hv.y += g.y * a1; *o = hv; }
        __syncthreads();
    }
}


#define LAS __attribute__((address_space(3)))
#define LDS_WAIT() asm volatile("s_waitcnt lgkmcnt(0)" ::: "memory")
__device__ __forceinline__ unsigned pk2(float lo, float hi) { return (unsigned)f2bf(lo) | ((unsigned)f2bf(hi) << 16); }
template <bool MAP>
__device__ __forceinline__ void transpose_item(const float* W, int ldw, int K, int nblk, bf16* WT, float* scr, int item, int lane) {
    const int kb = item / nblk, nb = item % nblk, k0 = 64 * kb, n0 = 32 * nb;
    const int n = n0 + (lane & 31);
    const int sc = MAP ? (n < 4052 ? inproj_src_col(n) : -1) : n;
#pragma unroll 8
    for (int i = 0; i < 32; ++i) { const int kk = 2 * i + (lane >> 5); scr[kk * 33 + (lane & 31)] = sc >= 0 ? W[(size_t)(k0 + kk) * ldw + sc] : 0.f; }
    LDS_WAIT();
    const int c = lane & 7;
#pragma unroll
    for (int j = 0; j < 4; ++j) { const int nn = (lane >> 3) + 8 * j; const float* sp = scr + (8 * c) * 33 + nn;
        uint4 o; o.x = pk2(sp[0 * 33], sp[1 * 33]); o.y = pk2(sp[2 * 33], sp[3 * 33]); o.z = pk2(sp[4 * 33], sp[5 * 33]); o.w = pk2(sp[6 * 33], sp[7 * 33]);
        *(uint4*)(WT + (size_t)(n0 + nn) * K + k0 + 8 * c) = o; }
    LDS_WAIT();
}
__device__ __forceinline__ void ph_wprep(const Ids& id, const Params& p, int layer, float* lds) {
    const int lane = id.tid & 63, wave = __builtin_amdgcn_readfirstlane(id.tid >> 6);
    float* scr = lds + wave * (64 * 33);
    unsigned char* ws = p.ws;
    {
        const float4* SK = (const float4*)(p.peer_subkeys + (size_t)layer * 262144); uint2* SKB = (uint2*)(p.ws + WS_SKB);
        for (int i = id.bid * NTHR + id.tid; i < 65536; i += gridDim.x * NTHR) { const float4 a = SK[i]; uint2 o; o.x = pk2(a.x, a.y); o.y = pk2(a.z, a.w); SKB[i] = o; }
    }
    constexpr int I_IN = 16 * 128, I_G = 16 * 96, I_O = 8 * 32, I_OUT = 16 * 32, I_PQ = 16 * 64;
    constexpr int NITEMS = I_IN + I_G + 3 * I_O + I_OUT + I_PQ;
    const float* win = p.w_in + (size_t)layer * 1024 * INC;
    for (int it = id.bid * 8 + wave; it < NITEMS; it += gridDim.x * 8) {
        int r = it;
        if (r < I_IN) { transpose_item<true>(win, INC, 1024, 128, (bf16*)(ws + WS_WIN_T), scr, r, lane); continue; } r -= I_IN;
        if (r < I_G) { transpose_item<false>(win + 4052, INC, 1024, 96, (bf16*)(ws + WS_WG_T), scr, r, lane); continue; } r -= I_G;
        if (r < I_O) { transpose_item<false>(p.w_oa + (size_t)layer * 512 * 1024, 1024, 512, 32, (bf16*)(ws + WS_WOA_T), scr, r, lane); continue; } r -= I_O;
        if (r < I_O) { transpose_item<false>(p.w_ob + (size_t)layer * 512 * 1024, 1024, 512, 32, (bf16*)(ws + WS_WOB_T), scr, r, lane); continue; } r -= I_O;
        if (r < I_O) { transpose_item<false>(p.w_oc + (size_t)layer * 512 * 1024, 1024, 512, 32, (bf16*)(ws + WS_WOC_T), scr, r, lane); continue; } r -= I_O;
        if (r < I_OUT) { transpose_item<false>(p.w_out + (size_t)layer * 1024 * 1024, 1024, 1024, 32, (bf16*)(ws + WS_WOUT_T), scr, r, lane); continue; } r -= I_OUT;
        transpose_item<false>(p.peer_wq + (size_t)layer * 1024 * 2048, 2048, 1024, 64, (bf16*)(ws + WS_WPQ_T), scr, r, lane);
    }
}

#ifndef FUSE_QK
#define FUSE_QK 1
#endif
#ifndef FUSE_GATES
#define FUSE_GATES 1
#endif
constexpr int LDG = FUSE_GATES ? 8192 : 3072;
namespace pg8 {
#define PG8_LAS __attribute__((address_space(3)))
typedef unsigned short bf16_t;
typedef short bf16x8 __attribute__((ext_vector_type(8)));
typedef float f32x4 __attribute__((ext_vector_type(4)));
typedef unsigned u32x4 __attribute__((ext_vector_type(4)));
constexpr int BM = 256, BK = 64, HALF = 128, HTB = HALF * BK * 2  , STAGE_BYTES = 8 * HTB, NXCD = 8, WGM = 8;

__host__ __device__ __forceinline__ int lds_byte(int r, int c) { const int st = (r >> 4) * 2 + (c >> 5), rr = r & 15, cc = c & 31, ob = rr * 64 + cc * 2; return st * 1024 + (ob ^ (((ob >> 9) & 1) << 5)); }
__host__ __device__ __forceinline__ void stage_rc(int b, int& R, int& C) { const int st = b / 1024, sb = b % 1024, swz = sb ^ (((sb >> 9) & 1) << 5); R = (st >> 1) * 16 + swz / 64; C = (st & 1) * 32 + (swz % 64) / 2; }
__host__ __device__ __forceinline__ int perm32(int rho) { const int n = rho >> 4, i = rho & 15; return 8 * (i >> 2) + 4 * n + (i & 3); }

struct Unit { int pm, pn; int br; };
struct Gemm { const bf16_t* A; const bf16_t* Bt; int M, N, K; const bf16_t* A1; const bf16_t* Bt1; const bf16_t* A2; const bf16_t* Bt2; };

struct StaticOrder {
    int nM, nN, nwg, G, c;
    __host__ __device__ void init(int M, int N, int G_, int c_) { nM = M / BM; nN = N / BM; nwg = nM * nN; G = G_; c = c_; }
    __host__ __device__ bool next(int i, Unit& u) const {
        const long L = (long)i * G + c; if (L >= nwg) return false;
        int wgid = (int)L; { const int q = nwg / NXCD, r = nwg % NXCD, xcd = wgid % NXCD, off = wgid / NXCD; wgid = (xcd < r ? xcd * (q + 1) : r * (q + 1) + (xcd - r) * q) + off; }
        const int nig = WGM * nN, gid = wgid / nig, fm = gid * WGM, gsz = (nM - fm) < WGM ? (nM - fm) : WGM;
        u.pm = fm + ((wgid % nig) % gsz); u.pn = (wgid % nig) / gsz; return true;
    }
    __device__ __forceinline__ void a_ready(const Unit&) const {}
    __device__ __forceinline__ void done(const Unit&) const {}
};
typedef float f32x2_t __attribute__((ext_vector_type(2))); typedef __bf16 bf16x2_t __attribute__((ext_vector_type(2)));
__device__ __forceinline__ unsigned cvt_pk_bf16(float lo, float hi) { f32x2_t v = {lo, hi}; bf16x2_t b = __builtin_convertvector(v, bf16x2_t); return __builtin_bit_cast(unsigned, b); }

__device__ __forceinline__ float fast_sigmoid(float x) { return __builtin_amdgcn_rcpf(1.0f + __builtin_amdgcn_exp2f(-1.4426950408889634f * x)); }
template <int ACT  > struct EpiBfStore {
    static constexpr bool PERM = true, AFTER_DRAIN = false;
    bf16_t* O; int ldc; const float* bias;
    __device__ __forceinline__ void operator()(const f32x4 (&acc)[2][2][4][2], const Unit& u, int wr, int wc, int fr, int fq) const {
        const int row0 = u.pm * BM + wr * 64 + fr, col0 = u.pn * BM + wc * 32 + 8 * fq;
        f32x4 bv[2][2];
#pragma unroll
        for (int bj = 0; bj < 2; ++bj)
#pragma unroll
            for (int n = 0; n < 2; ++n) bv[bj][n] = ACT ? *(const f32x4*)(bias + col0 + bj * HALF + 4 * n) : (f32x4){0.f, 0.f, 0.f, 0.f};
#pragma unroll
        for (int ai = 0; ai < 2; ++ai)
#pragma unroll
            for (int m = 0; m < 4; ++m) { bf16_t* rowp = O + (size_t)(row0 + ai * HALF + m * 16) * ldc + col0;
#pragma unroll
                for (int bj = 0; bj < 2; ++bj) { f32x4 v0 = acc[ai][bj][m][0] + bv[bj][0], v1 = acc[ai][bj][m][1] + bv[bj][1];
                    if (ACT == 1) {
#pragma unroll
                        for (int j = 0; j < 4; ++j) { v0[j] = fast_sigmoid(v0[j]); v1[j] = fast_sigmoid(v1[j]); } }
                    u32x4 w; w.x = cvt_pk_bf16(v0[0], v0[1]); w.y = cvt_pk_bf16(v0[2], v0[3]); w.z = cvt_pk_bf16(v1[0], v1[1]); w.w = cvt_pk_bf16(v1[2], v1[3]);
                    *(u32x4*)(rowp + bj * HALF) = w; } }
    }
};
__device__ __forceinline__ int qk_head_type(int c0) { return c0 < 512 ? 1 : (c0 == 512 ? 2 : ((c0 >= 960 && c0 < 1472) ? 3 : ((c0 >= 1472 && c0 < 1984) ? 4 : 0))); }
struct EpiInQK {
    static constexpr bool PERM = true, AFTER_DRAIN = false;
    bf16_t* O; int ldc; const float* gtab; PG8_LAS float* P;
    __device__ __forceinline__ void operator()(const f32x4 (&acc)[2][2][4][2], const Unit& u, int wr, int wc, int fr, int fq) const {
        const int row0 = u.pm * BM + wr * 64 + fr, col0 = u.pn * BM + wc * 32 + 8 * fq;
        const int wave = wr * 4 + wc;
        const bool normed = u.pn < 8;
        if (normed) {
#pragma unroll
            for (int bj = 0; bj < 2; ++bj)
#pragma unroll
                for (int ai = 0; ai < 2; ++ai)
#pragma unroll
                    for (int m = 0; m < 4; ++m) { const f32x4 a = acc[ai][bj][m][0], b = acc[ai][bj][m][1];
                        float s = (a[0] * a[0] + a[1] * a[1]) + (a[2] * a[2] + a[3] * a[3]) + (b[0] * b[0] + b[1] * b[1]) + (b[2] * b[2] + b[3] * b[3]);
                        { const auto r16 = __builtin_amdgcn_permlane16_swap(__float_as_uint(s), __float_as_uint(s), false, false); s = __uint_as_float(r16[0]) + __uint_as_float(r16[1]);
                          const auto r32 = __builtin_amdgcn_permlane32_swap(__float_as_uint(s), __float_as_uint(s), false, false); s = __uint_as_float(r32[0]) + __uint_as_float(r32[1]); }
                        if (fq == 0) P[wave * 256 + bj * 128 + ai * 64 + m * 16 + fr] = s; __builtin_amdgcn_sched_barrier(0); }
            asm volatile("s_waitcnt lgkmcnt(0)\n\ts_barrier" ::: "memory");
        }
#pragma unroll
        for (int bj = 0; bj < 2; ++bj) {
            const int ty = normed ? qk_head_type(u.pn * BM + bj * HALF + (wc >> 1) * 64) : 0;
            const float* gp = gtab + (ty ? ty - 1 : 0) * 64;
            f32x4 g0 = {1.f, 1.f, 1.f, 1.f}, g1 = {1.f, 1.f, 1.f, 1.f};
            if (ty) { g0 = *(const f32x4*)(gp + (wc & 1) * 32 + 8 * fq); g1 = *(const f32x4*)(gp + (wc & 1) * 32 + 8 * fq + 4); }
#pragma unroll
            for (int ai = 0; ai < 2; ++ai)
#pragma unroll
                for (int m = 0; m < 4; ++m) { bf16_t* rowp = O + (size_t)(row0 + ai * HALF + m * 16) * ldc + col0 + bj * HALF;
                    float rsv = 1.f;
                    if (ty) { const int pi = bj * 128 + ai * 64 + m * 16 + fr; rsv = __builtin_amdgcn_rsqf((P[wave * 256 + pi] + P[(wave ^ 1) * 256 + pi]) * (1.f / 64.f) + 1e-6f); }
                    const f32x4 v0 = acc[ai][bj][m][0] * g0 * rsv, v1 = acc[ai][bj][m][1] * g1 * rsv;
                    u32x4 w; w.x = cvt_pk_bf16(v0[0], v0[1]); w.y = cvt_pk_bf16(v0[2], v0[3]); w.z = cvt_pk_bf16(v1[0], v1[1]); w.w = cvt_pk_bf16(v1[2], v1[3]);
                    *(u32x4*)rowp = w; __builtin_amdgcn_sched_barrier(0); } }
    }
};
struct EpiGate8 {
    static constexpr bool PERM = true, AFTER_DRAIN = false;
    unsigned char* O; int ldc; const float* bias;
    __device__ __forceinline__ void operator()(const f32x4 (&acc)[2][2][4][2], const Unit& u, int wr, int wc, int fr, int fq) const {
        const int row0 = u.pm * BM + wr * 64 + fr, col0 = u.pn * BM + wc * 32 + 8 * fq;
        f32x4 bv[2][2];
#pragma unroll
        for (int bj = 0; bj < 2; ++bj)
#pragma unroll
            for (int n = 0; n < 2; ++n) bv[bj][n] = *(const f32x4*)(bias + col0 + bj * HALF + 4 * n);
        const int odd = fq & 1;
#pragma unroll
        for (int ai = 0; ai < 2; ++ai)
#pragma unroll
            for (int m = 0; m < 4; ++m) { unsigned char* rowp = O + (size_t)(row0 + ai * HALF + m * 16) * ldc + col0;
                unsigned wlo[2], whi[2];
#pragma unroll
                for (int bj = 0; bj < 2; ++bj) { f32x4 v0 = acc[ai][bj][m][0] + bv[bj][0], v1 = acc[ai][bj][m][1] + bv[bj][1];
#pragma unroll
                    for (int j = 0; j < 4; ++j) { v0[j] = fmaxf(fast_sigmoid(v0[j]), 0.001953125f); v1[j] = fmaxf(fast_sigmoid(v1[j]), 0.001953125f); }
                    int w0 = 0, w1 = 0;
                    w0 = __builtin_amdgcn_cvt_pk_fp8_f32(v0[0], v0[1], w0, false); w0 = __builtin_amdgcn_cvt_pk_fp8_f32(v0[2], v0[3], w0, true);
                    w1 = __builtin_amdgcn_cvt_pk_fp8_f32(v1[0], v1[1], w1, false); w1 = __builtin_amdgcn_cvt_pk_fp8_f32(v1[2], v1[3], w1, true);
                    wlo[bj] = (unsigned)w0; whi[bj] = (unsigned)w1; }
                const auto s0 = __builtin_amdgcn_permlane16_swap(wlo[0], wlo[1], false, false);
                const auto s1 = __builtin_amdgcn_permlane16_swap(whi[0], whi[1], false, false);
                u32x4 w; w.x = s0[0]; w.y = s1[0]; w.z = s0[1]; w.w = s1[1];
                *(u32x4*)(rowp + (odd ? HALF - 8 : 0)) = w; }
    }
};
template <int MODE> struct EpiProj {
    static constexpr bool PERM = true, AFTER_DRAIN = false;
    const unsigned char* G; int ldg; bf16_t* Mb; bf16_t* MG;
    __device__ __forceinline__ void operator()(const f32x4 (&acc)[2][2][4][2], const Unit& u, int wr, int wc, int fr, int fq) const {
        const int row0 = u.pm * BM + wr * 64 + fr, col0 = u.pn * BM + wc * 32 + 8 * fq;
#pragma unroll
        for (int ai = 0; ai < 2; ++ai)
#pragma unroll
            for (int m = 0; m < 4; ++m) { const size_t r = (size_t)(row0 + ai * HALF + m * 16);
#pragma unroll
                for (int bj = 0; bj < 2; ++bj) { const int c = col0 + bj * HALF;
                    const uint2 gw = *(const uint2*)(G + r * ldg + c);
                    typedef float f2g __attribute__((ext_vector_type(2)));
                    const f2g ga = __builtin_amdgcn_cvt_pk_f32_fp8((int)gw.x, false), gb = __builtin_amdgcn_cvt_pk_f32_fp8((int)gw.x, true), gc = __builtin_amdgcn_cvt_pk_f32_fp8((int)gw.y, false), gd = __builtin_amdgcn_cvt_pk_f32_fp8((int)gw.y, true);
                    const f32x4 g0 = {ga[0], ga[1], gb[0], gb[1]}, g1 = {gc[0], gc[1], gd[0], gd[1]};
                    f32x4 v0 = acc[ai][bj][m][0] * g0, v1 = acc[ai][bj][m][1] * g1;
                    bf16_t* mp = Mb + r * 1024 + c;
                    if (MODE >= 1) { const u32x4 mw = *(const u32x4*)mp;
                        v0[0] += __uint_as_float(mw.x << 16); v0[1] += __uint_as_float(mw.x & 0xffff0000u); v0[2] += __uint_as_float(mw.y << 16); v0[3] += __uint_as_float(mw.y & 0xffff0000u);
                        v1[0] += __uint_as_float(mw.z << 16); v1[1] += __uint_as_float(mw.z & 0xffff0000u); v1[2] += __uint_as_float(mw.w << 16); v1[3] += __uint_as_float(mw.w & 0xffff0000u); }
                    u32x4 w; w.x = cvt_pk_bf16(v0[0], v0[1]); w.y = cvt_pk_bf16(v0[2], v0[3]); w.z = cvt_pk_bf16(v1[0], v1[1]); w.w = cvt_pk_bf16(v1[2], v1[3]);
                    if (MODE <= 1) *(u32x4*)mp = w; else *(u32x4*)(MG + r * 1024 + c) = w; } }
    }
};
struct ChainOrder { StaticOrder S;
    __device__ bool next(int i, Unit& u) const { const int t = i / 3; if (!S.next(t, u)) return false; u.br = i - 3 * t; return true; }
    __device__ __forceinline__ void a_ready(const Unit&) const {}
    __device__ __forceinline__ void done(const Unit&) const {}
};
struct EpiChain {
    static constexpr bool PERM = true, AFTER_DRAIN = false;
    const unsigned char* G; bf16_t* MG;
    __device__ __forceinline__ void operator()(const f32x4 (&)[2][2][4][2], const Unit&, int, int, int, int) const {}
    __device__ __forceinline__ void chain(f32x4 (&acc)[2][2][4][2], const Unit& u, int wr, int wc, int fr, int fq) const {
        typedef float f2g __attribute__((ext_vector_type(2)));
        const int row0 = u.pm * BM + wr * 64 + fr, col0 = u.pn * BM + wc * 32 + 8 * fq, br = u.br;
#pragma unroll
        for (int ai = 0; ai < 2; ++ai)
#pragma unroll
            for (int m = 0; m < 4; ++m) { const size_t r = (size_t)(row0 + ai * HALF + m * 16);
#pragma unroll
                for (int bj = 0; bj < 2; ++bj) { const int c = col0 + bj * HALF;
                    const uint2 ga = *(const uint2*)(G + r * LDG + br * 1024 + c);
                    const f2g a0 = __builtin_amdgcn_cvt_pk_f32_fp8((int)ga.x, false), a1 = __builtin_amdgcn_cvt_pk_f32_fp8((int)ga.x, true), a2 = __builtin_amdgcn_cvt_pk_f32_fp8((int)ga.y, false), a3 = __builtin_amdgcn_cvt_pk_f32_fp8((int)ga.y, true);
                    f32x4 s0 = {a0[0], a0[1], a1[0], a1[1]}, s1 = {a2[0], a2[1], a3[0], a3[1]};
                    if (br < 2) { const uint2 gb = *(const uint2*)(G + r * LDG + (br + 1) * 1024 + c);
                        const f2g b0 = __builtin_amdgcn_cvt_pk_f32_fp8((int)gb.x, false), b1 = __builtin_amdgcn_cvt_pk_f32_fp8((int)gb.x, true), b2 = __builtin_amdgcn_cvt_pk_f32_fp8((int)gb.y, false), b3 = __builtin_amdgcn_cvt_pk_f32_fp8((int)gb.y, true);
                        s0[0] *= __builtin_amdgcn_rcpf(b0[0]); s0[1] *= __builtin_amdgcn_rcpf(b0[1]); s0[2] *= __builtin_amdgcn_rcpf(b1[0]); s0[3] *= __builtin_amdgcn_rcpf(b1[1]);
                        s1[0] *= __builtin_amdgcn_rcpf(b2[0]); s1[1] *= __builtin_amdgcn_rcpf(b2[1]); s1[2] *= __builtin_amdgcn_rcpf(b3[0]); s1[3] *= __builtin_amdgcn_rcpf(b3[1]);
                        acc[ai][bj][m][0] *= s0; acc[ai][bj][m][1] *= s1; }
                    else { const f32x4 v0 = acc[ai][bj][m][0] * s0, v1 = acc[ai][bj][m][1] * s1;
                        u32x4 w; w.x = cvt_pk_bf16(v0[0], v0[1]); w.y = cvt_pk_bf16(v0[2], v0[3]); w.z = cvt_pk_bf16(v1[0], v1[1]); w.w = cvt_pk_bf16(v1[2], v1[3]);
                        *(u32x4*)(MG + r * 1024 + c) = w; } } }
    }
};
template <bool HIN_BF16> struct EpiResid {
    static constexpr bool PERM = true, AFTER_DRAIN = false;
    const void* hin; bf16_t* hm; const float* gate;
    __device__ __forceinline__ void operator()(const f32x4 (&acc)[2][2][4][2], const Unit& u, int wr, int wc, int fr, int fq) const {
        const int row0 = u.pm * BM + wr * 64 + fr, col0 = u.pn * BM + wc * 32 + 8 * fq;
        const float* gp = gate + (size_t)(u.pm >> 3) * 6144 + col0;
        f32x4 gv[2][2];
#pragma unroll
        for (int bj = 0; bj < 2; ++bj)
#pragma unroll
            for (int n = 0; n < 2; ++n) gv[bj][n] = *(const f32x4*)(gp + bj * HALF + 4 * n);
#pragma unroll
        for (int ai = 0; ai < 2; ++ai)
#pragma unroll
            for (int m = 0; m < 4; ++m) { const size_t r = (size_t)(row0 + ai * HALF + m * 16);
#pragma unroll
                for (int bj = 0; bj < 2; ++bj) { const size_t o = r * 1024 + col0 + bj * HALF;
                    f32x4 h0, h1;
                    if constexpr (HIN_BF16) { const u32x4 hb = *(const u32x4*)((const bf16_t*)hin + o);
                        h0 = (f32x4){__uint_as_float(hb.x << 16), __uint_as_float(hb.x & 0xffff0000u), __uint_as_float(hb.y << 16), __uint_as_float(hb.y & 0xffff0000u)};
                        h1 = (f32x4){__uint_as_float(hb.z << 16), __uint_as_float(hb.z & 0xffff0000u), __uint_as_float(hb.w << 16), __uint_as_float(hb.w & 0xffff0000u)}; }
                    else { h0 = *(const f32x4*)((const float*)hin + o); h1 = *(const f32x4*)((const float*)hin + o + 4); }
                    const f32x4 v0 = h0 + gv[bj][0] * acc[ai][bj][m][0], v1 = h1 + gv[bj][1] * acc[ai][bj][m][1];
                    u32x4 w; w.x = cvt_pk_bf16(v0[0], v0[1]); w.y = cvt_pk_bf16(v0[2], v0[3]); w.z = cvt_pk_bf16(v1[0], v1[1]); w.w = cvt_pk_bf16(v1[2], v1[3]);
                    *(u32x4*)(hm + o) = w; } }
    }
};


template <class Epi, class Sched, bool ALIGN_EPI = false, bool SP2 = false, bool CHAIN = false>
__device__ __forceinline__ void gemm_phase(PG8_LAS unsigned char* lds, const Gemm g, const Sched& S, const Epi& E, const int tid) {
    const int wid = __builtin_amdgcn_readfirstlane(tid >> 6), lane = tid & 63, wr = wid >> 2, wc = wid & 3, fr = lane & 15, fq = lane >> 4;
    const int K = g.K, nt = K / BK;
    unsigned voffA[2], voffB[2];
#pragma unroll
    for (int i = 0; i < 2; ++i) { int R, C; stage_rc(tid * 16 + i * 8192, R, C); const int Rb = Epi::PERM ? ((R & ~31) + perm32(R & 31)) : R;
        voffA[i] = (unsigned)(R * K + C) * 2u; voffB[i] = (unsigned)(Rb * K + C) * 2u; }
    const size_t kstep = (size_t)(BK * 2);
    const size_t hstep = (size_t)HALF * K * 2;
    const size_t tstep = 2 * hstep;
    const unsigned ldsw = (unsigned)wid * 1024u;
    const int aoff = lds_byte(wr * 64 + fr, fq * 8), boff = lds_byte(wc * 32 + fr, fq * 8);
#define PG8_SA(b, h) (((b) * 2 + (h)) * HTB)
#define PG8_SB(b, h) ((4 + (b) * 2 + (h)) * HTB)
#define PG8_STAGE(bufoff, gbase, voff) do { _Pragma("unroll") for (int _i = 0; _i < 2; ++_i) \
        __builtin_amdgcn_global_load_lds((const unsigned*)((const char*)(gbase) + (voff)[_i]), (PG8_LAS unsigned*)(lds + (bufoff) + ldsw + _i * 8192), 16, 0, 0); } while (0)
#define PG8_LDA(dst, b, h) do { _Pragma("unroll") for (int m = 0; m < 4; ++m) _Pragma("unroll") for (int k = 0; k < 2; ++k) dst[m][k] = *(const PG8_LAS bf16x8*)(lds + PG8_SA(b, h) + aoff + m * 2048 + k * 1024); } while (0)
#define PG8_LDB(dst, b, h) do { _Pragma("unroll") for (int n = 0; n < 2; ++n) _Pragma("unroll") for (int k = 0; k < 2; ++k) dst[n][k] = *(const PG8_LAS bf16x8*)(lds + PG8_SB(b, h) + boff + n * 2048 + k * 1024); } while (0)
#define PG8_MMA(ai, bj, At, Bt) do { __builtin_amdgcn_s_setprio(1); _Pragma("unroll") for (int m = 0; m < 4; ++m) _Pragma("unroll") for (int n = 0; n < 2; ++n) _Pragma("unroll") for (int k = 0; k < 2; ++k) \
        acc[ai][bj][m][n] = __builtin_amdgcn_mfma_f32_16x16x32_bf16(Bt[n][k], At[m][k], acc[ai][bj][m][n], 0, 0, 0); __builtin_amdgcn_s_setprio(0); } while (0)
#define PG8_WAIT_V(n) asm volatile("s_waitcnt vmcnt(" #n ")" ::: "memory")
#define PG8_WAIT_L(n) asm volatile("s_waitcnt lgkmcnt(" #n ")" ::: "memory")
#define PG8_BAR __builtin_amdgcn_s_barrier()
#define PG8_SCHED __builtin_amdgcn_sched_barrier(0)
    Unit cur, nxt; int ui = 0;
    if (!S.next(0, cur)) return;
    f32x4 acc[2][2][4][2];
#pragma unroll
    for (int a = 0; a < 2; ++a)
#pragma unroll
        for (int b = 0; b < 2; ++b)
#pragma unroll
            for (int m = 0; m < 4; ++m)
#pragma unroll
                for (int n = 0; n < 2; ++n) acc[a][b][m][n] = (f32x4){0.f, 0.f, 0.f, 0.f};
    bf16x8 At[4][2], B0[2][2], B1[2][2];
#define PG8_SELA(u_) (!CHAIN || (u_).br == 0 ? g.A : ((u_).br == 1 ? g.A1 : g.A2))
#define PG8_SELB(u_) (!CHAIN || (u_).br == 0 ? g.Bt : ((u_).br == 1 ? g.Bt1 : g.Bt2))
    const char* cA = (const char*)PG8_SELA(cur) + (size_t)cur.pm * tstep; const char* cB = (const char*)PG8_SELB(cur) + (size_t)cur.pn * tstep;
    S.a_ready(cur);
    if constexpr (SP2) {
        PG8_STAGE(PG8_SB(0, 0), cB, voffB); PG8_STAGE(PG8_SB(0, 1), cB + hstep, voffB); PG8_STAGE(PG8_SA(0, 0), cA, voffA); PG8_STAGE(PG8_SA(0, 1), cA + hstep, voffA);
        if (wr == 1) PG8_BAR;
        PG8_WAIT_V(2); PG8_BAR;
        PG8_STAGE(PG8_SB(1, 0), cB + kstep, voffB); PG8_STAGE(PG8_SA(1, 0), cA + kstep, voffA); PG8_STAGE(PG8_SB(1, 1), cB + hstep + kstep, voffB);
        PG8_WAIT_V(6); PG8_BAR;
    } else {
        PG8_STAGE(PG8_SB(0, 0), cB, voffB); PG8_STAGE(PG8_SA(0, 0), cA, voffA); PG8_STAGE(PG8_SB(0, 1), cB + hstep, voffB); PG8_STAGE(PG8_SA(0, 1), cA + hstep, voffA);
        if (wr == 1) PG8_BAR;
        PG8_WAIT_V(4); PG8_BAR;
        PG8_STAGE(PG8_SB(1, 0), cB + kstep, voffB); PG8_STAGE(PG8_SA(1, 0), cA + kstep, voffA); PG8_STAGE(PG8_SB(1, 1), cB + hstep + kstep, voffB);
        PG8_WAIT_V(6); PG8_BAR;
    }
    for (;;) {
        const bool has_next = S.next(ui + 1, nxt);
        const char* nA = has_next ? (const char*)PG8_SELA(nxt) + (size_t)nxt.pm * tstep : cA; const char* nB = has_next ? (const char*)PG8_SELB(nxt) + (size_t)nxt.pn * tstep : cB;
        for (int t = 0; t < nt; t += 2) {
            const bool last = (t == nt - 2);
            const char* a1 = cA + (size_t)(t + 1) * kstep;
            const char* a2 = last ? nA : cA + (size_t)(t + 2) * kstep; const char* b2 = last ? nB : cB + (size_t)(t + 2) * kstep;
            const char* a3 = a2 + kstep; const char* b3 = b2 + kstep;
            if (last && has_next) S.a_ready(nxt);
            if constexpr (SP2) {
            PG8_LDB(B0, 0, 0); PG8_LDB(B1, 0, 1); PG8_SCHED; PG8_LDA(At, 0, 0); PG8_STAGE(PG8_SA(1, 1), a1 + hstep, voffA);
            PG8_WAIT_V(8); PG8_WAIT_L(0); PG8_BAR; PG8_MMA(0, 0, At, B0); PG8_MMA(0, 1, At, B1); PG8_BAR; PG8_SCHED;
            PG8_LDA(At, 0, 1); PG8_STAGE(PG8_SB(0, 0), b2, voffB); PG8_STAGE(PG8_SB(0, 1), b2 + hstep, voffB); PG8_STAGE(PG8_SA(0, 0), a2, voffA);
            PG8_WAIT_V(8); PG8_WAIT_L(0); PG8_BAR; PG8_MMA(1, 0, At, B0); PG8_MMA(1, 1, At, B1); PG8_BAR; PG8_SCHED;
            PG8_LDB(B0, 1, 0); PG8_LDB(B1, 1, 1); PG8_SCHED; PG8_LDA(At, 1, 0); PG8_STAGE(PG8_SA(0, 1), a2 + hstep, voffA);
            PG8_WAIT_V(8); PG8_WAIT_L(0); PG8_BAR; PG8_MMA(0, 0, At, B0); PG8_MMA(0, 1, At, B1); PG8_BAR; PG8_SCHED;
            PG8_LDA(At, 1, 1); PG8_STAGE(PG8_SB(1, 0), b3, voffB); PG8_STAGE(PG8_SB(1, 1), b3 + hstep, voffB); PG8_STAGE(PG8_SA(1, 0), a3, voffA);
            PG8_WAIT_V(8); PG8_WAIT_L(0); PG8_BAR; PG8_MMA(1, 0, At, B0); PG8_MMA(1, 1, At, B1); PG8_BAR; PG8_SCHED;
            } else {
            PG8_LDB(B0, 0, 0); PG8_SCHED; PG8_LDA(At, 0, 0); PG8_STAGE(PG8_SA(1, 1), a1 + hstep, voffA);
            PG8_WAIT_L(8); PG8_BAR; PG8_WAIT_L(0); PG8_MMA(0, 0, At, B0); PG8_BAR; PG8_SCHED;
            PG8_LDB(B1, 0, 1); PG8_STAGE(PG8_SB(0, 0), b2, voffB);
            PG8_BAR; PG8_WAIT_L(0); PG8_MMA(0, 1, At, B1); PG8_BAR;
            PG8_LDA(At, 0, 1); PG8_STAGE(PG8_SA(0, 0), a2, voffA);
            PG8_BAR; PG8_WAIT_L(0); PG8_MMA(1, 0, At, B0); PG8_BAR; PG8_SCHED;
            PG8_STAGE(PG8_SB(0, 1), b2 + hstep, voffB);
            PG8_WAIT_V(6); PG8_BAR; PG8_MMA(1, 1, At, B1); PG8_BAR;
            PG8_LDB(B0, 1, 0); PG8_SCHED; PG8_LDA(At, 1, 0); PG8_STAGE(PG8_SA(0, 1), a2 + hstep, voffA);
            PG8_WAIT_L(8); PG8_BAR; PG8_WAIT_L(0); PG8_MMA(0, 0, At, B0); PG8_BAR; PG8_SCHED;
            PG8_LDB(B1, 1, 1); PG8_STAGE(PG8_SB(1, 0), b3, voffB);
            PG8_BAR; PG8_WAIT_L(0); PG8_MMA(0, 1, At, B1); PG8_BAR;
            PG8_LDA(At, 1, 1); PG8_STAGE(PG8_SA(1, 0), a3, voffA);
            PG8_BAR; PG8_WAIT_L(0); PG8_MMA(1, 0, At, B0); PG8_BAR; PG8_SCHED;
            PG8_STAGE(PG8_SB(1, 1), b3 + hstep, voffB);
            PG8_WAIT_V(6); PG8_BAR; PG8_MMA(1, 1, At, B1); PG8_BAR;
            }
        }
        if constexpr (ALIGN_EPI) { if (wr == 0) PG8_BAR; }
        if constexpr (CHAIN) { E.chain(acc, cur, wr, wc, fr, fq); } else
        if constexpr (!Epi::AFTER_DRAIN) { E(acc, cur, wr, wc, fr, fq); S.done(cur); }
        if (!has_next) break;
        if (!CHAIN || cur.br == 2)
#pragma unroll
        for (int a = 0; a < 2; ++a)
#pragma unroll
            for (int b = 0; b < 2; ++b)
#pragma unroll
                for (int m = 0; m < 4; ++m)
#pragma unroll
                    for (int n = 0; n < 2; ++n) acc[a][b][m][n] = (f32x4){0.f, 0.f, 0.f, 0.f};
        cur = nxt; cA = nA; cB = nB; ++ui;
        if constexpr (ALIGN_EPI) { if (wr == 1) PG8_BAR; }
    }
    PG8_WAIT_V(0);
    if constexpr (!ALIGN_EPI) { if (wr == 0) PG8_BAR; }
    PG8_BAR;
    if constexpr (Epi::AFTER_DRAIN) { E.fused(acc, cur, wr, wc, fr, fq, lds, wid, lane); S.done(cur); }
#undef PG8_SELA
#undef PG8_SELB
#undef PG8_SA
#undef PG8_SB
#undef PG8_STAGE
#undef PG8_LDA
#undef PG8_LDB
#undef PG8_MMA
#undef PG8_WAIT_V
#undef PG8_WAIT_L
#undef PG8_BAR
#undef PG8_SCHED
}
}


constexpr size_t WS_UB = WS_Z + 160 * MiB;
constexpr size_t WS_VB = WS_Z + 192 * MiB;
__device__ __forceinline__ void ph_uvprep(const Ids& id, const Params& p, int layer) {
    const float4* U = (const float4*)(p.peer_u + (size_t)layer * 16384 * 1024); const float4* V = (const float4*)(p.peer_v + (size_t)layer * 16384 * 1024);
    uint2* UB = (uint2*)(p.ws + WS_UB); uint2* VB = (uint2*)(p.ws + WS_VB);
    const size_t n4 = (size_t)16384 * 1024 / 4;
    for (size_t i = (size_t)id.bid * NTHR + id.tid; i < n4; i += (size_t)gridDim.x * NTHR) {
        const float4 a = U[i], b = V[i];
        uint2 oa, ob; oa.x = cvt_pk(a.x, a.y); oa.y = cvt_pk(a.z, a.w); ob.x = cvt_pk(b.x, b.y); ob.y = cvt_pk(b.z, b.w);
        UB[i] = oa; VB[i] = ob;
    }
}
__device__ __forceinline__ float wave_sum_dpp(float v) {
#pragma unroll
    for (int o = 32; o >= 1; o >>= 1) v += __shfl_xor(v, o);
    return v;
}
__device__ __forceinline__ void ph_peerexp2(const Ids& id, const Params& p, int layer) {
    const bf16* N = (const bf16*)(p.ws + WS_N); const int* PE = (const int*)(p.ws + WS_PE); const float* PG = (const float*)(p.ws + WS_PG);
    const bf16* UB = (const bf16*)(p.ws + WS_UB); const bf16* VB = (const bf16*)(p.ws + WS_VB);
    const float* mod = (const float*)(p.ws + WS_MOD) + (size_t)layer * 16 * 6144;
    const int lane = id.tid & 63, wave = __builtin_amdgcn_readfirstlane(id.tid >> 6);
    for (int tok = id.bid * 8 + wave; tok < NTOK; tok += gridDim.x * 8) {
        const int b = tok >> 11;
        float x[16];
        { const uint4 x0 = *(const uint4*)(N + (size_t)tok * 1024 + lane * 8), x1 = *(const uint4*)(N + (size_t)tok * 1024 + 512 + lane * 8); unpack8(x0, x); unpack8(x1, x + 8); }
        const int e0 = PE[(size_t)tok * 128 + lane], e1 = PE[(size_t)tok * 128 + 64 + lane];
        const float g0 = PG[(size_t)tok * 128 + lane], g1 = PG[(size_t)tok * 128 + 64 + lane];
        float d0 = 0.f, d1 = 0.f;
#pragma unroll 4
        for (int j = 0; j < 64; ++j) {
            const int ea = __shfl(e0, j), eb = __shfl(e1, j);
            const bf16* ua = UB + (size_t)ea * 1024 + lane * 8; const bf16* ub = UB + (size_t)eb * 1024 + lane * 8;
            const uint4 a0 = *(const uint4*)ua, a1 = *(const uint4*)(ua + 512), b0 = *(const uint4*)ub, b1 = *(const uint4*)(ub + 512);
            float f[8]; float sa = 0.f, sb = 0.f;
            unpack8(a0, f);
#pragma unroll
            for (int i = 0; i < 8; ++i) sa += x[i] * f[i];
            unpack8(a1, f);
#pragma unroll
            for (int i = 0; i < 8; ++i) sa += x[8 + i] * f[i];
            unpack8(b0, f);
#pragma unroll
            for (int i = 0; i < 8; ++i) sb += x[i] * f[i];
            unpack8(b1, f);
#pragma unroll
            for (int i = 0; i < 8; ++i) sb += x[8 + i] * f[i];
            sa = wave_sum_dpp(sa); sb = wave_sum_dpp(sb);
            if (lane == j) { d0 = sa; d1 = sb; }
        }
        const float w0 = g0 * (0.5f * d0 * (1.f + erff(d0 * 0.70710678118654752f))), w1 = g1 * (0.5f * d1 * (1.f + erff(d1 * 0.70710678118654752f)));
        float acc[16];
#pragma unroll
        for (int i = 0; i < 16; ++i) acc[i] = 0.f;
#pragma unroll 4
        for (int j = 0; j < 64; ++j) {
            const int ea = __shfl(e0, j), eb = __shfl(e1, j); const float wa = __shfl(w0, j), wb = __shfl(w1, j);
            const bf16* va = VB + (size_t)ea * 1024 + lane * 8; const bf16* vb = VB + (size_t)eb * 1024 + lane * 8;
            const uint4 a0 = *(const uint4*)va, a1 = *(const uint4*)(va + 512), b0 = *(const uint4*)vb, b1 = *(const uint4*)(vb + 512);
            float f[8];
            unpack8(a0, f);
#pragma unroll
            for (int i = 0; i < 8; ++i) acc[i] += wa * f[i];
            unpack8(a1, f);
#pragma unroll
            for (int i = 0; i < 8; ++i) acc[8 + i] += wa * f[i];
            unpack8(b0, f);
#pragma unroll
            for (int i = 0; i < 8; ++i) acc[i] += wb * f[i];
            unpack8(b1, f);
#pragma unroll
            for (int i = 0; i < 8; ++i) acc[8 + i] += wb * f[i];
        }
        const float* gp = mod + (size_t)b * 6144 + 5 * 1024;
        float* op = p.out + (size_t)tok * 1024;
#pragma unroll
        for (int hh = 0; hh < 2; ++hh)
#pragma unroll
            for (int q = 0; q < 2; ++q) { const int c = hh * 512 + lane * 8 + q * 4;
                const float4 g = *(const float4*)(gp + c); float4 o = *(const float4*)(op + c);
                o.x += g.x * acc[hh * 8 + q * 4 + 0]; o.y += g.y * acc[hh * 8 + q * 4 + 1]; o.z += g.z * acc[hh * 8 + q * 4 + 2]; o.w += g.w * acc[hh * 8 + q * 4 + 3];
                *(float4*)(op + c) = o; }
    }
}


__device__ __forceinline__ unsigned f2key(float x) { const unsigned b = __float_as_uint(x); return (b & 0x80000000u) ? ~b : (b | 0x80000000u); }
__device__ __forceinline__ float key2f(unsigned k) { return __uint_as_float((k & 0x80000000u) ? (k & 0x7fffffffu) : ~k); }
__device__ __forceinline__ void sort16_desc(unsigned (&v)[16]) {
#pragma unroll
    for (int k = 2; k <= 16; k <<= 1)
#pragma unroll
        for (int j = k >> 1; j > 0; j >>= 1)
#pragma unroll
            for (int i = 0; i < 16; ++i) { const int l = i ^ j;
                if (l > i) { const bool desc = (i & k) == 0; const unsigned mx = max(v[i], v[l]), mn = min(v[i], v[l]); v[i] = desc ? mx : mn; v[l] = desc ? mn : mx; } }
}
__device__ __forceinline__ void merge16_desc(unsigned (&R)[16], const unsigned (&G)[16]) {
#pragma unroll
    for (int i = 0; i < 16; ++i) R[i] = max(R[i], G[15 - i]);
#pragma unroll
    for (int j = 8; j > 0; j >>= 1)
#pragma unroll
        for (int i = 0; i < 16; ++i) { const int l = i ^ j; if (l > i) { const unsigned mx = max(R[i], R[l]), mn = min(R[i], R[l]); R[i] = mx; R[l] = mn; } }
}
__device__ __forceinline__ void cross_half_top16(unsigned (&T)[16], const unsigned (&R)[16], int hf) {
    unsigned O[16];
#pragma unroll
    for (int i = 0; i < 16; ++i) O[i] = __shfl_xor(R[i], 32);
#pragma unroll
    for (int i = 0; i < 16; ++i) { unsigned oi = O[i], ri = R[i], rj = R[15 - i], oj = O[15 - i]; asm volatile("" : "+v"(oi), "+v"(ri), "+v"(rj), "+v"(oj)); const unsigned a = hf ? oi : ri, b = hf ? rj : oj; T[i] = max(a, b); }
}
__device__ __forceinline__ void ph_peersel2(const Ids& id, const Params& p, int layer, float* lds) {
    const bf16* PQ = (const bf16*)(p.ws + WS_PQ); int* PE = (int*)(p.ws + WS_PE); float* PG = (float*)(p.ws + WS_PG);
    const bf16* SKB = (const bf16*)(p.ws + WS_SKB);
    const int lane = id.tid & 63, wave = __builtin_amdgcn_readfirstlane(id.tid >> 6), r = lane & 31, hf = lane >> 5;
    typedef __attribute__((address_space(3))) unsigned lds_u32;
    lds_u32* tl = (lds_u32*)((lds_u8*)lds + wave * 8192) + lane;
    typedef unsigned u4v __attribute__((ext_vector_type(4)));
    const int hg = id.bid & 1, tid_ = id.tid;
    lds_u8* skl = (lds_u8*)lds + 65536;
    for (int tile = (id.bid >> 1) * 8 + wave; tile < 1024; tile += ((int)gridDim.x >> 1) * 8) {
        const int tok0 = tile * 32;
#define SK_DMA(step, bufo) do { _Pragma("unroll") for (int i_ = 0; i_ < 4; ++i_) { int P = (wave * 4 + i_) * 64 + lane; asm volatile("" : "+v"(P));     \
        const int row = P >> 4, col = (P & 15) ^ (row & 15); \
        __builtin_amdgcn_global_load_lds((const __attribute__((address_space(1))) unsigned*)(SKB + (size_t)(hg * 8 + (step)) * 16384 + row * 128 + col * 8), \
            (__attribute__((address_space(3))) unsigned*)(skl + (bufo) + (wave * 4 + i_) * 1024), 16, 0, 0); } } while (0)
        __syncthreads();
        SK_DMA(0, 0);
        __syncthreads();
        for (int hh = 0; hh < 4; ++hh) {
            const int h = hg * 4 + hh;
            unsigned T0[16], T1[16];
#pragma unroll
            for (int pp = 0; pp < 2; ++pp) {
                const int step = hh * 2 + pp, bufo = (step & 1) * 32768;
                s16x8 bq[8];
#pragma unroll
                for (int kk = 0; kk < 8; ++kk) bq[kk] = *(const s16x8*)(PQ + (size_t)(tok0 + r) * 2048 + h * 256 + pp * 128 + kk * 16 + hf * 8);
                if (step < 7) SK_DMA(step + 1, 32768 - bufo);
                const lds_u8* skp = skl + bufo + r * 256;
                unsigned R[16];
#pragma unroll
                for (int kb = 0; kb < 4; ++kb) {
                    f32x16 acc;
#pragma unroll
                    for (int i = 0; i < 16; ++i) acc[i] = 0.f;
#pragma unroll
                    for (int kk = 0; kk < 8; ++kk) acc = __builtin_amdgcn_mfma_f32_32x32x16_bf16(ldsv8(skp + kb * 32 * 256 + (((kk * 2 + hf) ^ (r & 15)) << 4)), bq[kk], acc, 0, 0, 0);
                    __builtin_amdgcn_sched_barrier(0);
                    unsigned G[16];
#pragma unroll
                    for (int i = 0; i < 16; ++i) { const int kidx = kb * 32 + (i & 3) + 8 * (i >> 2) + 4 * hf; G[i] = (f2key(acc[i]) & ~127u) | (unsigned)(127 - kidx); }
                    sort16_desc(G);
                    if (kb == 0) {
#pragma unroll
                        for (int i = 0; i < 16; ++i) R[i] = G[i];
                    } else merge16_desc(R, G);
                }
                __syncthreads();
                if (pp == 0) cross_half_top16(T0, R, hf); else cross_half_top16(T1, R, hf);
            }
            {
#pragma unroll
              for (int j = 8; j > 0; j >>= 1)
#pragma unroll
                for (int i = 0; i < 16; ++i) { const int l = i ^ j; if (l > i) { const unsigned mx0 = max(T0[i], T0[l]), mn0 = min(T0[i], T0[l]), mx1 = max(T1[i], T1[l]), mn1 = min(T1[i], T1[l]); T0[i] = mx0; T0[l] = mn0; T1[i] = mx1; T1[l] = mn1; } }
            }
            float v0[16], v1[16];
#pragma unroll
            for (int i = 0; i < 16; ++i) { tl[i * 64] = T0[i]; tl[(16 + i) * 64] = T1[i]; v0[i] = key2f(T0[i] & ~127u); v1[i] = key2f(T1[i] & ~127u); }
            unsigned R2[16];
            {
                static constexpr unsigned char PA0[32] = {0, 0, 0, 0, 0, 0, 0, 0, 1, 1, 1, 1, 2, 2, 2, 3, 3, 4, 5, 6, 7, 8, 10, 12, 14, 0, 0, 0, 0, 0, 0, 0}; static constexpr unsigned char PB0[32] = {0, 2, 4, 6, 8, 10, 12, 14, 0, 2, 4, 6, 0, 2, 4, 1, 3, 1, 0, 0, 0, 0, 0, 0, 0, 0, 0, 0, 0, 0, 0, 0};
                static constexpr unsigned char PA1[32] = {0, 0, 0, 0, 0, 0, 0, 0, 1, 1, 1, 1, 2, 2, 3, 3, 4, 4, 5, 6, 7, 9, 11, 13, 15, 0, 0, 0, 0, 0, 0, 0}; static constexpr unsigned char PB1[32] = {1, 3, 5, 7, 9, 11, 13, 15, 1, 3, 5, 7, 1, 3, 0, 2, 0, 2, 1, 1, 1, 0, 0, 0, 0, 0, 0, 0, 0, 0, 0, 0};
#pragma unroll
                for (int g = 0; g < 2; ++g) {
                    unsigned G[16];
#pragma unroll
                    for (int i = 0; i < 16; ++i) { const int sidx = g * 16 + i;
                        if (sidx < 25) { const float s_lo = v0[PA0[sidx]] + v1[PB0[sidx]], s_hi = v0[PA1[sidx]] + v1[PB1[sidx]];
                            const unsigned k_lo = (f2key(s_lo) & ~255u) | (unsigned)(255 - (PA0[sidx] * 16 + PB0[sidx])), k_hi = (f2key(s_hi) & ~255u) | (unsigned)(255 - (PA1[sidx] * 16 + PB1[sidx]));
                            G[i] = hf ? k_hi : k_lo; }
                        else G[i] = 0u; }
                    sort16_desc(G);
                    if (g == 0) {
#pragma unroll
                        for (int i = 0; i < 16; ++i) R2[i] = G[i];
                    } else merge16_desc(R2, G);
                }
            }
            unsigned W[16];
            cross_half_top16(W, R2, hf);
            float sv[16]; int ex[16]; float m = -3.0e38f;
#pragma unroll
            for (int i = 0; i < 16; ++i) { const unsigned ci = 255u - (W[i] & 255u); const unsigned t0 = tl[(ci >> 4) * 64], t1 = tl[(16 + (ci & 15)) * 64];
                sv[i] = key2f(t0 & ~127u) + key2f(t1 & ~127u); ex[i] = (int)((127u - (t0 & 127u)) * 128u + (127u - (t1 & 127u))); m = fmaxf(m, sv[i]); }
            float sum = 0.f;
#pragma unroll
            for (int i = 0; i < 16; ++i) { sv[i] = __expf(sv[i] - m); sum += sv[i]; }
            const float inv = 1.f / sum;
            { unsigned ew[4], gw[4];
#pragma unroll
              for (int q = 0; q < 4; ++q) {
                  int ea0 = ex[2 * q], ea1 = ex[8 + 2 * q], eb0 = ex[1 + 2 * q], eb1 = ex[9 + 2 * q]; float ga0 = sv[2 * q], ga1 = sv[8 + 2 * q], gb0 = sv[1 + 2 * q], gb1 = sv[9 + 2 * q];
                  asm volatile("" : "+v"(ea0), "+v"(ea1), "+v"(eb0), "+v"(eb1), "+v"(ga0), "+v"(ga1), "+v"(gb0), "+v"(gb1));
                  const int ea = hf ? ea1 : ea0, eb = hf ? eb1 : eb0; const float ga = hf ? ga1 : ga0, gb = hf ? gb1 : gb0;
                  ew[q] = (unsigned)ea | ((unsigned)eb << 16); gw[q] = pg8::cvt_pk_bf16(ga * inv, gb * inv); }
              uint4 e4, g4; e4.x = ew[0]; e4.y = ew[1]; e4.z = ew[2]; e4.w = ew[3]; g4.x = gw[0]; g4.y = gw[1]; g4.z = gw[2]; g4.w = gw[3];
              const size_t o16 = ((size_t)(tok0 + r) * 128 + h * 16 + hf * 8) * 2;
              *(uint4*)((unsigned char*)PE + o16) = e4; *(uint4*)((unsigned char*)PG + o16) = g4; }
        }
    }
    __syncthreads();
}
#undef SK_DMA


constexpr size_t WS_U8 = WS_Z + 160 * MiB, WS_V8 = WS_Z + 176 * MiB;
constexpr size_t WS_SU = WS_Z + 192 * MiB, WS_SV = WS_SU + 65536;
constexpr size_t WS_PW = WS_Z + 193 * MiB;
typedef float f32x2v __attribute__((ext_vector_type(2)));
__device__ __forceinline__ void ph_uvprep8(const Ids& id, const Params& p, int layer) {
    const float* U = p.peer_u + (size_t)layer * 16384 * 1024; const float* V = p.peer_v + (size_t)layer * 16384 * 1024;
    const int lane = id.tid & 63, wave = __builtin_amdgcn_readfirstlane(id.tid >> 6);
    for (int row = id.bid * 8 + wave; row < 32768; row += gridDim.x * 8) {
        const bool isv = row >= 16384; const int e = isv ? row - 16384 : row;
        const float4* src = (const float4*)((isv ? V : U) + (size_t)e * 1024 + lane * 16);
        const float4 a = src[0], b = src[1], c = src[2], d = src[3];
        float am = fmaxf(fmaxf(fmaxf(fabsf(a.x), fabsf(a.y)), fmaxf(fabsf(a.z), fabsf(a.w))), fmaxf(fmaxf(fabsf(b.x), fabsf(b.y)), fmaxf(fabsf(b.z), fabsf(b.w))));
        am = fmaxf(am, fmaxf(fmaxf(fmaxf(fabsf(c.x), fabsf(c.y)), fmaxf(fabsf(c.z), fabsf(c.w))), fmaxf(fmaxf(fabsf(d.x), fabsf(d.y)), fmaxf(fabsf(d.z), fabsf(d.w)))));
        am = wave_max(am);
        const float sc = am > 0.f ? am * (1.f / 440.f) : 1.f, inv = 1.f / sc;
        int w0 = 0, w1 = 0, w2 = 0, w3 = 0;
        w0 = __builtin_amdgcn_cvt_pk_fp8_f32(a.x * inv, a.y * inv, w0, false); w0 = __builtin_amdgcn_cvt_pk_fp8_f32(a.z * inv, a.w * inv, w0, true);
        w1 = __builtin_amdgcn_cvt_pk_fp8_f32(b.x * inv, b.y * inv, w1, false); w1 = __builtin_amdgcn_cvt_pk_fp8_f32(b.z * inv, b.w * inv, w1, true);
        w2 = __builtin_amdgcn_cvt_pk_fp8_f32(c.x * inv, c.y * inv, w2, false); w2 = __builtin_amdgcn_cvt_pk_fp8_f32(c.z * inv, c.w * inv, w2, true);
        w3 = __builtin_amdgcn_cvt_pk_fp8_f32(d.x * inv, d.y * inv, w3, false); w3 = __builtin_amdgcn_cvt_pk_fp8_f32(d.z * inv, d.w * inv, w3, true);
        uint4 o; o.x = (unsigned)w0; o.y = (unsigned)w1; o.z = (unsigned)w2; o.w = (unsigned)w3;
        *(uint4*)(p.ws + (isv ? WS_V8 : WS_U8) + (size_t)e * 1024 + lane * 16) = o;
        if (lane == 0) ((float*)(p.ws + (isv ? WS_SV : WS_SU)))[e] = sc;
    }
}
__device__ __forceinline__ void unpack_fp8x16(const uint4 q, float* f) {
    const unsigned w[4] = {q.x, q.y, q.z, q.w};
#pragma unroll
    for (int i = 0; i < 4; ++i) { const f32x2v lo = __builtin_amdgcn_cvt_pk_f32_fp8((int)w[i], false), hi = __builtin_amdgcn_cvt_pk_f32_fp8((int)w[i], true);
        f[4 * i] = lo[0]; f[4 * i + 1] = lo[1]; f[4 * i + 2] = hi[0]; f[4 * i + 3] = hi[1]; }
}
__device__ __forceinline__ float dot16_fp8(const uint4 q, const float* x) {
    const unsigned w[4] = {q.x, q.y, q.z, q.w}; f32x2v acc = {0.f, 0.f};
#pragma unroll
    for (int i = 0; i < 4; ++i) { const f32x2v lo = __builtin_amdgcn_cvt_pk_f32_fp8((int)w[i], false), hi = __builtin_amdgcn_cvt_pk_f32_fp8((int)w[i], true);
        const f32x2v x0 = {x[4 * i], x[4 * i + 1]}, x1 = {x[4 * i + 2], x[4 * i + 3]};
        acc = __builtin_elementwise_fma(x0, lo, acc); acc = __builtin_elementwise_fma(x1, hi, acc); }
    return acc[0] + acc[1]; }
__device__ __forceinline__ void dot16_fp8_acc(const uint4 q, const float* x, f32x2v& acc) {
    const unsigned w[4] = {q.x, q.y, q.z, q.w};
#pragma unroll
    for (int i = 0; i < 4; ++i) { const f32x2v lo = __builtin_amdgcn_cvt_pk_f32_fp8((int)w[i], false), hi = __builtin_amdgcn_cvt_pk_f32_fp8((int)w[i], true);
        const f32x2v x0 = {x[4 * i], x[4 * i + 1]}, x1 = {x[4 * i + 2], x[4 * i + 3]};
        acc = __builtin_elementwise_fma(x0, lo, acc); acc = __builtin_elementwise_fma(x1, hi, acc); } }
__device__ __forceinline__ float dot64_fp8(const uint4 q0, const uint4 q1, const uint4 q2, const uint4 q3, const float* x) {
    f32x2v a = {0.f, 0.f}, b = {0.f, 0.f};
    dot16_fp8_acc(q0, x, a); dot16_fp8_acc(q1, x + 16, b); dot16_fp8_acc(q2, x + 32, a); dot16_fp8_acc(q3, x + 48, b);
    a += b; return a[0] + a[1]; }
__device__ __forceinline__ float swap32_add(float a, float b) { const auto r = __builtin_amdgcn_permlane32_swap(__float_as_uint(a), __float_as_uint(b), false, false); return __uint_as_float(r[0]) + __uint_as_float(r[1]); }
__device__ __forceinline__ float swap16_add(float a, float b) { const auto r = __builtin_amdgcn_permlane16_swap(__float_as_uint(a), __float_as_uint(b), false, false); return __uint_as_float(r[0]) + __uint_as_float(r[1]); }
__device__ __forceinline__ float dpp_ror8(float v) { return __uint_as_float(__builtin_amdgcn_update_dpp(0u, __float_as_uint(v), 0x128, 0xf, 0xf, true)); }
__device__ __forceinline__ float sum8_dpp(float v) {
    v += __uint_as_float(__builtin_amdgcn_update_dpp(0u, __float_as_uint(v), 0x141, 0xf, 0xf, true));
    v += __uint_as_float(__builtin_amdgcn_update_dpp(0u, __float_as_uint(v), 0xb1, 0xf, 0xf, true));
    v += __uint_as_float(__builtin_amdgcn_update_dpp(0u, __float_as_uint(v), 0x4e, 0xf, 0xf, true));
    return v;
}

__device__ __forceinline__ float gelu_erf(float v) {
    const float av = fabsf(v), t = __builtin_amdgcn_rcpf(av * 0.2316418882f + 1.0f);
    float q = t * 0.5307027145f + (-0.7265760135f); q = q * t + 0.7107068705f; q = q * t + (-0.142248368f); q = q * t + 0.127414796f; q = q * t;
    const float e = __builtin_amdgcn_exp2f((v * v) * (-0.72134752044f));
    const float m = v * (q * e);
    return v < 0.f ? m : v - m;
}
__device__ __forceinline__ float row16_sum_dpp(float v) {
    v += __uint_as_float(__builtin_amdgcn_update_dpp(0u, __float_as_uint(v), 0x128, 0xf, 0xf, true));
    v += __uint_as_float(__builtin_amdgcn_update_dpp(0u, __float_as_uint(v), 0x124, 0xf, 0xf, true));
    v += __uint_as_float(__builtin_amdgcn_update_dpp(0u, __float_as_uint(v), 0x122, 0xf, 0xf, true));
    v += __uint_as_float(__builtin_amdgcn_update_dpp(0u, __float_as_uint(v), 0x121, 0xf, 0xf, true));
    return v;
}
__device__ __forceinline__ void ph_peer_u(const Ids& id, const Params& p, int layer, float* lds, int emask = 0x7fffffff) {
    const bf16* N = (const bf16*)(p.ws + WS_N); const int* PE = (const int*)(p.ws + WS_PE); const float* PG = (const float*)(p.ws + WS_PG); float* PW = (float*)(p.ws + WS_PW);
    const float* SU = (const float*)(p.ws + WS_SU); const float* SV = (const float*)(p.ws + WS_SV);
    const int lane = id.tid & 63, wave = __builtin_amdgcn_readfirstlane(id.tid >> 6), s16 = lane & 15, rg = lane >> 4;
    const unsigned char* U8b = p.ws + WS_U8; const unsigned uoff = (unsigned)(s16 * 16);
    const int j = id.bid & 7, widx = (id.bid >> 3) * 8 + wave, nw = ((int)gridDim.x >> 3) * 8;
    typedef __attribute__((address_space(3))) unsigned lds_u32;
    lds_u32* Le = (lds_u32*)((lds_u8*)lds + wave * 2048); lds_u32* Ls = Le + 128; lds_u32* Ld = Le + 256;
    unsigned nep = ((const unsigned*)PE)[(size_t)widx * 64 + lane], ngp = ((const unsigned*)PG)[(size_t)widx * 64 + lane];
    for (int tok = widx; tok < NTOK; tok += nw) {
        const int e0 = (int)(nep & 0xffffu), e1 = (int)(nep >> 16); const float g0 = __uint_as_float(ngp << 16), g1 = __uint_as_float(ngp & 0xffff0000u);
        uint4 xr[8];
#pragma unroll
        for (int i = 0; i < 4; ++i) { const bf16* xp = N + (size_t)tok * 1024 + i * 256 + s16 * 16; xr[2 * i] = *(const uint4*)xp; xr[2 * i + 1] = *(const uint4*)(xp + 8); }
        { const int tn = (tok + nw < NTOK) ? tok + nw : tok;
          nep = ((const unsigned*)PE)[(size_t)tn * 64 + lane]; ngp = ((const unsigned*)PG)[(size_t)tn * 64 + lane]; }
        const bool own0 = (e0 >> 11) == j, own1 = (e1 >> 11) == j;
        const unsigned long long m0 = __builtin_amdgcn_ballot_w64(own0), m1 = __builtin_amdgcn_ballot_w64(own1);
        const int n0 = __builtin_popcountll(m0), n = n0 + __builtin_popcountll(m1);
        const int pos0 = (int)__builtin_amdgcn_mbcnt_hi((unsigned)(m0 >> 32), __builtin_amdgcn_mbcnt_lo((unsigned)m0, 0u));
        const int pos1 = n0 + (int)__builtin_amdgcn_mbcnt_hi((unsigned)(m1 >> 32), __builtin_amdgcn_mbcnt_lo((unsigned)m1, 0u));
        if (own0) { Le[pos0] = (unsigned)e0; Ls[pos0] = (unsigned)(2 * lane); }
        if (own1) { Le[pos1] = (unsigned)e1; Ls[pos1] = (unsigned)(2 * lane + 1); }
        const int ef = (int)Le[lane < n ? lane : 0] & 16383; const float suf = SU[ef];
        const float svf = SV[ef];
        const int npass = (n + 3) >> 2;
        {
            uint4 q[6][4]; bool vld[6];
#pragma unroll
            for (int k = 0; k < 6; ++k) { const int idx = 4 * k + rg; vld[k] = idx < n;
                const int e = (int)Le[vld[k] ? idx : 0] & emask; const unsigned ro = ((unsigned)e << 10) + uoff;
                if (k < npass) { q[k][0] = *(const uint4*)(U8b + ro); q[k][1] = *(const uint4*)(U8b + ro + 256); q[k][2] = *(const uint4*)(U8b + ro + 512); q[k][3] = *(const uint4*)(U8b + ro + 768); } }
            float x[64];
#pragma unroll
            for (int i = 0; i < 8; ++i) unpack8(xr[i], x + 8 * i);
#pragma unroll
            for (int k = 0; k < 6; ++k) if (k < npass) {
                float d = dot64_fp8(q[k][0], q[k][1], q[k][2], q[k][3], x);
                d = row16_sum_dpp(d);
                if (vld[k] && s16 == 0) Ld[4 * k + rg] = __float_as_uint(d); }
        }
        for (int k = 6; k < npass; ++k) {
            float x[64];
#pragma unroll
            for (int i = 0; i < 8; ++i) unpack8(xr[i], x + 8 * i);
            const int idx = 4 * k + rg; const bool valid = idx < n;
            const int e = (int)Le[valid ? idx : 0] & emask;
            const unsigned ro = ((unsigned)e << 10) + uoff;
            const uint4 q0 = *(const uint4*)(U8b + ro), q1 = *(const uint4*)(U8b + ro + 256), q2 = *(const uint4*)(U8b + ro + 512), q3 = *(const uint4*)(U8b + ro + 768);
            float d = dot64_fp8(q0, q1, q2, q3, x);
            d = row16_sum_dpp(d);
            if (valid && s16 == 0) Ld[idx] = __float_as_uint(d);
        }
#pragma unroll
        for (int hh = 0; hh < 2; ++hh) { const int i = hh * 64 + lane;
            if (hh == 1 && n <= 64) break;
            const int slot = (i < n) ? (int)Ls[i] : 0; const float gsa = __shfl(g0, slot >> 1), gsb = __shfl(g1, slot >> 1); const float gs = (slot & 1) ? gsb : gsa;
            if (i < n) { const float dv = __uint_as_float(Ld[i]) * (hh == 0 ? suf : SU[(int)Le[i] & 16383]); const float g = gs * (hh == 0 ? svf : SV[(int)Le[i] & 16383]);
                ((bf16*)PW)[(size_t)tok * 128 + slot] = f2bf(g * gelu_erf(dv)); } }
    }
    __syncthreads();
}
struct TokV { int e0, e1; float ws0, ws1; float acc[16]; };
__device__ __forceinline__ void peerv_issue(const TokV& t, int hb, uint4 (&q)[8], float (&wsl)[8], const unsigned char* V8b, unsigned voff, int rg) {
#pragma unroll
    for (int it = 0; it < 8; ++it) { const int sl = it * 8 + rg;
        const int e = hb ? __shfl(t.e1, sl) : __shfl(t.e0, sl); wsl[it] = hb ? __shfl(t.ws1, sl) : __shfl(t.ws0, sl);
        q[it] = *(const uint4*)(V8b + (((unsigned)e << 10) + voff)); }
}
__device__ __forceinline__ void peerv_compute(TokV& t, const uint4 (&q)[8], const float (&wsl)[8]) {
#pragma unroll
    for (int it = 0; it < 8; ++it) { const unsigned w[4] = {q[it].x, q[it].y, q[it].z, q[it].w}; const f32x2v ws2 = {wsl[it], wsl[it]};
#pragma unroll
        for (int i = 0; i < 4; ++i) { const f32x2v lo = __builtin_amdgcn_cvt_pk_f32_fp8((int)w[i], false), hi = __builtin_amdgcn_cvt_pk_f32_fp8((int)w[i], true);
            f32x2v a0 = {t.acc[4 * i], t.acc[4 * i + 1]}, a1 = {t.acc[4 * i + 2], t.acc[4 * i + 3]};
            a0 = __builtin_elementwise_fma(ws2, lo, a0); a1 = __builtin_elementwise_fma(ws2, hi, a1);
            t.acc[4 * i] = a0[0]; t.acc[4 * i + 1] = a0[1]; t.acc[4 * i + 2] = a1[0]; t.acc[4 * i + 3] = a1[1]; } }
}
__device__ __forceinline__ void peerv_finish(const TokV& t, const Params& p, const float* modg, int tok, int dimoff, int lane, float gmul, bool last) {
    float r8[8], r4[4], r2[2];
#pragma unroll
    for (int i = 0; i < 8; ++i) r8[i] = swap32_add(t.acc[i], t.acc[8 + i]);
#pragma unroll
    for (int i = 0; i < 4; ++i) r4[i] = swap16_add(r8[i], r8[4 + i]);
    const bool b3 = (lane >> 3) & 1;
#pragma unroll
    for (int i = 0; i < 2; ++i) r2[i] = (b3 ? r4[2 + i] : r4[i]) + dpp_ror8(b3 ? r4[i] : r4[2 + i]);
    const unsigned off = (unsigned)tok * 1024u + (unsigned)dimoff;
    const float2 g = *(const float2*)((const char*)modg + (((unsigned)(tok >> 11) * 6144u + (unsigned)dimoff) << 2)); const unsigned hb = *(const unsigned*)((const char*)(p.ws + WS_HM) + (off << 1));
    const float o0 = __uint_as_float(hb << 16) + gmul * g.x * r2[0], o1 = __uint_as_float(hb & 0xffff0000u) + gmul * g.y * r2[1];
    if (last) { float2 o; o.x = o0; o.y = o1; *(float2*)((char*)p.out + (off << 2)) = o; }
    else *(unsigned*)((char*)p.out + (off << 1)) = pg8::cvt_pk_bf16(o0, o1);
}
__device__ __forceinline__ void ph_peer_v(const Ids& id, const Params& p, int layer, float gmul = 1.f) {
    const int* PE = (const int*)(p.ws + WS_PE); const float* PW = (const float*)(p.ws + WS_PW);
    const float* SV = (const float*)(p.ws + WS_SV);
    const float* mod = (const float*)(p.ws + WS_MOD) + (size_t)layer * 16 * 6144;
    const int lane = id.tid & 63, wave = __builtin_amdgcn_readfirstlane(id.tid >> 6), sub = lane & 7, rg = lane >> 3;
    const int j = id.bid & 7, widx = (id.bid >> 3) * 8 + wave, nw = ((int)gridDim.x >> 3) * 8;
    const unsigned char* V8b = p.ws + WS_V8; const unsigned voff = (unsigned)(j * 128 + sub * 16);
    const int dimoff = j * 128 + sub * 16 + 8 * ((lane >> 5) & 1) + 4 * ((lane >> 4) & 1) + 2 * ((lane >> 3) & 1);
#define PV_UNPACK(T, ew, ww) do { T.e0 = (int)((ew) & 0xffffu); T.e1 = (int)((ew) >> 16); T.ws0 = __uint_as_float((ww) << 16); T.ws1 = __uint_as_float((ww) & 0xffff0000u); } while (0)
#define PV_REC(tn_) do { nea = ((const unsigned*)PE)[(size_t)(tn_) * 64 + lane]; neb = ((const unsigned*)PE)[(size_t)((tn_) + nw) * 64 + lane]; \
                         nwa = ((const unsigned*)PW)[(size_t)(tn_) * 64 + lane]; nwb = ((const unsigned*)PW)[(size_t)((tn_) + nw) * 64 + lane]; } while (0)
    unsigned nea, neb, nwa, nwb;
    TokV A, B;
    PV_REC(widx);
    unsigned pea = nea, peb = neb, pwa = nwa, pwb = nwb;
    PV_UNPACK(A, pea, pwa); PV_UNPACK(B, peb, pwb);
    { const int t1 = (widx + 2 * nw < NTOK) ? widx + 2 * nw : widx; PV_REC(t1); }
    uint4 qa[8], qb[8]; float wa[8], wb[8];
    peerv_issue(A, 0, qa, wa, V8b, voff, rg); peerv_issue(B, 0, qb, wb, V8b, voff, rg);
    for (int tok = widx; tok < NTOK; tok += 2 * nw) {
        const int tokB = tok + nw;
        PV_UNPACK(A, pea, pwa); PV_UNPACK(B, peb, pwb);
#pragma unroll
        for (int i = 0; i < 16; ++i) { A.acc[i] = 0.f; B.acc[i] = 0.f; }
        peerv_compute(A, qa, wa); peerv_issue(A, 1, qa, wa, V8b, voff, rg); __builtin_amdgcn_sched_barrier(0);
        peerv_compute(B, qb, wb); peerv_issue(B, 1, qb, wb, V8b, voff, rg); __builtin_amdgcn_sched_barrier(0);
        peerv_compute(A, qa, wa);
        { TokV An; PV_UNPACK(An, nea, nwa); peerv_issue(An, 0, qa, wa, V8b, voff, rg); } __builtin_amdgcn_sched_barrier(0);
        peerv_compute(B, qb, wb);
        { TokV Bn; PV_UNPACK(Bn, neb, nwb); peerv_issue(Bn, 0, qb, wb, V8b, voff, rg); } __builtin_amdgcn_sched_barrier(0);
        pea = nea; peb = neb; pwa = nwa; pwb = nwb;
        { const int t2 = (tok + 4 * nw < NTOK) ? tok + 4 * nw : tok; PV_REC(t2); }
        peerv_finish(A, p, mod + 5 * 1024, tok, dimoff, lane, gmul, layer == 1);
        peerv_finish(B, p, mod + 5 * 1024, tokB, dimoff, lane, gmul, layer == 1);
    }
#undef PV_UNPACK
#undef PV_REC
}

#ifndef PROBE_A
#define PROBE_A 0
#endif
#ifndef PROBE_GAIN
#define PROBE_GAIN 1.0f
#endif
#if PROBE_A
constexpr size_t WS_Y2 = 516 * MiB;
__device__ __forceinline__ void ph_probe_diff(const Ids& id, const Params& p, int layer, float* lds) {
    const bf16* Y1 = (const bf16*)(p.ws + WS_YA); const bf16* Y2 = (const bf16*)(p.ws + WS_Y2);
    float e = 0.f, n = 0.f;
    for (size_t i = (size_t)id.bid * NTHR + id.tid; i < (size_t)8192 * 512; i += (size_t)gridDim.x * NTHR) { const float a = bf2f(Y1[i]), b = bf2f(Y2[i]); e += (a - b) * (a - b); n += a * a; }
    e = wave_sum(e); n = wave_sum(n);
    __syncthreads();
    if ((id.tid & 63) == 0) { lds[(id.tid >> 6) * 2] = e; lds[(id.tid >> 6) * 2 + 1] = n; }
    __syncthreads();
    if (id.tid == 0) { float es = 0.f, ns = 0.f; for (int w = 0; w < 8; ++w) { es += lds[w * 2]; ns += lds[w * 2 + 1]; }
        float* o = (float*)(p.ws + WS_CTL) + (layer * 256 + id.bid) * 2; o[0] = es; o[1] = ns; }
    __syncthreads();
}
__device__ __forceinline__ void ph_probe_scale(const Ids& id, const Params& p) {
    float e = 0.f, n = 0.f; const float* c = (const float*)(p.ws + WS_CTL);
    for (int i = 0; i < 2 * (int)gridDim.x; ++i) { e += c[2 * i]; n += c[2 * i + 1]; }
    const float f = 1.f + PROBE_GAIN * sqrtf(e / n);
    for (size_t i = (size_t)id.bid * NTHR + id.tid; i < (size_t)NTOK * 1024; i += (size_t)gridDim.x * NTHR) p.out[i] *= f;
}
#endif

#define XB_TMO      128
#define XB_XCNT(j)  (256  + 64 * (j))
#define XB_XSUB(j)  (1280 + 64 * (j))
#define XB_XGEN(j)  (2304 + 64 * (j))
#define XB_TOP      3328
#define XB_TOPGEN   3392
#define XCD_BAR_WORDS 3456
#define XB_SPIN_CAP (1u << 18)

__device__ __forceinline__ unsigned xb_ld(unsigned* p)              { return __hip_atomic_load(p, __ATOMIC_RELAXED, __HIP_MEMORY_SCOPE_AGENT); }
__device__ __forceinline__ unsigned xb_add(unsigned* p, unsigned v) { return __hip_atomic_fetch_add(p, v, __ATOMIC_RELAXED, __HIP_MEMORY_SCOPE_AGENT); }
__device__ __forceinline__ unsigned xb_xcc_id() { return (unsigned)__builtin_amdgcn_s_getreg((3 << 11) | 20) & 0xFu; }
#define XB_SPIN(cond, bar) do { unsigned _sp = 0; while (cond) { __builtin_amdgcn_s_sleep(1); \
    if ((++_sp & 255u) == 0u) { if (xb_ld(&(bar)[XB_TMO])) break; if (_sp > XB_SPIN_CAP) { atomicAdd(&(bar)[XB_TMO], 1u); break; } } } } while (0)

struct XcdBarrier {
    unsigned* bar; unsigned x;
    volatile __attribute__((address_space(3))) unsigned* st;
};

__device__ __forceinline__ XcdBarrier xcd_barrier_post(unsigned* bar, volatile __attribute__((address_space(3))) unsigned* st) {
    XcdBarrier b; b.bar = bar; b.x = xb_xcc_id(); b.st = st;
    if (threadIdx.x == 0) (void)xb_add(&bar[XB_XCNT(b.x)], 1u);
    return b;
}
__device__ __forceinline__ void xcd_barrier_complete(unsigned* bar, unsigned x, unsigned& nloc, unsigned& nx) {
    const unsigned G = gridDim.x * gridDim.y * gridDim.z;
    unsigned sum, cnt, mine, sp = 0u;
    for (;;) {
        sum = 0u; cnt = 0u; mine = 0u;
#pragma unroll
        for (unsigned j = 0; j < 16; ++j) { const unsigned c = xb_ld(&bar[XB_XCNT(j)]); sum += c; cnt += (c > 0u) ? 1u : 0u; mine = (j == x) ? c : mine; }
        if (sum == G) break;
        __builtin_amdgcn_s_sleep(1);
        if ((++sp & 255u) == 0u) { if (xb_ld(&bar[XB_TMO])) break; if (sp > XB_SPIN_CAP) { atomicAdd(&bar[XB_TMO], 1u); break; } }
    }
    nloc = mine > 0u ? mine : 1u; nx = cnt > 0u ? cnt : 1u;
}

__device__ __forceinline__ void xcd_barrier(const XcdBarrier& b) {
    asm volatile("s_waitcnt vmcnt(0)" ::: "memory");
    __syncthreads();
    if (threadIdx.x == 0) {
        unsigned* bar = b.bar;
        __builtin_amdgcn_s_waitcnt(0);
        unsigned nloc = b.st[0], nx = b.st[1];
        if (nloc == 0u) { xcd_barrier_complete(bar, b.x, nloc, nx); b.st[0] = nloc; b.st[1] = nx; }
        const unsigned old = xb_add(&bar[XB_XSUB(b.x)], 1u);
        const unsigned gen = old / nloc;
        if (old + 1u == (gen + 1u) * nloc) {
            __builtin_amdgcn_fence(__ATOMIC_RELEASE, "agent");
            asm volatile("s_waitcnt vmcnt(0)" ::: "memory");
            const unsigned og = xb_add(&bar[XB_TOP], 1u);
            const unsigned tg = og / nx;
            if (og + 1u == (tg + 1u) * nx) xb_add(&bar[XB_TOPGEN], 1u);
            else XB_SPIN(xb_ld(&bar[XB_TOPGEN]) == tg, bar);
            __builtin_amdgcn_fence(__ATOMIC_ACQUIRE, "agent");
            xb_add(&bar[XB_XGEN(b.x)], 1u);
            asm volatile("s_waitcnt vmcnt(0)" ::: "memory");
        } else {
            XB_SPIN(xb_ld(&bar[XB_XGEN(b.x)]) == gen, bar);
            __builtin_amdgcn_fence(__ATOMIC_ACQUIRE, "agent");
            asm volatile("s_waitcnt vmcnt(0)" ::: "memory");
        }
    }
    __syncthreads();
}


constexpr int PH_PER_LAYER = 14;
#ifndef REP_PEERSEL
#define REP_PEERSEL 1
#endif
#ifndef REP_C
#define REP_C 1
#endif
#ifndef PROBE_NOGATHER
#define PROBE_NOGATHER 0
#endif
#ifndef USE_XCD_BARRIER
#define USE_XCD_BARRIER 1
#endif
#ifndef USE_PEER8
#define USE_PEER8 1
#endif
#ifndef REP_A
#define REP_A 1
#endif
#ifndef REP_B
#define REP_B 1
#endif
#ifndef REP_C2
#define REP_C2 1
#endif
#ifndef REP_Q
#define REP_Q -100
#endif
#ifndef REP_N
#define REP_N 2
#endif
#ifndef USE_C_MFMA
#define USE_C_MFMA 1
#endif
#ifndef USE_PEERSEL2
#define USE_PEERSEL2 1
#endif
#ifndef USE_PEEREXP2
#define USE_PEEREXP2 1
#endif
#ifndef USE_A_MFMA
#define USE_A_MFMA 1
#endif
#ifndef USE_B_MFMA
#define USE_B_MFMA 1
#endif
#ifndef GATE_ACT
#define GATE_ACT 1
#endif
#ifndef GEMM_PG8
#define GEMM_PG8 31
#endif

template <class Epi>
__device__ __forceinline__ void run_gemm(const Ids& id, float* lds, const bf16* A, const bf16* Bt, int N, int K, const Epi& E) {
    pg8::Gemm g{A, Bt, NTOK, N, K, nullptr, nullptr, nullptr, nullptr}; pg8::StaticOrder S; S.init(NTOK, N, (int)gridDim.x, id.bid);
    pg8::gemm_phase<Epi, pg8::StaticOrder, true, true>((PG8_LAS unsigned char*)lds, g, S, E, id.tid);
}

template <int Q>
__device__ __forceinline__ void run_phase_body(const Params& p, int layer, float* lds, const int rep_) {
    {
    Ids id; id.tid = threadIdx.x; id.bid = blockIdx.x;
    asm volatile("" : "+v"(id.tid), "+s"(id.bid));
    if constexpr (Q < 0) { ph_mod(id, p, lds); if (rep_ + 1 < ((Q == REP_Q) ? REP_N : 1)) return;
#if PROBE_A
        if (id.bid == 0 && id.tid < 2) ((float*)(p.ws + WS_CTL))[id.tid] = 0.f;
#endif
        return; }
    unsigned char* ws = p.ws;
    bf16* N = (bf16*)(ws + WS_N); bf16* Z = (bf16*)(ws + WS_Z);
    const float* mod = (const float*)(ws + WS_MOD) + (size_t)layer * 16 * 6144;
    float* M = (float*)(ws + WS_M); bf16* G = (bf16*)(ws + WS_G);
    const float* win = p.w_in + (size_t)layer * 1024 * INC;
    if constexpr (Q == 0) { ph_wprep(id, p, layer, lds); ph_norm(id, p, layer, 0);
        if (id.bid == 0 && id.tid < 256) { const int t4 = id.tid >> 6, c = id.tid & 63; const float* sp = t4 == 0 ? p.a_qn_g : (t4 == 1 ? p.a_kn_g : (t4 == 2 ? p.b_qn_g : p.b_kn_g));
            ((float*)(ws + WS_QKG))[layer * 256 + id.tid] = sp[layer * 64 + c]; } }
    if constexpr (Q == 1) { if constexpr (GEMM_PG8 & 1) { if constexpr (FUSE_QK) run_gemm(id, lds, N, (const bf16*)(ws + WS_WIN_T), 4096, 1024, pg8::EpiInQK{Z, ZC, (const float*)(ws + WS_QKG) + layer * 256, (PG8_LAS float*)((PG8_LAS unsigned char*)lds + pg8::STAGE_BYTES)});
                              else run_gemm(id, lds, N, (const bf16*)(ws + WS_WIN_T), 4096, 1024, pg8::EpiBfStore<0>{Z, ZC, nullptr}); }
                            else gemm_naive<true>(id, N, 1024, win, INC, 4052, 1024, EpiBf{Z, ZC, 0}, lds); }
    if constexpr (Q == 2 && !FUSE_QK) ph_qknorm(id, p, layer);
    if constexpr (Q == 3) {
#if PROBE_A
        ph_A(id, p, lds); ph_A_mfma(id, p, layer, lds, WS_Y2, 4);
#else
        if constexpr (USE_A_MFMA) { for (int ra = 0; ra < REP_A; ++ra) { asm volatile("" : "+s"(ra)); ph_A_mfma(id, p, layer, lds); } } else ph_A(id, p, lds);
#endif
 if constexpr (USE_B_MFMA) { for (int rb = 0; rb < REP_B; ++rb) { asm volatile("" : "+s"(rb)); ph_B_mfma(id, p, lds); } } else ph_B(id, p, lds); ph_C_chunk<1>(id, p, layer, lds); }
    if constexpr (Q == 5) ph_C_chunk<3>(id, p, layer, lds);
    if constexpr (Q == 4) { ph_C_scan(id, p);
        if constexpr (FUSE_GATES) run_gemm(id, lds, N, (const bf16*)(ws + WS_WG_T), 3072, 1024, pg8::EpiGate8{(unsigned char*)G, LDG, p.b_gate + layer * 3072});
#if PROBE_A
        ph_probe_diff(id, p, layer, lds);
#endif
    }
    if constexpr (Q == 6 && !FUSE_GATES) { if constexpr (GEMM_PG8 & 2) run_gemm(id, lds, N, (const bf16*)(ws + WS_WG_T), 3072, 1024, pg8::EpiGate8{(unsigned char*)G, LDG, p.b_gate + layer * 3072});
                            else gemm_naive<false>(id, N, 1024, win + 4052, INC, 3072, 1024, EpiSigBfN{G, p.b_gate + layer * 3072}, lds); }
    if constexpr (Q == 7) {
        if constexpr (GEMM_PG8 & 4) {
        {   pg8::Gemm g{(const bf16*)(ws + WS_YA), (const bf16*)(ws + WS_WOA_T), NTOK, 1024, 512, (const bf16*)(ws + WS_YB), (const bf16*)(ws + WS_WOB_T), (const bf16*)(ws + WS_YC), (const bf16*)(ws + WS_WOC_T)};
            pg8::ChainOrder S; S.S.init(NTOK, 1024, (int)gridDim.x, id.bid);
            pg8::gemm_phase<pg8::EpiChain, pg8::ChainOrder, true, true, true>((PG8_LAS unsigned char*)lds, g, S, pg8::EpiChain{(const unsigned char*)G, N}, id.tid); }
        } else {
        gemm_naive<false>(id, (const bf16*)(ws + WS_YA), 512, p.w_oa + (size_t)layer * 512 * 1024, 1024, 1024, 512, EpiProjN{G, M, N, 0, GATE_ACT ? nullptr : p.b_gate + layer * 3072}, lds);
        gemm_naive<false>(id, (const bf16*)(ws + WS_YB), 512, p.w_ob + (size_t)layer * 512 * 1024, 1024, 1024, 512, EpiProjN{G + 1024, M, N, 1, GATE_ACT ? nullptr : p.b_gate + layer * 3072 + 1024}, lds);
        gemm_naive<false>(id, (const bf16*)(ws + WS_YC), 512, p.w_oc + (size_t)layer * 512 * 1024, 1024, 1024, 512, EpiProjN{G + 2048, M, N, 2, GATE_ACT ? nullptr : p.b_gate + layer * 3072 + 2048}, lds);
        }
    }
    if constexpr (Q == 8) { if constexpr (GEMM_PG8 & 8) { if (layer == 0) run_gemm(id, lds, N, (const bf16*)(ws + WS_WOUT_T), 1024, 1024, pg8::EpiResid<false>{(const void*)p.x, (bf16*)(ws + WS_HM), mod + 2 * 1024});
                              else run_gemm(id, lds, N, (const bf16*)(ws + WS_WOUT_T), 1024, 1024, pg8::EpiResid<true>{(const void*)p.out, (bf16*)(ws + WS_HM), mod + 2 * 1024}); }
                            else gemm_naive<false>(id, N, 1024, p.w_out + (size_t)layer * 1024 * 1024, 1024, 1024, 1024, EpiRes{layer == 0 ? p.x : p.out, p.out, mod + 2 * 1024}, lds); }
    if constexpr (Q == 9) { ph_norm(id, p, layer, 1); if constexpr (USE_PEER8) ph_uvprep8(id, p, layer); else ph_uvprep(id, p, layer); }
    if constexpr (Q == 10) { if constexpr (GEMM_PG8 & 16) run_gemm(id, lds, N, (const bf16*)(ws + WS_WPQ_T), 2048, 1024, pg8::EpiBfStore<0>{(bf16*)(ws + WS_PQ), 2048, nullptr});
                            else gemm_naive<false>(id, N, 1024, p.peer_wq + (size_t)layer * 1024 * 2048, 2048, 2048, 1024, EpiBf{(bf16*)(ws + WS_PQ), 2048, 0}, lds); }
    if constexpr (Q == 11) { for (int rep = 0; rep < REP_PEERSEL; ++rep) { asm volatile("" : "+s"(rep)); if constexpr (USE_PEERSEL2) ph_peersel2(id, p, layer, lds); else ph_peersel(id, p, layer, lds); } }
    if constexpr (Q == 12) { if constexpr (USE_PEER8) ph_peer_u(id, p, layer, lds, (PROBE_NOGATHER && rep_ + 1 < REP_N) ? 0x3800 : 0x7fffffff); else if constexpr (USE_PEEREXP2) ph_peerexp2(id, p, layer); else ph_peerexp(id, p, layer, lds); }
    if constexpr (Q == 13) { if constexpr (USE_PEER8) ph_peer_v(id, p, layer, (rep_ + 1 < ((Q == REP_Q) ? REP_N : 1)) ? 0.f : 1.f); }
    }
}

template <int Q>
__device__ __forceinline__ void run_phase(const Params& p_unused, int layer, float* lds) {
    if constexpr (Q == REP_Q) { for (int rep_ = 0; rep_ < REP_N; ++rep_) { asm volatile("" : "+s"(rep_)); run_phase_body<Q>(p_unused, layer, lds, rep_); } }
    else run_phase_body<Q>(p_unused, layer, lds, 0);
}

#if MK_COOP
constexpr int CW_BAR = 4096;
constexpr int LDS_MISC = LDS_BYTES - 64;
#if USE_XCD_BARRIER
#define GSYNC() xcd_barrier(xbar)
#else
#define GSYNC() cg::this_grid().sync()
#endif
template <int Q> __device__ __forceinline__ void layer_phases(const Params& p, int layer, float* lds, const XcdBarrier& xbar) {
    if constexpr ((FUSE_QK && Q == 2) || (FUSE_GATES && Q == 6)) { layer_phases<Q + 1>(p, layer, lds, xbar); }
    else {
    run_phase<Q>(p, layer, lds);
    if constexpr (Q + 1 < PH_PER_LAYER) { GSYNC(); layer_phases<Q + 1>(p, layer, lds, xbar); }
    }
}
__global__ void __launch_bounds__(NTHR, 2) k_mega(Params p) {
    extern __shared__ __attribute__((aligned(16))) unsigned char lds_raw[];
    float* lds = (float*)lds_raw;
    volatile __attribute__((address_space(3))) unsigned* misc = (volatile __attribute__((address_space(3))) unsigned*)((__attribute__((address_space(3))) unsigned char*)lds_raw + LDS_MISC);
    if (threadIdx.x < 16) misc[threadIdx.x] = 0u;
    __syncthreads();
    XcdBarrier xbar; xbar.bar = (unsigned*)p.ws + CW_BAR; xbar.x = xb_xcc_id(); xbar.st = misc;
    if (blockIdx.x == 0) { uint4* cw = (uint4*)p.ws; const uint4 z4 = {0u, 0u, 0u, 0u};
#pragma unroll 1
        for (int i = threadIdx.x; i < 4096; i += NTHR) cw[i] = z4; }
    run_phase<-1>(p, 0, lds);
    cg::this_grid().sync();
    if (threadIdx.x == 0) (void)xb_add(&xbar.bar[XB_XCNT(xbar.x)], 1u);
    layer_phases<0>(p, 0, lds, xbar); GSYNC();
    layer_phases<0>(p, 1, lds, xbar);
#if PROBE_A
    GSYNC(); { Ids id; id.tid = threadIdx.x; id.bid = blockIdx.x; ph_probe_scale(id, p); }
#endif
}
#else
template <int Q> __global__ void __launch_bounds__(NTHR, 2) k_phase(Params p) {
    extern __shared__ __attribute__((aligned(16))) unsigned char lds_raw[];
    run_phase<Q>(p, p.ph_lo, (float*)lds_raw);
}
template <int Q> static void launch_phase(Params p, int layer, int grid, hipStream_t stream) {
    static bool attr = false;
    if (!attr) { (void)hipFuncSetAttribute((const void*)k_phase<Q>, hipFuncAttributeMaxDynamicSharedMemorySize, LDS_BYTES); attr = true; }
    p.ph_lo = layer; p.ph_hi = 0;
    hipLaunchKernelGGL(k_phase<Q>, dim3(grid), dim3(NTHR), LDS_BYTES, stream, p);
}
template <int Q> static void launch_layer(const Params& p, int layer, int grid, hipStream_t stream) {
    launch_phase<Q>(p, layer, grid, stream);
    if constexpr (Q + 1 < PH_PER_LAYER) launch_layer<Q + 1>(p, layer, grid, stream);
}
#endif

extern "C" void kernel_launch(void* const* d_in, const int* in_sizes, int n_in, void* d_out, int out_size, void* d_ws, size_t ws_size, hipStream_t stream) {
    static int grid = 0;
    if (grid == 0) {
        if (n_in != 23 || out_size != NTOK * D || ws_size < WS_END) { fprintf(stderr, "kernel_launch: unexpected problem: n_in %d out %d ws %zu (need %zu)\n", n_in, out_size, ws_size, (size_t)WS_END); grid = -1; return; }
        int dev = 0, cus = 0;
        (void)hipGetDevice(&dev); (void)hipDeviceGetAttribute(&cus, hipDeviceAttributeMultiprocessorCount, dev);
#if MK_COOP
        int per_cu = 0;
        if (hipFuncSetAttribute((const void*)k_mega, hipFuncAttributeMaxDynamicSharedMemorySize, LDS_BYTES) != hipSuccess) { fprintf(stderr, "hipFuncSetAttribute failed\n"); grid = -1; return; }
        if (hipOccupancyMaxActiveBlocksPerMultiprocessor(&per_cu, (const void*)k_mega, NTHR, LDS_BYTES) != hipSuccess || per_cu < 1) { fprintf(stderr, "occupancy query: %d\n", per_cu); per_cu = 1; }
        (void)hipGetLastError();
        grid = cus * per_cu;
#else
        grid = cus;
#endif
        fprintf(stderr, "kernel_launch: grid %d (cus %d), ws %zu\n", grid, cus, ws_size);
    }
    if (grid < 0) return;
    Params p{};
    const float** pp = (const float**)&p;
    for (int i = 0; i < 23; ++i) pp[i] = (const float*)d_in[i];
    p.out = (float*)d_out; p.ws = (unsigned char*)d_ws;
#if MK_COOP
    void* args[] = {&p};
    hipError_t e = hipLaunchCooperativeKernel((const void*)k_mega, dim3(grid), dim3(NTHR), args, LDS_BYTES, stream);
    if (e != hipSuccess) fprintf(stderr, "cooperative launch failed: %s (grid %d)\n", hipGetErrorString(e), grid);
#else
    launch_phase<-1>(p, 0, grid, stream);
    launch_layer<0>(p, 0, grid, stream);
    launch_layer<0>(p, 1, grid, stream);
#endif
}
```
